# Optimizing an MI355X kernel written in HIP

```python
import jax, jax.numpy as jnp
from jax import lax
import numpy as np

D_MODEL = 1024
BATCH = 8
SEQ = 2048
DEPTH = 2

GRID_W = 64
NA_HEADS = 4
NA_HEAD_DIM = 64
NA_KH = 8
NA_KW = 16
NA_QB = 16
MLA_HEADS = 4
MLA_Q_LORA = 256
MLA_KV_LORA = 128
MLA_NOPE = 64
MLA_ROPE = 32
MLA_V = 64
GQA_HEADS = 8
GQA_KV_HEADS = 2
GQA_HEAD_DIM = 64
N_BRANCHES = 3
FFN_HIDDEN = -(-8 * D_MODEL // (3 * 256)) * 256
Q_BLOCK = 128
ROPE_THETA = 10000.0
AXIAL_THETA = 10000.0
NORM_EPS = 1e-6
N_MOD = 6

kernel_name = "hybrid_na_mla_gqa_encoder"


def _in_splits():
    return ([NA_HEADS * NA_HEAD_DIM] * 3
            + [MLA_Q_LORA, MLA_KV_LORA, MLA_ROPE]
            + [GQA_HEADS * GQA_HEAD_DIM, GQA_KV_HEADS * GQA_HEAD_DIM, GQA_KV_HEADS * GQA_HEAD_DIM]
            + [D_MODEL] * N_BRANCHES)


def _in_cols():
    return int(sum(_in_splits()))


def rms_norm(x, g):
    xf = x.astype(jnp.float32)
    y = xf * lax.rsqrt(jnp.mean(xf * xf, axis=-1, keepdims=True) + NORM_EPS)
    return (y * g.astype(jnp.float32)).astype(x.dtype)


def rope(x, pos, theta):
    d = x.shape[-1]
    half = d // 2
    inv_freq = 1.0 / (theta ** (jnp.arange(half, dtype=jnp.float32) / half))
    ang = pos[:, None] * inv_freq[None, :]
    ang = ang.reshape((ang.shape[0],) + (1,) * (x.ndim - 3) + (half,))
    cos, sin = jnp.cos(ang), jnp.sin(ang)
    xf = x.astype(jnp.float32)
    x1, x2 = xf[..., :half], xf[..., half:]
    return jnp.concatenate([x1 * cos - x2 * sin, x2 * cos + x1 * sin], axis=-1).astype(x.dtype)


def axial_rope(x, row, col):
    h = x.shape[-1] // 2
    return jnp.concatenate([rope(x[..., :h], row, AXIAL_THETA), rope(x[..., h:], col, AXIAL_THETA)], axis=-1)


def blocked_attention(q, k, v, scale):
    B, S, KVH, G, dk = q.shape
    dv = v.shape[-1]
    nb = S // Q_BLOCK
    qb = jnp.moveaxis(q.reshape(B, nb, Q_BLOCK, KVH, G, dk), 1, 0)

    def one_block(qi):
        s = jnp.einsum('bqkgd,bskd->bkgqs', qi, k, preferred_element_type=jnp.float32) * scale
        p = jax.nn.softmax(s, axis=-1)
        return jnp.einsum('bkgqs,bskd->bqkgd', p.astype(v.dtype), v)

    o = lax.map(one_block, qb)
    return jnp.moveaxis(o, 0, 1).reshape(B, S, KVH * G * dv)


def neighborhood_attention(q, k, v, rpb):
    B, S, H, d = q.shape
    rows = S // GRID_W
    kh = min(NA_KH, rows)
    kw = NA_KW
    n_cb = GRID_W // NA_QB
    band = NA_QB + kw
    scale = d ** -0.5
    qg = q.reshape(B, rows, GRID_W, H, d)
    kg = k.reshape(B, rows, GRID_W, H, d)
    vg = v.reshape(B, rows, GRID_W, H, d)

    cb_start = jnp.clip(jnp.arange(n_cb) * NA_QB - kw // 2, 0, GRID_W - band)
    band_cols = cb_start[:, None] + jnp.arange(band)[None, :]
    q_cols = (jnp.arange(n_cb) * NA_QB)[:, None] + jnp.arange(NA_QB)[None, :]
    win_start = jnp.clip(q_cols - kw // 2, 0, GRID_W - kw)
    bc = band_cols[:, None, :]
    col_valid = (bc >= win_start[..., None]) & (bc < win_start[..., None] + kw)
    col_off = jnp.clip(bc - q_cols[..., None], -(kw - 1), kw - 1) + (kw - 1)
    rpb_cols = rpb[:, :, col_off]

    def one_row(r):
        rs = jnp.clip(r - kh // 2, 0, rows - kh)
        k_rows = lax.dynamic_slice_in_dim(kg, rs, kh, axis=1)
        v_rows = lax.dynamic_slice_in_dim(vg, rs, kh, axis=1)
        k_band = k_rows[:, :, band_cols]
        v_band = v_rows[:, :, band_cols]
        q_row = lax.dynamic_index_in_dim(qg, r, axis=1, keepdims=False).reshape(B, n_cb, NA_QB, H, d)
        s = jnp.einsum('bnqhd,bknjhd->bhnqkj', q_row, k_band, preferred_element_type=jnp.float32) * scale
        row_off = rs + jnp.arange(kh) - r + (NA_KH - 1)
        bias = jnp.transpose(rpb_cols[:, row_off], (0, 2, 3, 1, 4))
        s = s + bias[None].astype(jnp.float32)
        s = jnp.where(col_valid[None, None, :, :, None, :], s, -jnp.inf)
        p = jax.nn.softmax(s.reshape(B, H, n_cb, NA_QB, kh * band), axis=-1)
        p = p.reshape(B, H, n_cb, NA_QB, kh, band)
        o = jnp.einsum('bhnqkj,bknjhd->bnqhd', p.astype(v.dtype), v_band)
        return o.reshape(B, GRID_W, H, d)

    out = lax.map(one_row, jnp.arange(rows))
    return jnp.moveaxis(out, 0, 1).reshape(B, S, H * d)


def hybrid_layer(x, c, ada_w, ada_b, norm_mix_g, norm_ffn_g, w_in, na_rpb,
                 mla_q_norm_g, mla_kv_norm_g, mla_w_uq, mla_w_ukv, gqa_q_norm_g, gqa_k_norm_g,
                 w_br_na, w_br_mla, w_br_gqa, w_out, ffn_w_gate_up, ffn_w_down, pos_t, pos_row, pos_col):
    B, S, D = x.shape
    mod = jax.nn.silu(c) @ ada_w + ada_b
    sh_m, sc_m, g_m, sh_f, sc_f, g_f = [m[:, None, :] for m in jnp.split(mod, N_MOD, axis=-1)]

    h = rms_norm(x, norm_mix_g) * (1 + sc_m) + sh_m
    proj = h @ w_in
    idx = [int(i) for i in np.cumsum(_in_splits())[:-1]]
    (qa, ka, va, cq, ckv, kr, qc, kc, vc, ga, gb, gc) = jnp.split(proj, idx, axis=-1)

    o_na = neighborhood_attention(qa.reshape(B, S, NA_HEADS, NA_HEAD_DIM),
                                  ka.reshape(B, S, NA_HEADS, NA_HEAD_DIM),
                                  va.reshape(B, S, NA_HEADS, NA_HEAD_DIM), na_rpb)

    q_b = (rms_norm(cq, mla_q_norm_g) @ mla_w_uq).reshape(B, S, MLA_HEADS, MLA_NOPE + MLA_ROPE)
    q_nope, q_pe = q_b[..., :MLA_NOPE], rope(q_b[..., MLA_NOPE:], pos_t, ROPE_THETA)
    kv_b = (rms_norm(ckv, mla_kv_norm_g) @ mla_w_ukv).reshape(B, S, MLA_HEADS, MLA_NOPE + MLA_V)
    k_nope, v_b = kv_b[..., :MLA_NOPE], kv_b[..., MLA_NOPE:]
    k_pe = jnp.broadcast_to(rope(kr, pos_t, ROPE_THETA)[:, :, None, :], (B, S, MLA_HEADS, MLA_ROPE))
    q_full = jnp.concatenate([q_nope, q_pe], axis=-1)[:, :, :, None, :]
    k_full = jnp.concatenate([k_nope, k_pe], axis=-1)
    o_mla = blocked_attention(q_full, k_full, v_b, (MLA_NOPE + MLA_ROPE) ** -0.5)

    q_c = axial_rope(rms_norm(qc.reshape(B, S, GQA_HEADS, GQA_HEAD_DIM), gqa_q_norm_g), pos_row, pos_col)
    k_c = axial_rope(rms_norm(kc.reshape(B, S, GQA_KV_HEADS, GQA_HEAD_DIM), gqa_k_norm_g), pos_row, pos_col)
    v_c = vc.reshape(B, S, GQA_KV_HEADS, GQA_HEAD_DIM)
    q_c = q_c.reshape(B, S, GQA_KV_HEADS, GQA_HEADS // GQA_KV_HEADS, GQA_HEAD_DIM)
    o_gqa = blocked_attention(q_c, k_c, v_c, GQA_HEAD_DIM ** -0.5)

    merged = (jax.nn.sigmoid(ga) * (o_na @ w_br_na)
              + jax.nn.sigmoid(gb) * (o_mla @ w_br_mla)
              + jax.nn.sigmoid(gc) * (o_gqa @ w_br_gqa))
    x = x + g_m * (merged @ w_out)

    h = rms_norm(x, norm_ffn_g) * (1 + sc_f) + sh_f
    gate, up = jnp.split(h @ ffn_w_gate_up, 2, axis=-1)
    x = x + g_f * ((jax.nn.silu(gate) * up) @ ffn_w_down)
    return x


def setup_inputs(seed: int = 0) -> dict:
    key = jax.random.key(seed)
    ks = jax.random.split(key, 24)
    f32 = jnp.float32

    def w(k, shape, fan_in):
        return jax.random.normal(k, shape, f32) * fan_in ** -0.5

    def gain(k, shape):
        return 1.0 + 0.02 * jax.random.normal(k, shape, f32)

    L, D = DEPTH, D_MODEL
    return {
        "x": jax.random.normal(ks[0], (BATCH, SEQ, D), f32),
        "c": jax.random.normal(ks[1], (BATCH, D), f32),
        "ada_w": w(ks[2], (L, D, N_MOD * D), D),
        "ada_b": 0.02 * jax.random.normal(ks[3], (L, N_MOD * D), f32),
        "norm_mix_g": gain(ks[4], (L, D)),
        "norm_ffn_g": gain(ks[5], (L, D)),
        "w_in": w(ks[6], (L, D, _in_cols()), D),
        "na_rpb": 0.1 * jax.random.normal(ks[7], (L, NA_HEADS, 2 * NA_KH - 1, 2 * NA_KW - 1), f32),
        "mla_q_norm_g": gain(ks[8], (L, MLA_Q_LORA)),
        "mla_kv_norm_g": gain(ks[9], (L, MLA_KV_LORA)),
        "mla_w_uq": w(ks[10], (L, MLA_Q_LORA, MLA_HEADS * (MLA_NOPE + MLA_ROPE)), MLA_Q_LORA),
        "mla_w_ukv": w(ks[11], (L, MLA_KV_LORA, MLA_HEADS * (MLA_NOPE + MLA_V)), MLA_KV_LORA),
        "gqa_q_norm_g": gain(ks[12], (L, GQA_HEAD_DIM)),
        "gqa_k_norm_g": gain(ks[13], (L, GQA_HEAD_DIM)),
        "w_br_na": w(ks[14], (L, NA_HEADS * NA_HEAD_DIM, D), NA_HEADS * NA_HEAD_DIM),
        "w_br_mla": w(ks[15], (L, MLA_HEADS * MLA_V, D), MLA_HEADS * MLA_V),
        "w_br_gqa": w(ks[16], (L, GQA_HEADS * GQA_HEAD_DIM, D), GQA_HEADS * GQA_HEAD_DIM),
        "w_out": w(ks[17], (L, D, D), D),
        "ffn_w_gate_up": w(ks[18], (L, D, 2 * FFN_HIDDEN), D),
        "ffn_w_down": w(ks[19], (L, FFN_HIDDEN, D), FFN_HIDDEN),
        "final_norm_g": gain(ks[20], (D,)),
    }


def reference(x, c, ada_w, ada_b, norm_mix_g, norm_ffn_g, w_in, na_rpb, mla_q_norm_g, mla_kv_norm_g,
              mla_w_uq, mla_w_ukv, gqa_q_norm_g, gqa_k_norm_g, w_br_na, w_br_mla, w_br_gqa, w_out,
              ffn_w_gate_up, ffn_w_down, final_norm_g):
    S = x.shape[1]
    t = jnp.arange(S, dtype=jnp.int32)
    pos_t = t.astype(jnp.float32)
    pos_row = (t // GRID_W).astype(jnp.float32)
    pos_col = (t % GRID_W).astype(jnp.float32)
    for l in range(DEPTH):
        x = hybrid_layer(x, c, ada_w[l], ada_b[l], norm_mix_g[l], norm_ffn_g[l], w_in[l], na_rpb[l],
                         mla_q_norm_g[l], mla_kv_norm_g[l], mla_w_uq[l], mla_w_ukv[l],
                         gqa_q_norm_g[l], gqa_k_norm_g[l], w_br_na[l], w_br_mla[l], w_br_gqa[l], w_out[l],
                         ffn_w_gate_up[l], ffn_w_down[l], pos_t, pos_row, pos_col)
    return rms_norm(x, final_norm_g)
```

```cpp
#define SELFCHECK 0
#include <hip/hip_runtime.h>
#include <hip/hip_bf16.h>
#include <cstdio>
#include <cstdint>

__device__ __forceinline__ int opaque_v(int v) { asm volatile("" : "+v"(v)); return v; }
__device__ __forceinline__ int opaque_s(int v) { asm volatile("" : "+s"(v)); return v; }
namespace pg8 {
#define PG8_LAS __attribute__((address_space(3)))
typedef unsigned short bf16_t;
typedef short bf16x8 __attribute__((ext_vector_type(8)));
typedef float f32x4 __attribute__((ext_vector_type(4)));
typedef unsigned u32x4 __attribute__((ext_vector_type(4)));
constexpr int BM = 256, BK = 64, HALF = 128, HTB = HALF * BK * 2, STAGE_BYTES = 8 * HTB, NXCD = 8, WGM = 8;

__host__ __device__ __forceinline__ int lds_byte(int r, int c) { const int st = (r >> 4) * 2 + (c >> 5), rr = r & 15, cc = c & 31, ob = rr * 64 + cc * 2; return st * 1024 + (ob ^ (((ob >> 9) & 1) << 5)); }
__host__ __device__ __forceinline__ void stage_rc(int b, int& R, int& C) { const int st = b / 1024, sb = b % 1024, swz = sb ^ (((sb >> 9) & 1) << 5); R = (st >> 1) * 16 + swz / 64; C = (st & 1) * 32 + (swz % 64) / 2; }
__host__ __device__ __forceinline__ int perm32(int rho) { const int n = rho >> 4, i = rho & 15; return 8 * (i >> 2) + 4 * n + (i & 3); }

struct Unit { int pm, pn; };
struct Gemm { const bf16_t* A; const bf16_t* Bt; int M, N, K, lda, ldb; };

struct StaticOrder {
    int nM, nN, nwg, G, c;
    __host__ __device__ void init(int M, int N, int G_, int c_) { nM = M / BM; nN = N / BM; nwg = nM * nN; G = G_; c = c_; }
    __host__ __device__ bool next(int i, Unit& u) const {
        const long L = (long)i * G + c; if (L >= nwg) return false;
        int wgid = (int)L; { const int q = nwg / NXCD, r = nwg % NXCD, xcd = wgid % NXCD, off = wgid / NXCD; wgid = (xcd < r ? xcd * (q + 1) : r * (q + 1) + (xcd - r) * q) + off; }
        const int nig = WGM * nN, gid = wgid / nig, fm = gid * WGM, gsz = (nM - fm) < WGM ? (nM - fm) : WGM;
        u.pm = fm + ((wgid % nig) % gsz); u.pn = (wgid % nig) / gsz; return true;
    }
    __device__ __forceinline__ void a_ready(const Unit&) const {}
    __device__ __forceinline__ void done(const Unit&) const {}
};

typedef float f32x2_t __attribute__((ext_vector_type(2))); typedef __bf16 bf16x2_t __attribute__((ext_vector_type(2)));
__device__ __forceinline__ unsigned cvt_pk_bf16(float lo, float hi) { f32x2_t v = {lo, hi}; bf16x2_t b = __builtin_convertvector(v, bf16x2_t); return __builtin_bit_cast(unsigned, b); }
__device__ __forceinline__ float bf_lo(unsigned w) { return __uint_as_float(w << 16); }
__device__ __forceinline__ float bf_hi(unsigned w) { return __uint_as_float(w & 0xffff0000u); }
__device__ __forceinline__ float sigmoidf_(float v) { return __builtin_amdgcn_rcpf(1.0f + __builtin_amdgcn_exp2f(-1.4426950408889634f * v)); }

template <int ACT  > struct EpiBf16 {
    static constexpr bool PERM = true, AFTER_DRAIN = false;
    bf16_t* O; int ldc;
    __device__ __forceinline__ void operator()(const f32x4 (&acc)[2][2][4][2], const Unit& u, int wr, int wc, int fr, int fq) const {
        const int row0 = u.pm * BM + wr * 64 + fr, col0 = u.pn * BM + wc * 32 + 8 * fq;
#pragma unroll
        for (int ai = 0; ai < 2; ++ai)
#pragma unroll
            for (int m = 0; m < 4; ++m) { bf16_t* rowp = O + (size_t)(row0 + ai * HALF + m * 16) * ldc + col0;
#pragma unroll
                for (int bj = 0; bj < 2; ++bj) { f32x4 v0 = acc[ai][bj][m][0], v1 = acc[ai][bj][m][1];
                    if (ACT == 1) {
#pragma unroll
                        for (int e = 0; e < 4; ++e) { v0[e] = sigmoidf_(v0[e]); v1[e] = sigmoidf_(v1[e]); } }
                    u32x4 w; w.x = cvt_pk_bf16(v0[0], v0[1]); w.y = cvt_pk_bf16(v0[2], v0[3]); w.z = cvt_pk_bf16(v1[0], v1[1]); w.w = cvt_pk_bf16(v1[2], v1[3]);
                    *(u32x4*)(rowp + bj * HALF) = w; } }
    }
};
struct EpiGateAcc {
    static constexpr bool PERM = true, AFTER_DRAIN = false;
    bf16_t* O; int ldc; const bf16_t* G; int ldg; int goff; int first;
    __device__ __forceinline__ void operator()(const f32x4 (&acc)[2][2][4][2], const Unit& u, int wr, int wc, int fr, int fq) const {
        const int row0 = u.pm * BM + wr * 64 + fr, col0 = u.pn * BM + wc * 32 + 8 * fq;
#pragma unroll
        for (int ai = 0; ai < 2; ++ai)
#pragma unroll
            for (int m = 0; m < 4; ++m) { const size_t r = (size_t)(row0 + ai * HALF + m * 16); bf16_t* rowp = O + r * ldc + col0; const bf16_t* gp = G + r * ldg + goff + col0;
#pragma unroll
                for (int bj = 0; bj < 2; ++bj) { const f32x4 v0 = acc[ai][bj][m][0], v1 = acc[ai][bj][m][1];
                    const u32x4 g = *(const u32x4*)(gp + bj * HALF);
                    float o[8];
                    o[0] = bf_lo(g.x) * v0[0]; o[1] = bf_hi(g.x) * v0[1]; o[2] = bf_lo(g.y) * v0[2]; o[3] = bf_hi(g.y) * v0[3];
                    o[4] = bf_lo(g.z) * v1[0]; o[5] = bf_hi(g.z) * v1[1]; o[6] = bf_lo(g.w) * v1[2]; o[7] = bf_hi(g.w) * v1[3];
                    if (!first) { const u32x4 p = *(const u32x4*)(rowp + bj * HALF);
                        o[0] += bf_lo(p.x); o[1] += bf_hi(p.x); o[2] += bf_lo(p.y); o[3] += bf_hi(p.y); o[4] += bf_lo(p.z); o[5] += bf_hi(p.z); o[6] += bf_lo(p.w); o[7] += bf_hi(p.w); }
                    u32x4 w; w.x = cvt_pk_bf16(o[0], o[1]); w.y = cvt_pk_bf16(o[2], o[3]); w.z = cvt_pk_bf16(o[4], o[5]); w.w = cvt_pk_bf16(o[6], o[7]);
                    *(u32x4*)(rowp + bj * HALF) = w; } }
    }
};
struct EpiSwiGLU {
    static constexpr bool PERM = true, AFTER_DRAIN = false;
    bf16_t* O; int ldc;
    __device__ __forceinline__ void operator()(const f32x4 (&acc)[2][2][4][2], const Unit& u, int wr, int wc, int fr, int fq) const {
        const int row0 = u.pm * BM + wr * 64 + fr, col0 = u.pn * HALF + wc * 32 + 8 * fq;
#pragma unroll
        for (int ai = 0; ai < 2; ++ai)
#pragma unroll
            for (int m = 0; m < 4; ++m) { bf16_t* rowp = O + (size_t)(row0 + ai * HALF + m * 16) * ldc + col0;
                float o[8];
#pragma unroll
                for (int n = 0; n < 2; ++n)
#pragma unroll
                    for (int e = 0; e < 4; ++e) { const float g = acc[ai][0][m][n][e], up = acc[ai][1][m][n][e]; o[n * 4 + e] = g * sigmoidf_(g) * up; }
                u32x4 w; w.x = cvt_pk_bf16(o[0], o[1]); w.y = cvt_pk_bf16(o[2], o[3]); w.z = cvt_pk_bf16(o[4], o[5]); w.w = cvt_pk_bf16(o[6], o[7]);
                *(u32x4*)rowp = w; }
    }
};
struct EpiResidual {
    static constexpr bool PERM = false, AFTER_DRAIN = false;
    const float* xin; float* xout; int ldc; const float* gvec; int gstride; int rows_per_batch;
    __device__ __forceinline__ void operator()(const f32x4 (&acc)[2][2][4][2], const Unit& u, int wr, int wc, int fr, int fq) const {
        const int row0 = u.pm * BM + wr * 64 + fr, col0 = u.pn * BM + wc * 32 + 4 * fq;
        const int b = (u.pm * BM) / rows_per_batch;
        f32x4 gv[2][2];
#pragma unroll
        for (int bj = 0; bj < 2; ++bj)
#pragma unroll
            for (int n = 0; n < 2; ++n) gv[bj][n] = *(const f32x4*)(gvec + (size_t)b * gstride + col0 + bj * HALF + n * 16);
#pragma unroll
        for (int ai = 0; ai < 2; ++ai)
#pragma unroll
            for (int m = 0; m < 4; ++m) { const size_t off = (size_t)(row0 + ai * HALF + m * 16) * ldc + col0;
#pragma unroll
                for (int bj = 0; bj < 2; ++bj)
#pragma unroll
                    for (int n = 0; n < 2; ++n) { const f32x4 xi = *(const f32x4*)(xin + off + bj * HALF + n * 16);
                        *(f32x4*)(xout + off + bj * HALF + n * 16) = xi + gv[bj][n] * acc[ai][bj][m][n]; } }
    }
};

template <class Epi, class Sched, bool ALIGN_EPI = false, bool SP2 = false>
__device__ __forceinline__ void gemm_phase(PG8_LAS unsigned char* lds, const Gemm g, const Sched& S, const Epi& E) {
    const int tid = opaque_v(threadIdx.x), wid = __builtin_amdgcn_readfirstlane(tid >> 6), lane = tid & 63, wr = wid >> 2, wc = wid & 3, fr = lane & 15, fq = lane >> 4;
    const int K = g.K, nt = K / BK;
    unsigned voffA[2], voffB[2];
#pragma unroll
    for (int i = 0; i < 2; ++i) { int R, C; stage_rc(tid * 16 + i * 8192, R, C); const int Rb = Epi::PERM ? ((R & ~31) + perm32(R & 31)) : R;
        voffA[i] = (unsigned)(R * g.lda + C) * 2u; voffB[i] = (unsigned)(Rb * g.ldb + C) * 2u; }
    const size_t kstep = (size_t)(BK * 2);
    const size_t hstepA = (size_t)HALF * g.lda * 2, hstepB = (size_t)HALF * g.ldb * 2;
    const size_t tstepA = 2 * hstepA, tstepB = 2 * hstepB;
    const unsigned ldsw = (unsigned)wid * 1024u;
    const int aoff = lds_byte(wr * 64 + fr, fq * 8), boff = lds_byte(wc * 32 + fr, fq * 8);
#define PG8_SA(b, h) (((b) * 2 + (h)) * HTB)
#define PG8_SB(b, h) ((4 + (b) * 2 + (h)) * HTB)
#define PG8_STAGE(bufoff, gbase, voff) do { _Pragma("unroll") for (int _i = 0; _i < 2; ++_i) \
        __builtin_amdgcn_global_load_lds((const unsigned*)((const char*)(gbase) + (voff)[_i]), (PG8_LAS unsigned*)(lds + (bufoff) + ldsw + _i * 8192), 16, 0, 0); } while (0)
#define PG8_LDA(dst, b, h) do { _Pragma("unroll") for (int m = 0; m < 4; ++m) _Pragma("unroll") for (int k = 0; k < 2; ++k) dst[m][k] = *(const PG8_LAS bf16x8*)(lds + PG8_SA(b, h) + aoff + m * 2048 + k * 1024); } while (0)
#define PG8_LDB(dst, b, h) do { _Pragma("unroll") for (int n = 0; n < 2; ++n) _Pragma("unroll") for (int k = 0; k < 2; ++k) dst[n][k] = *(const PG8_LAS bf16x8*)(lds + PG8_SB(b, h) + boff + n * 2048 + k * 1024); } while (0)
#define PG8_MMA(ai, bj, At, Bt) do { __builtin_amdgcn_s_setprio(1); _Pragma("unroll") for (int m = 0; m < 4; ++m) _Pragma("unroll") for (int n = 0; n < 2; ++n) _Pragma("unroll") for (int k = 0; k < 2; ++k) \
        acc[ai][bj][m][n] = __builtin_amdgcn_mfma_f32_16x16x32_bf16(Bt[n][k], At[m][k], acc[ai][bj][m][n], 0, 0, 0); __builtin_amdgcn_s_setprio(0); } while (0)
#define PG8_WAIT_V(n) asm volatile("s_waitcnt vmcnt(" #n ")" ::: "memory")
#define PG8_WAIT_L(n) asm volatile("s_waitcnt lgkmcnt(" #n ")" ::: "memory")
#define PG8_BAR __builtin_amdgcn_s_barrier()
#define PG8_SCHED __builtin_amdgcn_sched_barrier(0)
    Unit cur, nxt; int ui = 0;
    if (!S.next(0, cur)) return;
    f32x4 acc[2][2][4][2];
#pragma unroll
    for (int a = 0; a < 2; ++a)
#pragma unroll
        for (int b = 0; b < 2; ++b)
#pragma unroll
            for (int m = 0; m < 4; ++m)
#pragma unroll
                for (int n = 0; n < 2; ++n) acc[a][b][m][n] = (f32x4){0.f, 0.f, 0.f, 0.f};
    bf16x8 At[4][2], B0[2][2], B1[2][2];
    const char* cA = (const char*)g.A + (size_t)cur.pm * tstepA; const char* cB = (const char*)g.Bt + (size_t)cur.pn * tstepB;
    S.a_ready(cur);
    if constexpr (SP2) {
        PG8_STAGE(PG8_SB(0, 0), cB, voffB); PG8_STAGE(PG8_SB(0, 1), cB + hstepB, voffB); PG8_STAGE(PG8_SA(0, 0), cA, voffA); PG8_STAGE(PG8_SA(0, 1), cA + hstepA, voffA);
        if (wr == 1) PG8_BAR;
        PG8_WAIT_V(2); PG8_BAR;
        PG8_STAGE(PG8_SB(1, 0), cB + kstep, voffB); PG8_STAGE(PG8_SA(1, 0), cA + kstep, voffA); PG8_STAGE(PG8_SB(1, 1), cB + hstepB + kstep, voffB);
        PG8_WAIT_V(6); PG8_BAR;
    } else {
        PG8_STAGE(PG8_SB(0, 0), cB, voffB); PG8_STAGE(PG8_SA(0, 0), cA, voffA); PG8_STAGE(PG8_SB(0, 1), cB + hstepB, voffB); PG8_STAGE(PG8_SA(0, 1), cA + hstepA, voffA);
        if (wr == 1) PG8_BAR;
        PG8_WAIT_V(4); PG8_BAR;
        PG8_STAGE(PG8_SB(1, 0), cB + kstep, voffB); PG8_STAGE(PG8_SA(1, 0), cA + kstep, voffA); PG8_STAGE(PG8_SB(1, 1), cB + hstepB + kstep, voffB);
        PG8_WAIT_V(6); PG8_BAR;
    }
    for (;;) {
        const bool has_next = S.next(ui + 1, nxt);
        const char* nA = has_next ? (const char*)g.A + (size_t)nxt.pm * tstepA : cA; const char* nB = has_next ? (const char*)g.Bt + (size_t)nxt.pn * tstepB : cB;
#pragma unroll 1
        for (int t = 0; t < nt; t += 2) {
            const bool last = (t == nt - 2);
            const char* a1 = cA + (size_t)(t + 1) * kstep;
            const char* a2 = last ? nA : cA + (size_t)(t + 2) * kstep; const char* b2 = last ? nB : cB + (size_t)(t + 2) * kstep;
            const char* a3 = a2 + kstep; const char* b3 = b2 + kstep;
            if (last && has_next) S.a_ready(nxt);
            if constexpr (SP2) {
            PG8_LDB(B0, 0, 0); PG8_LDB(B1, 0, 1); PG8_SCHED; PG8_LDA(At, 0, 0); PG8_STAGE(PG8_SA(1, 1), a1 + hstepA, voffA);
            PG8_WAIT_V(8); PG8_WAIT_L(0); PG8_BAR; PG8_MMA(0, 0, At, B0); PG8_MMA(0, 1, At, B1); PG8_BAR; PG8_SCHED;
            PG8_LDA(At, 0, 1); PG8_STAGE(PG8_SB(0, 0), b2, voffB); PG8_STAGE(PG8_SB(0, 1), b2 + hstepB, voffB); PG8_STAGE(PG8_SA(0, 0), a2, voffA);
            PG8_WAIT_V(8); PG8_WAIT_L(0); PG8_BAR; PG8_MMA(1, 0, At, B0); PG8_MMA(1, 1, At, B1); PG8_BAR; PG8_SCHED;
            PG8_LDB(B0, 1, 0); PG8_LDB(B1, 1, 1); PG8_SCHED; PG8_LDA(At, 1, 0); PG8_STAGE(PG8_SA(0, 1), a2 + hstepA, voffA);
            PG8_WAIT_V(8); PG8_WAIT_L(0); PG8_BAR; PG8_MMA(0, 0, At, B0); PG8_MMA(0, 1, At, B1); PG8_BAR; PG8_SCHED;
            PG8_LDA(At, 1, 1); PG8_STAGE(PG8_SB(1, 0), b3, voffB); PG8_STAGE(PG8_SB(1, 1), b3 + hstepB, voffB); PG8_STAGE(PG8_SA(1, 0), a3, voffA);
            PG8_WAIT_V(8); PG8_WAIT_L(0); PG8_BAR; PG8_MMA(1, 0, At, B0); PG8_MMA(1, 1, At, B1); PG8_BAR; PG8_SCHED;
            } else {
            PG8_LDB(B0, 0, 0); PG8_SCHED; PG8_LDA(At, 0, 0); PG8_STAGE(PG8_SA(1, 1), a1 + hstepA, voffA);
            PG8_WAIT_L(8); PG8_BAR; PG8_WAIT_L(0); PG8_MMA(0, 0, At, B0); PG8_BAR; PG8_SCHED;
            PG8_LDB(B1, 0, 1); PG8_STAGE(PG8_SB(0, 0), b2, voffB);
            PG8_BAR; PG8_WAIT_L(0); PG8_MMA(0, 1, At, B1); PG8_BAR;
            PG8_LDA(At, 0, 1); PG8_STAGE(PG8_SA(0, 0), a2, voffA);
            PG8_BAR; PG8_WAIT_L(0); PG8_MMA(1, 0, At, B0); PG8_BAR; PG8_SCHED;
            PG8_STAGE(PG8_SB(0, 1), b2 + hstepB, voffB);
            PG8_WAIT_V(6); PG8_BAR; PG8_MMA(1, 1, At, B1); PG8_BAR;
            PG8_LDB(B0, 1, 0); PG8_SCHED; PG8_LDA(At, 1, 0); PG8_STAGE(PG8_SA(0, 1), a2 + hstepA, voffA);
            PG8_WAIT_L(8); PG8_BAR; PG8_WAIT_L(0); PG8_MMA(0, 0, At, B0); PG8_BAR; PG8_SCHED;
            PG8_LDB(B1, 1, 1); PG8_STAGE(PG8_SB(1, 0), b3, voffB);
            PG8_BAR; PG8_WAIT_L(0); PG8_MMA(0, 1, At, B1); PG8_BAR;
            PG8_LDA(At, 1, 1); PG8_STAGE(PG8_SA(1, 0), a3, voffA);
            PG8_BAR; PG8_WAIT_L(0); PG8_MMA(1, 0, At, B0); PG8_BAR; PG8_SCHED;
            PG8_STAGE(PG8_SB(1, 1), b3 + hstepB, voffB);
            PG8_WAIT_V(6); PG8_BAR; PG8_MMA(1, 1, At, B1); PG8_BAR;
            }
        }
        if constexpr (ALIGN_EPI) { if (wr == 0) PG8_BAR; }
        if constexpr (!Epi::AFTER_DRAIN) { E(acc, cur, wr, wc, fr, fq); S.done(cur); }
        if (!has_next) break;
#pragma unroll
        for (int a = 0; a < 2; ++a)
#pragma unroll
            for (int b = 0; b < 2; ++b)
#pragma unroll
                for (int m = 0; m < 4; ++m)
#pragma unroll
                    for (int n = 0; n < 2; ++n) acc[a][b][m][n] = (f32x4){0.f, 0.f, 0.f, 0.f};
        cur = nxt; cA = nA; cB = nB; ++ui;
        if constexpr (ALIGN_EPI) { if (wr == 1) PG8_BAR; }
    }
    PG8_WAIT_V(0);
    if constexpr (!ALIGN_EPI) { if (wr == 0) PG8_BAR; }
    PG8_BAR;
#undef PG8_SA
#undef PG8_SB
#undef PG8_STAGE
#undef PG8_LDA
#undef PG8_LDB
#undef PG8_MMA
#undef PG8_WAIT_V
#undef PG8_WAIT_L
#undef PG8_BAR
#undef PG8_SCHED
}
}

namespace att {
using bf16x8 = __attribute__((ext_vector_type(8))) short;
using s16x4  = __attribute__((ext_vector_type(4))) short;
using f32x16 = __attribute__((ext_vector_type(16))) float;
using f32x4  = __attribute__((ext_vector_type(4))) float;
using u32x4  = __attribute__((ext_vector_type(4))) unsigned;
typedef unsigned short bf16_t;
constexpr int NW = 8, QBLK = 32, KVBLK = 64;
constexpr int SHM_V = 8192, SHM_KN = 8192, SHM_KR = 4096;
constexpr int OFF_V = 0, OFF_KN = 2 * SHM_V, OFF_KR = OFF_KN + 2 * SHM_KN, OFF_WS = OFF_KR + 2 * SHM_KR, LDS_BYTES = OFF_WS + NW * 64 * 4;
#define ATT_SBAR() __builtin_amdgcn_sched_barrier(0)
__device__ __forceinline__ int crow(int r, int hi) { return (r & 3) + 8 * (r >> 2) + 4 * hi; }
__device__ __forceinline__ unsigned cvtpk(float lo, float hi) { return pg8::cvt_pk_bf16(lo, hi); }
__device__ __forceinline__ float bf2f(short s) { return __uint_as_float(((unsigned)(unsigned short)s) << 16); }
__device__ __forceinline__ int kn_off(int row, int chunk) { return row * 128 + ((chunk ^ ((row >> 1) & 7)) << 4); }
__device__ __forceinline__ int kr_off(int row, int chunk) { return row * 64 + ((chunk ^ ((row >> 2) & 3)) << 4); }
__device__ __forceinline__ int v_st(int k, int c) { const int kk = (k & ~0xC) | ((k & 4) << 1) | ((k & 8) >> 1); return ((kk >> 3) * 2 + (c >> 5)) * 512 + ((kk & 7) * 32 + (c & 31)) * 2; }
__device__ __forceinline__ int v_rd_base(int lane) { return ((lane & 3) << 3) | (((lane >> 2) & 3) << 6) | (((lane >> 4) & 1) << 5) | (((lane >> 5) & 1) << 8); }
constexpr int v_rd_off(int d0, int ks, int half) { return d0 * 512 + ks * 2048 + half * 1024; }
template <int OFF> __device__ __forceinline__ s16x4 tr_read(int vb) { s16x4 r; asm volatile("ds_read_b64_tr_b16 %0, %1 offset:%2" : "=&v"(r) : "v"(vb), "i"(OFF) : "memory"); return r; }

template <int D0> __device__ __forceinline__ void pv_one(f32x16& od, int vb, bf16x8 pa0, bf16x8 pa1, bf16x8 pa2, bf16x8 pa3) {
  const s16x4 l0 = tr_read<v_rd_off(D0, 0, 0)>(vb), h0 = tr_read<v_rd_off(D0, 0, 1)>(vb), l1 = tr_read<v_rd_off(D0, 1, 0)>(vb), h1 = tr_read<v_rd_off(D0, 1, 1)>(vb);
  const s16x4 l2 = tr_read<v_rd_off(D0, 2, 0)>(vb), h2 = tr_read<v_rd_off(D0, 2, 1)>(vb), l3 = tr_read<v_rd_off(D0, 3, 0)>(vb), h3 = tr_read<v_rd_off(D0, 3, 1)>(vb);
  asm volatile("s_waitcnt lgkmcnt(0)" ::: "memory"); ATT_SBAR();
#define ATT_PK(L, H) (bf16x8){L[0], L[1], L[2], L[3], H[0], H[1], H[2], H[3]}
  od = __builtin_amdgcn_mfma_f32_32x32x16_bf16(pa0, ATT_PK(l0, h0), od, 0, 0, 0);
  od = __builtin_amdgcn_mfma_f32_32x32x16_bf16(pa1, ATT_PK(l1, h1), od, 0, 0, 0);
  od = __builtin_amdgcn_mfma_f32_32x32x16_bf16(pa2, ATT_PK(l2, h2), od, 0, 0, 0);
  od = __builtin_amdgcn_mfma_f32_32x32x16_bf16(pa3, ATT_PK(l3, h3), od, 0, 0, 0);
#undef ATT_PK
}

template <int DKR> struct Cst { static constexpr float SCALE = DKR ? 0.10206207261596577f : 0.125f; static constexpr float C = SCALE * 1.4426950408889634f; };

template <int DKR> __device__ __forceinline__ void partialSM(f32x16& p0, f32x16& p1, float& m_reg, float& alpha) {
  constexpr float C = Cst<DKR>::C;
  float pmax = p0[0];
#pragma unroll
  for (int r = 1; r < 16; ++r) pmax = fmaxf(pmax, p0[r]);
#pragma unroll
  for (int r = 0; r < 16; ++r) pmax = fmaxf(pmax, p1[r]);
  { auto rr = __builtin_amdgcn_permlane32_swap(__float_as_uint(pmax), __float_as_uint(pmax), false, false);
    pmax = fmaxf(__uint_as_float(rr[0]), __uint_as_float(rr[1])); }
  float mn;
  if (__builtin_expect(__all(pmax <= m_reg), 1)) { mn = m_reg; alpha = 1.f; }
  else { mn = fmaxf(m_reg, pmax); alpha = __builtin_amdgcn_exp2f((m_reg - mn) * C); m_reg = mn; }
  const float mnC = -mn * C;
#pragma unroll
  for (int r = 0; r < 16; ++r) p0[r] = fmaf(p0[r], C, mnC);
#pragma unroll
  for (int r = 0; r < 16; ++r) p1[r] = fmaf(p1[r], C, mnC);
#pragma unroll
  for (int r = 0; r < 16; ++r) p0[r] = __builtin_amdgcn_exp2f(p0[r]);
}
__device__ __forceinline__ void finishSM(f32x16& p0, f32x16& p1, float alpha, float& l_reg, bf16x8& pa0, bf16x8& pa1, bf16x8& pa2, bf16x8& pa3) {
#pragma unroll
  for (int r = 0; r < 16; ++r) p1[r] = __builtin_amdgcn_exp2f(p1[r]);
  float ps = 0;
#pragma unroll
  for (int r = 0; r < 16; ++r) ps += p0[r];
#pragma unroll
  for (int r = 0; r < 16; ++r) ps += p1[r];
  { auto rr = __builtin_amdgcn_permlane32_swap(__float_as_uint(ps), __float_as_uint(ps), false, false);
    ps = __uint_as_float(rr[0]) + __uint_as_float(rr[1]); }
  l_reg = l_reg * alpha + ps;
#define ATT_PK4(P, BASE, OUT) do { unsigned a0 = cvtpk(P[BASE + 0], P[BASE + 1]), a1 = cvtpk(P[BASE + 2], P[BASE + 3]);   \
    unsigned b0 = cvtpk(P[BASE + 4], P[BASE + 5]), b1 = cvtpk(P[BASE + 6], P[BASE + 7]);                              \
    auto r0 = __builtin_amdgcn_permlane32_swap(a0, b0, false, false); auto r1 = __builtin_amdgcn_permlane32_swap(a1, b1, false, false); \
    u32x4 w = {r0[0], r1[0], r0[1], r1[1]}; OUT = *reinterpret_cast<bf16x8*>(&w); } while (0)
  ATT_PK4(p0, 0, pa0); ATT_PK4(p0, 8, pa1); ATT_PK4(p1, 0, pa2); ATT_PK4(p1, 8, pa3);
#undef ATT_PK4
}
template <int DKR> __device__ __forceinline__ void qkt(f32x16& p0, f32x16& p1, const char* Kn, const char* Kr, const bf16x8* qr, int r32, int hi) {
  p0 = f32x16{}; p1 = f32x16{};
#pragma unroll
  for (int d0 = 0; d0 < 4; ++d0) {
    const bf16x8 b0 = *reinterpret_cast<const bf16x8*>(Kn + kn_off(r32, d0 * 2 + hi));
    const bf16x8 b1 = *reinterpret_cast<const bf16x8*>(Kn + kn_off(32 + r32, d0 * 2 + hi));
    p0 = __builtin_amdgcn_mfma_f32_32x32x16_bf16(b0, qr[d0], p0, 0, 0, 0);
    p1 = __builtin_amdgcn_mfma_f32_32x32x16_bf16(b1, qr[d0], p1, 0, 0, 0); }
  if constexpr (DKR != 0) {
#pragma unroll
    for (int d0 = 0; d0 < 2; ++d0) {
      const bf16x8 b0 = *reinterpret_cast<const bf16x8*>(Kr + kr_off(r32, d0 * 2 + hi));
      const bf16x8 b1 = *reinterpret_cast<const bf16x8*>(Kr + kr_off(32 + r32, d0 * 2 + hi));
      p0 = __builtin_amdgcn_mfma_f32_32x32x16_bf16(b0, qr[4 + d0], p0, 0, 0, 0);
      p1 = __builtin_amdgcn_mfma_f32_32x32x16_bf16(b1, qr[4 + d0], p1, 0, 0, 0); }
  }
}

template <int DKR>
__device__ __forceinline__ void attn_unit(const bf16_t* __restrict__ Qb, int ldq, const bf16_t* __restrict__ Kn, int ldk, const bf16_t* __restrict__ Kr, int ldkr,
                                          const bf16_t* __restrict__ Vh, int ldv, bf16_t* __restrict__ Ob, int ldo, int seq, const float* __restrict__ qtab, char* lds) {
  const int tid = opaque_v(threadIdx.x), wid = tid >> 6, lane = tid & 63, r32 = lane & 31, hi = lane >> 5;
  char* V_lds = lds + OFF_V; char* KN_lds = lds + OFF_KN; char* KR_lds = lds + OFF_KR;
  float* ws = (float*)(lds + OFF_WS) + wid * 64; float* li_l = ws; float* al_l = ws + 32;
  float m_reg = -1e30f, l_reg = 0; f32x16 o[2] = {}; bf16x8 qr[DKR ? 6 : 4];
  const bf16_t* Qw = Qb + (long)(wid * QBLK + r32) * ldq + hi * 8;
#pragma unroll
  for (int d0 = 0; d0 < 4; ++d0) qr[d0] = *reinterpret_cast<const bf16x8*>(Qw + d0 * 16);
  if constexpr (DKR != 0) {
    const bf16x8 x1 = *reinterpret_cast<const bf16x8*>(Qw + 64), x2 = *reinterpret_cast<const bf16x8*>(Qw + 80);
    const float* tb = qtab + (long)(wid * QBLK + r32) * 32 + hi * 8;
    const f32x4 c0 = *(const f32x4*)(tb), c1 = *(const f32x4*)(tb + 4), s0 = *(const f32x4*)(tb + 16), s1 = *(const f32x4*)(tb + 20);
    float y1[8], y2[8];
#pragma unroll
    for (int j = 0; j < 8; ++j) { const float a = bf2f(x1[j]), b = bf2f(x2[j]); const float cc = j < 4 ? c0[j & 3] : c1[j & 3], ss = j < 4 ? s0[j & 3] : s1[j & 3];
      y1[j] = a * cc - b * ss; y2[j] = b * cc + a * ss; }
    u32x4 w1 = {cvtpk(y1[0], y1[1]), cvtpk(y1[2], y1[3]), cvtpk(y1[4], y1[5]), cvtpk(y1[6], y1[7])};
    u32x4 w2 = {cvtpk(y2[0], y2[1]), cvtpk(y2[2], y2[3]), cvtpk(y2[4], y2[5]), cvtpk(y2[6], y2[7])};
    qr[4] = *reinterpret_cast<bf16x8*>(&w1); qr[5] = *reinterpret_cast<bf16x8*>(&w2);
  }
  const int sr = tid >> 3, sc8 = tid & 7, knst = kn_off(sr, sc8), vst = v_st(sr, sc8 * 8);
  const int rr_ = (tid >> 2) & 63, rc_ = tid & 3, krst = kr_off(rr_, rc_);
  const bool do_kr = (DKR != 0) && (tid < 256);
  const int vb0 = (int)(uintptr_t)V_lds + v_rd_base(lane);
  bf16x8 sK0, sV0, sR0, sK1, sV1, sR1;
  sR0 = bf16x8{}; sR1 = bf16x8{};
#define ATT_SLOAD(SK, SV, SR, k0) do { SK = *reinterpret_cast<const bf16x8*>(Kn + (long)((k0) + sr) * ldk + sc8 * 8); SV = *reinterpret_cast<const bf16x8*>(Vh + (long)((k0) + sr) * ldv + sc8 * 8); \
    if (do_kr) SR = *reinterpret_cast<const bf16x8*>(Kr + (long)((k0) + rr_) * ldkr + rc_ * 8); } while (0)
#define ATT_SWRITE(b, SK, SV, SR) do { *(bf16x8*)(V_lds + (b) * SHM_V + vst) = SV; *(bf16x8*)(KN_lds + (b) * SHM_KN + knst) = SK; \
    if (do_kr) *(bf16x8*)(KR_lds + (b) * SHM_KR + krst) = SR; } while (0)
#define ATT_RESC(a) do { if (__any((a) < 1.f)) { if (hi == 0) al_l[r32] = (a); asm volatile("s_waitcnt lgkmcnt(0)" ::: "memory"); \
    _Pragma("unroll") for (int d = 0; d < 2; ++d) _Pragma("unroll") for (int r = 0; r < 16; ++r) o[d][r] *= al_l[crow(r, hi)]; } } while (0)
  f32x16 pA0, pA1, pB0, pB1; float alA, alB; bf16x8 pa0, pa1, pa2, pa3; const int NT = seq / KVBLK;
  ATT_SLOAD(sK0, sV0, sR0, 0); ATT_SWRITE(0, sK0, sV0, sR0); __syncthreads();
  qkt<DKR>(pA0, pA1, KN_lds, KR_lds, qr, r32, hi); partialSM<DKR>(pA0, pA1, m_reg, alA);
  ATT_SLOAD(sK1, sV1, sR1, KVBLK); if (2 < NT) ATT_SLOAD(sK0, sV0, sR0, 2 * KVBLK);
  ATT_SWRITE(1, sK1, sV1, sR1); __syncthreads();
  for (int j = 1; j + 1 < NT; j += 2) {
    ATT_SBAR(); qkt<DKR>(pB0, pB1, KN_lds + SHM_KN, KR_lds + SHM_KR, qr, r32, hi);
    finishSM(pA0, pA1, alA, l_reg, pa0, pa1, pa2, pa3); ATT_SBAR();
    ATT_SLOAD(sK1, sV1, sR1, (j + 2) * KVBLK); ATT_SBAR();
    pv_one<0>(o[0], vb0, pa0, pa1, pa2, pa3); pv_one<1>(o[1], vb0, pa0, pa1, pa2, pa3); partialSM<DKR>(pB0, pB1, m_reg, alB);
    __syncthreads(); ATT_SWRITE(0, sK0, sV0, sR0);
    ATT_RESC(alB); __syncthreads();
    ATT_SBAR(); qkt<DKR>(pA0, pA1, KN_lds, KR_lds, qr, r32, hi);
    finishSM(pB0, pB1, alB, l_reg, pa0, pa1, pa2, pa3); ATT_SBAR();
    if (j + 3 < NT) ATT_SLOAD(sK0, sV0, sR0, (j + 3) * KVBLK); ATT_SBAR();
    pv_one<0>(o[0], vb0 + SHM_V, pa0, pa1, pa2, pa3); pv_one<1>(o[1], vb0 + SHM_V, pa0, pa1, pa2, pa3); partialSM<DKR>(pA0, pA1, m_reg, alA);
    __syncthreads(); ATT_SWRITE(1, sK1, sV1, sR1);
    ATT_RESC(alA); __syncthreads();
  }
  ATT_SBAR(); qkt<DKR>(pB0, pB1, KN_lds + SHM_KN, KR_lds + SHM_KR, qr, r32, hi);
  finishSM(pA0, pA1, alA, l_reg, pa0, pa1, pa2, pa3); ATT_SBAR();
  pv_one<0>(o[0], vb0, pa0, pa1, pa2, pa3); pv_one<1>(o[1], vb0, pa0, pa1, pa2, pa3); partialSM<DKR>(pB0, pB1, m_reg, alB);
  __syncthreads(); ATT_RESC(alB);
  finishSM(pB0, pB1, alB, l_reg, pa0, pa1, pa2, pa3); ATT_SBAR();
  pv_one<0>(o[0], vb0 + SHM_V, pa0, pa1, pa2, pa3); pv_one<1>(o[1], vb0 + SHM_V, pa0, pa1, pa2, pa3);
  if (hi == 0) li_l[r32] = l_reg; asm volatile("s_waitcnt lgkmcnt(0)" ::: "memory");
  float rli[16];
#pragma unroll
  for (int r = 0; r < 16; ++r) rli[r] = __builtin_amdgcn_rcpf(li_l[crow(r, hi)]);
  bf16_t* Ow = Ob + (long)(wid * QBLK) * ldo;
#pragma unroll
  for (int r = 0; r < 16; ++r) { const int orow = crow(r, hi);
#pragma unroll
    for (int d0 = 0; d0 < 2; ++d0) { const float v = o[d0][r] * rli[r]; Ow[(long)orow * ldo + d0 * 32 + r32] = (bf16_t)(cvtpk(v, v) & 0xffffu); } }
  __syncthreads();
#undef ATT_SLOAD
#undef ATT_SWRITE
#undef ATT_RESC
}
#undef ATT_SBAR
}

constexpr int NWAVES = 8;
constexpr int BATCH = 8, SEQ = 2048, DM = 1024, DEPTH = 2, M = BATCH * SEQ;
constexpr int GRID_W = 64, NROWS = SEQ / GRID_W;
constexpr int IN_COLS = 5024, N1 = 2048  , NG = 3072, N1_USED = 1952;
constexpr int FFN = 2816, NMOD = 6;
constexpr float NORM_EPS = 1e-6f;
constexpr int C_QA = 0, C_KA = 256, C_VA = 512, C_CQ = 768, C_CKV = 1024, C_KR = 1152, C_QC = 1184, C_KC = 1696, C_VC = 1824;

constexpr size_t MiB = 1u << 20;
constexpr size_t WS_CTL = 0, CTL_ZERO_BYTES = 64 * 1024;
constexpr size_t WS_MOD = 1 * MiB;
constexpr size_t WS_TABT = WS_MOD + 512 * 1024;
constexpr size_t WS_TABA = WS_TABT + 256 * 1024;
constexpr size_t WS_W = 2 * MiB;
constexpr size_t W_1 = 0, W_G = W_1 + (size_t)N1 * DM * 2, W_2 = W_G + (size_t)NG * DM * 2, W_BNA = W_2 + (size_t)1024 * 384 * 2, W_BMLA = W_BNA + (size_t)1024 * 256 * 2,
                 W_BGQA = W_BMLA + (size_t)1024 * 256 * 2, W_OUT = W_BGQA + (size_t)1024 * 512 * 2, W_GU = W_OUT + (size_t)1024 * 1024 * 2, W_DN = W_GU + (size_t)2 * FFN * DM * 2,
                 LAYER_W_BYTES = W_DN + (size_t)DM * FFN * 2;
static_assert(LAYER_W_BYTES == 32768000, "weights per layer");
constexpr size_t WS_H = 66 * MiB;
constexpr size_t WS_P1 = 98 * MiB;
constexpr size_t WS_KPE = 162 * MiB;
constexpr size_t WS_QC = 163 * MiB;
constexpr size_t WS_KC = 179 * MiB;
constexpr size_t WS_P2 = 183 * MiB;
constexpr size_t WS_OCAT = 215 * MiB;
constexpr size_t WS_A2 = 215 * MiB;
constexpr size_t WS_GATES = 98 * MiB;
constexpr size_t WS_ACT = 98 * MiB;
constexpr size_t WS_END = 247 * MiB;
static_assert(WS_W + 2 * LAYER_W_BYTES <= WS_H && WS_GATES + (size_t)M * NG * 2 <= WS_OCAT && WS_ACT + (size_t)M * FFN * 2 <= WS_OCAT, "ws map");
constexpr int CW_BAR = 4096;

constexpr int RING_OFF = 0, RING_BYTES = 131072;
constexpr int LDSCTL_OFF = RING_BYTES, MISC_OFF = LDSCTL_OFF + 320;
constexpr int LDS_BYTES = 147456;

#define GAS __attribute__((address_space(1)))
#define LAS __attribute__((address_space(3)))
typedef unsigned short bf16;
typedef unsigned v4u __attribute__((ext_vector_type(4)));
typedef unsigned v2u __attribute__((ext_vector_type(2)));
typedef float f32x4 __attribute__((ext_vector_type(4)));
typedef short bf16x8 __attribute__((ext_vector_type(8)));
typedef GAS unsigned gu32;
#define RLX_AGENT __ATOMIC_RELAXED, __HIP_MEMORY_SCOPE_AGENT
#define LDS_WAIT() asm volatile("s_waitcnt lgkmcnt(0)" ::: "memory")
__device__ __forceinline__ unsigned f2bf(float f) { unsigned u = __builtin_bit_cast(unsigned, f); return (u + 0x7fffu + ((u >> 16) & 1u)) >> 16; }
__device__ __forceinline__ unsigned pk2(float lo, float hi) { return f2bf(lo) | (f2bf(hi) << 16); }
__device__ __forceinline__ float bflo(unsigned w) { return __uint_as_float(w << 16); }
__device__ __forceinline__ float bfhi(unsigned w) { return __uint_as_float(w & 0xffff0000u); }
__device__ __forceinline__ float bf1(bf16 s) { return __uint_as_float(((unsigned)s) << 16); }

#define XB_TMO      128
#define XB_XCNT(j)  (256  + 64 * (j))
#define XB_XSUB(j)  (1280 + 64 * (j))
#define XB_XGEN(j)  (2304 + 64 * (j))
#define XB_TOP      3328
#define XB_TOPGEN   3392
#define XCD_BAR_WORDS 3456
#define XB_SPIN_CAP (1u << 18)
__device__ __forceinline__ unsigned xb_ld(unsigned* p)              { return __hip_atomic_load(p, __ATOMIC_RELAXED, __HIP_MEMORY_SCOPE_AGENT); }
__device__ __forceinline__ unsigned xb_add(unsigned* p, unsigned v) { return __hip_atomic_fetch_add(p, v, __ATOMIC_RELAXED, __HIP_MEMORY_SCOPE_AGENT); }
__device__ __forceinline__ unsigned xb_xcc_id() { return (unsigned)__builtin_amdgcn_s_getreg((3 << 11) | 20) & 0xFu; }
#define XB_SPIN(cond, bar) do { unsigned _sp = 0; while (cond) { __builtin_amdgcn_s_sleep(1); \
    if ((++_sp & 255u) == 0u) { if (xb_ld(&(bar)[XB_TMO])) break; if (_sp > XB_SPIN_CAP) { atomicAdd(&(bar)[XB_TMO], 1u); break; } } } } while (0)
struct XcdBarrier { unsigned* bar; unsigned x; volatile LAS unsigned* st; };
__device__ __forceinline__ XcdBarrier xcd_barrier_post(unsigned* bar, volatile LAS unsigned* st) {
    XcdBarrier b; b.bar = bar; b.x = xb_xcc_id(); b.st = st;
    if (threadIdx.x == 0) (void)xb_add(&bar[XB_XCNT(b.x)], 1u);
    return b;
}
__device__ __forceinline__ void xcd_barrier_complete(unsigned* bar, unsigned x, unsigned& nloc, unsigned& nx) {
    const unsigned G = gridDim.x * gridDim.y * gridDim.z;
    unsigned sum, cnt, mine, sp = 0u;
    for (;;) {
        sum = 0u; cnt = 0u; mine = 0u;
#pragma unroll
        for (unsigned j = 0; j < 16; ++j) { const unsigned c = xb_ld(&bar[XB_XCNT(j)]); sum += c; cnt += (c > 0u) ? 1u : 0u; mine = (j == x) ? c : mine; }
        if (sum == G) break;
        __builtin_amdgcn_s_sleep(1);
        if ((++sp & 255u) == 0u) { if (xb_ld(&bar[XB_TMO])) break; if (sp > XB_SPIN_CAP) { atomicAdd(&bar[XB_TMO], 1u); break; } }
    }
    nloc = mine > 0u ? mine : 1u; nx = cnt > 0u ? cnt : 1u;
}
__device__ __forceinline__ void xcd_barrier(const XcdBarrier& b) {
    asm volatile("s_waitcnt vmcnt(0)" ::: "memory");
    __syncthreads();
    if (threadIdx.x == 0) {
        unsigned* bar = b.bar;
        __builtin_amdgcn_s_waitcnt(0);
        unsigned nloc = b.st[0], nx = b.st[1];
        if (nloc == 0u) { xcd_barrier_complete(bar, b.x, nloc, nx); b.st[0] = nloc; b.st[1] = nx; }
        const unsigned old = xb_add(&bar[XB_XSUB(b.x)], 1u);
        const unsigned gen = old / nloc;
        if (old + 1u == (gen + 1u) * nloc) {
            __builtin_amdgcn_fence(__ATOMIC_RELEASE, "agent");
            asm volatile("s_waitcnt vmcnt(0)" ::: "memory");
            const unsigned og = xb_add(&bar[XB_TOP], 1u);
            const unsigned tg = og / nx;
            if (og + 1u == (tg + 1u) * nx) xb_add(&bar[XB_TOPGEN], 1u);
            else XB_SPIN(xb_ld(&bar[XB_TOPGEN]) == tg, bar);
            __builtin_amdgcn_fence(__ATOMIC_ACQUIRE, "agent");
            xb_add(&bar[XB_XGEN(b.x)], 1u);
            asm volatile("s_waitcnt vmcnt(0)" ::: "memory");
        } else {
            XB_SPIN(xb_ld(&bar[XB_XGEN(b.x)]) == gen, bar);
            __builtin_amdgcn_fence(__ATOMIC_ACQUIRE, "agent");
            asm volatile("s_waitcnt vmcnt(0)" ::: "memory");
        }
    }
    __syncthreads();
}

struct Args { const float* in[21]; float* out; unsigned char* ws; int ph_lo, ph_hi; };
struct LayerW { bf16 *w1, *wg, *w2, *bna, *bmla, *bgqa, *wout, *wgu, *wdn; };
__device__ __forceinline__ LayerW layer_w(unsigned char* ws, int l) {
    unsigned char* b = ws + WS_W + (size_t)l * LAYER_W_BYTES; LayerW w;
    w.w1 = (bf16*)(b + W_1); w.wg = (bf16*)(b + W_G); w.w2 = (bf16*)(b + W_2); w.bna = (bf16*)(b + W_BNA); w.bmla = (bf16*)(b + W_BMLA); w.bgqa = (bf16*)(b + W_BGQA);
    w.wout = (bf16*)(b + W_OUT); w.wgu = (bf16*)(b + W_GU); w.wdn = (bf16*)(b + W_DN); return w;
}
__device__ __forceinline__ float wave_sum(float v) {
#pragma unroll
    for (int o = 1; o < 64; o <<= 1) v += __shfl_xor(v, o);
    return v;
}
__device__ __forceinline__ void sincos_d(double x, double& s, double& c) {
    const double k = __builtin_rint(x * 0.15915494309189535);
    double r = __builtin_fma(-k, 6.283185307179586, x); r = __builtin_fma(-k, 2.4492935982947064e-16, r);
    const double r2 = r * r; double tc = 1.0, ts = 1.0, cs = 1.0, ss = 1.0;
#pragma unroll 1
    for (int n = 1; n <= 15; ++n) { tc *= -r2 / (double)((2 * n - 1) * (2 * n)); cs += tc; ts *= -r2 / (double)((2 * n) * (2 * n + 1)); ss += ts; }
    s = r * ss; c = cs;
}
__device__ __forceinline__ float inv_freq(int i) {
    const float q[4] = {1.0f, 0.5623413251903491f, 0.31622776601683794f, 0.17782794100389228f};
    const float p[4] = {1.0f, 0.1f, 0.01f, 0.001f};
    float a = (i & 3) == 0 ? q[0] : (i & 3) == 1 ? q[1] : (i & 3) == 2 ? q[2] : q[3];
    float b = (i >> 2) == 0 ? p[0] : (i >> 2) == 1 ? p[1] : (i >> 2) == 2 ? p[2] : p[3];
    return (float)((double)a * (double)b);
}

template <class RowPtr>
__device__ __forceinline__ void transpose_item(const float* W, int N, int k0, int n0, const RowPtr& rp, LAS float* scr, int lane) {
#pragma unroll 8
    for (int i = 0; i < 32; ++i) { const int kk = 2 * i + (lane >> 5); scr[kk * 33 + (lane & 31)] = W[(size_t)(k0 + kk) * N + n0 + (lane & 31)]; }
    LDS_WAIT(); asm volatile("" ::: "memory");
    const int c = lane & 7;
#pragma unroll
    for (int j = 0; j < 4; ++j) { const int n = (lane >> 3) + 8 * j; const LAS float* s = scr + (8 * c) * 33 + n;
        v4u o; o.x = pk2(s[0 * 33], s[1 * 33]); o.y = pk2(s[2 * 33], s[3 * 33]); o.z = pk2(s[4 * 33], s[5 * 33]); o.w = pk2(s[6 * 33], s[7 * 33]);
        *(GAS v4u*)(rp(n0 + n) + k0 + 8 * c) = o; }
    LDS_WAIT(); asm volatile("" ::: "memory");
}
struct RpPlain { bf16* base; int ld; int roff; int koff; __device__ __forceinline__ bf16* operator()(int n) const { return base + (size_t)(n + roff) * ld + koff; } };
struct RpWin { bf16* w1; bf16* wg; __device__ __forceinline__ bf16* operator()(int n) const { return n < N1_USED ? w1 + (size_t)n * DM : wg + (size_t)(n - N1_USED) * DM; } };
struct RpGU { bf16* base; __device__ __forceinline__ bf16* operator()(int n) const { const int j = n < FFN ? n : n - FFN; return base + (size_t)(256 * (j >> 7) + (n < FFN ? 0 : 128) + (j & 127)) * DM; } };


#ifndef SELFCHECK
#define SELFCHECK 0
#endif
#if SELFCHECK
constexpr size_t WS_SAVE = WS_TABA + 16 * 1024;
constexpr int CW_FLAGS = 64;
__device__ __forceinline__ unsigned hash_u(unsigned x) { x ^= x >> 16; x *= 0x7feb352dU; x ^= x >> 15; x *= 0x846ca68bU; x ^= x >> 16; return x; }
__device__ __forceinline__ bool nclose(float a, float ref, float tol) { return !(fabsf(a - ref) <= tol); }
__device__ __forceinline__ int save_row(int s) { return (s * 509 + 13) % M; }
template <int ST> __device__ __forceinline__ void selfcheck(const Args& args, int l, unsigned* flags) {
    unsigned char* ws = args.ws;
    const int gtid = opaque_v(blockIdx.x * (NWAVES * 64) + threadIdx.x);
    const unsigned hsh = hash_u((unsigned)gtid * 2654435761u + ST * 977u + l * 7919u);
    const float* modp = (const float*)(ws + WS_MOD); const float* tabt = (const float*)(ws + WS_TABT); const float* taba = (const float*)(ws + WS_TABA);
    const bf16* Hb = (const bf16*)(ws + WS_H); const bf16* P1 = (const bf16*)(ws + WS_P1); const bf16* KPE = (const bf16*)(ws + WS_KPE); const bf16* QC = (const bf16*)(ws + WS_QC); const bf16* KC = (const bf16*)(ws + WS_KC);
    const bf16* P2 = (const bf16*)(ws + WS_P2); const bf16* OCAT = (const bf16*)(ws + WS_OCAT); const bf16* A2 = (const bf16*)(ws + WS_A2); const bf16* GATES = (const bf16*)(ws + WS_GATES); const bf16* ACT = (const bf16*)(ws + WS_ACT);
    float* saved = (float*)(ws + WS_SAVE);
    const float* mod = modp + (size_t)l * BATCH * NMOD * DM;
    const float* xcur = (l == 0) ? args.in[0] : args.out; const float* xres = args.out;
    bool bad = false;
    const int m = hsh % M, b = m / SEQ, t = m % SEQ; const unsigned h2 = hsh >> 14;
    if constexpr (ST == 0) {
        const int ll = hsh & 1, bb = (hsh >> 1) & 7, j = (hsh >> 4) % (NMOD * DM); float ref = args.in[3][(size_t)ll * NMOD * DM + j];
        for (int k = 0; k < DM; ++k) { const float v = args.in[1][bb * DM + k]; ref += (v / (1.0f + expf(-v))) * args.in[2][((size_t)ll * DM + k) * (NMOD * DM) + j]; }
        bad = nclose(modp[((size_t)ll * BATCH + bb) * (NMOD * DM) + j], ref, 1e-3f + 1e-3f * fabsf(ref));
    } else if constexpr (ST == 1) {
        const int tt = hsh % SEQ, i = (hsh >> 11) & 15, p = (hsh >> 15) & 63;
        const float a1 = (float)tt * inv_freq(i), a2 = (float)p * inv_freq(i);
        bad = nclose(tabt[tt * 32 + i], cosf(a1), 2e-4f) || nclose(tabt[tt * 32 + 16 + i], sinf(a1), 2e-4f) || nclose(taba[p * 32 + i], cosf(a2), 2e-4f) || nclose(taba[p * 32 + 16 + i], sinf(a2), 2e-4f);
    } else if constexpr (ST == 2 || ST == 12) {
        const float* x = (ST == 2 ? xcur : xres) + (size_t)m * DM; const int c = h2 % DM; float ss = 0.f;
        for (int k = 0; k < DM; ++k) ss += x[k] * x[k];
        const float rstd = 1.0f / sqrtf(ss / DM + NORM_EPS); const float* g = args.in[ST == 2 ? 4 : 5] + (size_t)l * DM; const float* sh = mod + (size_t)b * NMOD * DM + (ST == 2 ? 0 : 3 * DM);
        const float ref = (x[c] * rstd * g[c]) * (1.0f + sh[DM + c]) + sh[c];
        bad = nclose(bf1(Hb[(size_t)m * DM + c]), ref, 0.01f + 0.01f * fabsf(ref));
    } else if constexpr (ST == 3 || ST == 9) {
        const int n = h2 % (ST == 3 ? N1_USED : NG); const int ncol = ST == 3 ? n : N1_USED + n; const float* W = args.in[6] + (size_t)l * DM * IN_COLS + ncol; float ref = 0.f, s2 = 0.f;
        for (int k = 0; k < DM; ++k) { const float p = bf1(Hb[(size_t)m * DM + k]) * W[(size_t)k * IN_COLS]; ref += p; s2 += p * p; }
        if (ST == 3) bad = nclose(bf1(P1[(size_t)m * N1 + n]), ref, 0.02f * sqrtf(s2) + 0.01f * fabsf(ref) + 1e-3f);
        else { const size_t gi = (size_t)m * NG + n; const unsigned wsys = __hip_atomic_load((unsigned*)(GATES + (gi & ~(size_t)1)), __ATOMIC_RELAXED, __HIP_MEMORY_SCOPE_SYSTEM);
            const bf16 vsys = (bf16)((gi & 1) ? (wsys >> 16) : (wsys & 0xffffu)); const bf16 vpl = GATES[gi];
            bad = nclose(bf1(vsys), 1.0f / (1.0f + expf(-ref)), 0.03f); if (vpl != vsys) atomicOr(flags, 1u << 15);
            { pg8::StaticOrder So; So.init(M, NG, 256, 0); int ui = 3; for (int L = 0; L < 768; ++L) { pg8::StaticOrder S1 = So; S1.c = L & 255; pg8::Unit u; S1.next(L >> 8, u); if (u.pm == m / 256 && u.pn == n / 256) ui = L >> 8; }
              atomicAdd(flags + 2 + ui, 1u); if (bad) atomicAdd(flags + 8 + ui, 1u); } }
    } else if constexpr (ST == 4) {
        const bf16* pr = P1 + (size_t)m * N1; const int which = h2 & 3; const unsigned h3 = hsh >> 16; const int prow = t / GRID_W, pcol = t % GRID_W;
        if (which == 0) { const int j = h3 % 384; const int base = j < 256 ? C_CQ : C_CKV, n = j < 256 ? 256 : 128, jj = j < 256 ? j : j - 256; float ss = 0.f;
            for (int k = 0; k < n; ++k) { const float v = bf1(pr[base + k]); ss += v * v; }
            const float g = j < 256 ? args.in[8][(size_t)l * 256 + jj] : args.in[9][(size_t)l * 128 + jj];
            const float ref = bf1(pr[base + jj]) / sqrtf(ss / n + NORM_EPS) * g; bad = nclose(bf1(A2[(size_t)m * 384 + j]), ref, 0.02f + 0.01f * fabsf(ref));
        } else if (which == 1) { const int j = h3 % 32, i = j & 15; const float x1 = bf1(pr[C_KR + i]), x2 = bf1(pr[C_KR + 16 + i]), c = tabt[t * 32 + i], sn = tabt[t * 32 + 16 + i];
            const float ref = j < 16 ? x1 * c - x2 * sn : x2 * c + x1 * sn; bad = nclose(bf1(KPE[(size_t)m * 32 + j]), ref, 0.02f + 0.01f * fabsf(ref));
        } else { const bool isq = which == 2; const int j = h3 % (isq ? 512 : 128), hd = j / 64, d = j % 64; const bf16* src = pr + (isq ? C_QC : C_KC) + hd * 64; float ss = 0.f;
            for (int k = 0; k < 64; ++k) { const float v = bf1(src[k]); ss += v * v; }
            const float rstd = 1.0f / sqrtf(ss / 64 + NORM_EPS); const float* g = args.in[isq ? 12 : 13] + (size_t)l * 64;
            const int part = d / 32, i = (d % 32) % 16; const bool second = (d % 32) >= 16; const int dp = second ? d - 16 : d + 16; const int pos = part == 0 ? prow : pcol;
            const float y = bf1(src[d]) * rstd * g[d], yp = bf1(src[dp]) * rstd * g[dp], c = taba[pos * 32 + i], sn = taba[pos * 32 + 16 + i];
            const float ref = second ? y * c + yp * sn : y * c - yp * sn;
            bad = nclose(bf1(isq ? QC[(size_t)m * 512 + j] : KC[(size_t)m * 128 + j]), ref, 0.02f + 0.01f * fabsf(ref)); }
    } else if constexpr (ST == 5) {
        const int n = h2 % 896; float ref = 0.f, s2 = 0.f;
        if (n < 384) { const float* W = args.in[10] + (size_t)l * 256 * 384 + n; for (int k = 0; k < 256; ++k) { const float p = bf1(A2[(size_t)m * 384 + k]) * W[(size_t)k * 384]; ref += p; s2 += p * p; } }
        else { const float* W = args.in[11] + (size_t)l * 128 * 512 + (n - 384); for (int k = 0; k < 128; ++k) { const float p = bf1(A2[(size_t)m * 384 + 256 + k]) * W[(size_t)k * 512]; ref += p; s2 += p * p; } }
        bad = nclose(bf1(P2[(size_t)m * 1024 + n]), ref, 0.02f * sqrtf(s2) + 0.01f * fabsf(ref) + 1e-3f);
    } else if constexpr (ST == 6) {
        if (blockIdx.x < 16) { const int h = h2 & 3, d = (h2 >> 2) & 63; const bf16* qp = P2 + (size_t)m * 1024 + h * 96; float q[96];
#pragma unroll
            for (int i = 0; i < 64; ++i) q[i] = bf1(qp[i]);
#pragma unroll
            for (int i = 0; i < 16; ++i) { const float x1 = bf1(qp[64 + i]), x2 = bf1(qp[80 + i]), c = tabt[t * 32 + i], sn = tabt[t * 32 + 16 + i]; q[64 + i] = x1 * c - x2 * sn; q[80 + i] = x2 * c + x1 * sn; }
            float mx = -1e30f, lsum = 0.f, o = 0.f;
            for (int kk = 0; kk < SEQ; ++kk) { const size_t mk = (size_t)b * SEQ + kk; const bf16* kn = P2 + mk * 1024 + 384 + h * 128; const bf16* kr = KPE + mk * 32; float sc = 0.f;
#pragma unroll
                for (int i = 0; i < 64; ++i) sc += q[i] * bf1(kn[i]);
#pragma unroll
                for (int i = 0; i < 32; ++i) sc += q[64 + i] * bf1(kr[i]);
                sc *= 0.10206207261596577f; const float mn = fmaxf(mx, sc), a = expf(mx - mn), p = expf(sc - mn); mx = mn; lsum = lsum * a + p; o = o * a + p * bf1(kn[64 + d]); }
            const float ref = o / lsum; bad = nclose(bf1(OCAT[(size_t)m * 1024 + 256 + h * 64 + d]), ref, 0.002f + 0.02f * fabsf(ref)); }
    } else if constexpr (ST == 7) {
        if (blockIdx.x < 16) { const int hq = h2 & 7, kvh = hq >> 2, d = (h2 >> 3) & 63; const bf16* qp = QC + (size_t)m * 512 + hq * 64; float q[64];
#pragma unroll
            for (int i = 0; i < 64; ++i) q[i] = bf1(qp[i]);
            float mx = -1e30f, lsum = 0.f, o = 0.f;
            for (int kk = 0; kk < SEQ; ++kk) { const size_t mk = (size_t)b * SEQ + kk; const bf16* kn = KC + mk * 128 + kvh * 64; float sc = 0.f;
#pragma unroll
                for (int i = 0; i < 64; ++i) sc += q[i] * bf1(kn[i]);
                sc *= 0.125f; const float mn = fmaxf(mx, sc), a = expf(mx - mn), p = expf(sc - mn); mx = mn; lsum = lsum * a + p; o = o * a + p * bf1(P1[mk * N1 + C_VC + kvh * 64 + d]); }
            const float ref = o / lsum; bad = nclose(bf1(OCAT[(size_t)m * 1024 + 512 + hq * 64 + d]), ref, 0.002f + 0.02f * fabsf(ref)); }
    } else if constexpr (ST == 8) {
        const int h = h2 & 3, d = (h2 >> 2) & 63, r = t / GRID_W, qc = t % GRID_W; const int rs = min(max(r - 4, 0), NROWS - 8), wst = min(max(qc - 8, 0), GRID_W - 16);
        const bf16* qp = P1 + (size_t)m * N1 + C_QA + h * 64; const float* rpb = args.in[7] + (size_t)l * 4 * 15 * 31; float mx = -1e30f, lsum = 0.f, o = 0.f;
        for (int i = 0; i < 8; ++i)
            for (int j = 0; j < 16; ++j) { const size_t tk = (size_t)b * SEQ + (size_t)(rs + i) * GRID_W + wst + j; const bf16* kp = P1 + tk * N1 + C_KA + h * 64; float s_ = 0.f;
                for (int k = 0; k < 64; ++k) s_ += bf1(qp[k]) * bf1(kp[k]);
                s_ = s_ * 0.125f + rpb[((size_t)h * 15 + (rs + i - r + 7)) * 31 + (wst + j - qc + 15)];
                const float mn = fmaxf(mx, s_), a = expf(mx - mn), p = expf(s_ - mn); mx = mn; lsum = lsum * a + p; o = o * a + p * bf1(P1[tk * N1 + C_VA + h * 64 + d]); }
        const float ref = o / lsum; bad = nclose(bf1(OCAT[(size_t)m * 1024 + h * 64 + d]), ref, 0.003f + 0.02f * fabsf(ref));
    } else if constexpr (ST == 10) {
        const int c = h2 % DM; float ref = 0.f;
        for (int br = 0; br < 3; ++br) { const int kk = br == 2 ? 512 : 256, off = br * 256; const float* W = args.in[14 + br] + (size_t)l * kk * DM + c; float y = 0.f;
            for (int k = 0; k < kk; ++k) y += bf1(OCAT[(size_t)m * 1024 + off + k]) * W[(size_t)k * DM];
            ref += bf1(GATES[(size_t)m * NG + br * 1024 + c]) * y; }
        bad = nclose(bf1(Hb[(size_t)m * DM + c]), ref, 0.002f + 0.03f * fabsf(ref));
        if (bad) atomicAdd(flags + 2, 1u); if (nclose(bf1(Hb[(size_t)m * DM + c]), ref, 0.01f + 0.15f * fabsf(ref))) atomicAdd(flags + 3, 1u);
        if (gtid < 32 * DM) saved[gtid] = xcur[(size_t)save_row(gtid / DM) * DM + (gtid % DM)];
    } else if constexpr (ST == 11 || ST == 14) {
        if (gtid < 32 * DM) { const int s = gtid / DM, c = gtid % DM, mm = save_row(s), bb = mm / SEQ; float acc = 0.f, s2 = 0.f;
            if (ST == 11) { const float* W = args.in[17] + (size_t)l * DM * DM + c; for (int k = 0; k < DM; ++k) { const float p = bf1(Hb[(size_t)mm * DM + k]) * W[(size_t)k * DM]; acc += p; s2 += p * p; } }
            else { const float* W = args.in[19] + (size_t)l * FFN * DM + c; for (int k = 0; k < FFN; ++k) { const float p = bf1(ACT[(size_t)mm * FFN + k]) * W[(size_t)k * DM]; acc += p; s2 += p * p; } }
            const float g = mod[(size_t)bb * NMOD * DM + (ST == 11 ? 2 : 5) * DM + c]; const float ref = saved[gtid] + g * acc;
            bad = nclose(xres[(size_t)mm * DM + c], ref, 1e-3f + fabsf(g) * 0.02f * sqrtf(s2) + 1e-3f * fabsf(ref)); }
    } else if constexpr (ST == 13) {
        const int j = h2 % FFN; const float* W = args.in[18] + (size_t)l * DM * 2 * FFN; float gt = 0.f, up = 0.f, s2 = 0.f;
        for (int k = 0; k < DM; ++k) { const float hv = bf1(Hb[(size_t)m * DM + k]); const float p1 = hv * W[(size_t)k * 2 * FFN + j], p2 = hv * W[(size_t)k * 2 * FFN + FFN + j]; gt += p1; up += p2; s2 += p1 * p1 + p2 * p2; }
        const float ref = gt / (1.0f + expf(-gt)) * up; bad = nclose(bf1(ACT[(size_t)m * FFN + j]), ref, 0.03f * sqrtf(s2) * (1.0f + fabsf(gt) + fabsf(up)) + 0.02f * fabsf(ref) + 2e-3f);
        if (gtid < 32 * DM) saved[gtid] = xres[(size_t)save_row(gtid / DM) * DM + (gtid % DM)];
    }
    if (bad) atomicOr(flags, 1u << (ST + 16 * l));
}
#ifndef CHKMASK
#define CHKMASK 0xffff
#endif
#define CHK(ST) do { if constexpr (((CHKMASK >> (ST)) & 1) != 0) if (ph <= hi && ph > lo) { selfcheck<ST>(args, l_chk, (unsigned*)(ctl + CW_FLAGS)); xcd_barrier(bar); } } while (0)
#else
#define CHK(ST) do { } while (0)
#endif

__global__ void __launch_bounds__(NWAVES * 64, 2) hybrid_fwd(Args args) {
    extern __shared__ __attribute__((aligned(16))) unsigned char lds[];
    LAS unsigned char* ldsl = (LAS unsigned char*)lds;
    volatile LAS unsigned* MISC = (volatile LAS unsigned*)(ldsl + MISC_OFF);
    const int tid = threadIdx.x, lane = tid & 63, wave = __builtin_amdgcn_readfirstlane(tid >> 6);
    const int G = gridDim.x; const int bx = blockIdx.x; const int vcu = (G % 8 == 0) ? (bx % 8) * (G / 8) + bx / 8 : bx;
    if (G != 256) return;
    unsigned char* ws = args.ws;
    gu32* ctl = (gu32*)(ws + WS_CTL);
    for (int u = tid; u < (LDS_BYTES - LDSCTL_OFF) / 4; u += NWAVES * 64) ((LAS unsigned*)(ldsl + LDSCTL_OFF))[u] = 0u;
    __syncthreads();
    XcdBarrier bar = xcd_barrier_post((unsigned*)(ctl + CW_BAR), MISC + 8);
    const int gw0 = vcu * NWAVES + wave;
    const int lo = args.ph_lo, hi = args.ph_hi; int ph = 0;
#define PHASE_BEGIN() if (lo <= ph && ph < hi) {
#define PHASE_END() if (SELFCHECK || ph + 1 < hi) xcd_barrier(bar); } ++ph;

    float* modp = (float*)(ws + WS_MOD); float* tabt = (float*)(ws + WS_TABT); float* taba = (float*)(ws + WS_TABA);
    bf16* Hb = (bf16*)(ws + WS_H); bf16* P1 = (bf16*)(ws + WS_P1); bf16* KPE = (bf16*)(ws + WS_KPE); bf16* QC = (bf16*)(ws + WS_QC); bf16* KC = (bf16*)(ws + WS_KC);
    bf16* P2 = (bf16*)(ws + WS_P2); bf16* OCAT = (bf16*)(ws + WS_OCAT); bf16* A2 = (bf16*)(ws + WS_A2); bf16* GATES = (bf16*)(ws + WS_GATES); bf16* ACT = (bf16*)(ws + WS_ACT);
    const float* x_in = args.in[0]; float* xres = args.out;

    PHASE_BEGIN()
    { const int tid = opaque_v(threadIdx.x), lane = tid & 63, bx = opaque_s((int)blockIdx.x), G = opaque_s((int)gridDim.x), gw = opaque_s(gw0), NGW = G * NWAVES; (void)lane; (void)bx; (void)G; (void)gw; (void)NGW;
        LAS float* sc = (LAS float*)(ldsl + RING_OFF);
        const float* cin = args.in[1];
        for (int i = tid; i < BATCH * DM; i += NWAVES * 64) { const int b = i / DM, k = i % DM; const float v = cin[i]; sc[k * 8 + b] = v / (1.0f + __expf(-v)); }
        __syncthreads();
        if (wave == 0 && bx < 192) {
            const int l = bx / 96, cg = bx % 96; const float* W = args.in[2] + (size_t)l * DM * (NMOD * DM) + cg * 64 + lane;
            float acc[8];
#pragma unroll
            for (int b = 0; b < 8; ++b) acc[b] = 0.f;
#pragma unroll 8
            for (int k = 0; k < DM; ++k) { const float w = W[(size_t)k * (NMOD * DM)]; const f32x4 s0 = *(const LAS f32x4*)(sc + k * 8), s1 = *(const LAS f32x4*)(sc + k * 8 + 4);
                acc[0] += s0[0] * w; acc[1] += s0[1] * w; acc[2] += s0[2] * w; acc[3] += s0[3] * w; acc[4] += s1[0] * w; acc[5] += s1[1] * w; acc[6] += s1[2] * w; acc[7] += s1[3] * w; }
            const float bias = args.in[3][(size_t)l * NMOD * DM + cg * 64 + lane];
#pragma unroll
            for (int b = 0; b < 8; ++b) modp[((size_t)l * BATCH + b) * (NMOD * DM) + cg * 64 + lane] = acc[b] + bias;
        }
        for (int i = bx * NWAVES * 64 + tid; i < (SEQ + 64) * 16; i += G * NWAVES * 64) {
            const int p = i >> 4, fi = i & 15; const int pos = p < SEQ ? p : p - SEQ; float* dst = p < SEQ ? tabt + (size_t)p * 32 : taba + (size_t)(p - SEQ) * 32;
            const float ang = (float)pos * inv_freq(fi); double s, c; sincos_d((double)ang, s, c); dst[fi] = (float)c; dst[16 + fi] = (float)s;
        }
        LAS float* scr = (LAS float*)(ldsl + RING_OFF + 32768 + wave * 8704);
        for (int l = 0; l < DEPTH; ++l) {
            const LayerW w = layer_w(ws, l);
            constexpr int I_IN = 16 * 157, I_UQ = 4 * 12, I_UKV = 2 * 16, I_BNA = 4 * 32, I_BMLA = 4 * 32, I_BGQA = 8 * 32, I_OUT = 16 * 32, I_GU = 16 * 176, I_DN = 44 * 32;
            constexpr int NITEMS = I_IN + I_UQ + I_UKV + I_BNA + I_BMLA + I_BGQA + I_OUT + I_GU + I_DN;
            for (int it = gw; it < NITEMS; it += NGW) {
                int r = it;
                if (r < I_IN)  { transpose_item(args.in[6] + (size_t)l * DM * IN_COLS, IN_COLS, 64 * (r / 157), 32 * (r % 157), RpWin{w.w1, w.wg}, scr, lane); continue; } r -= I_IN;
                if (r < I_UQ)  { transpose_item(args.in[10] + (size_t)l * 256 * 384, 384, 64 * (r / 12), 32 * (r % 12), RpPlain{w.w2, 384, 0, 0}, scr, lane); continue; } r -= I_UQ;
                if (r < I_UKV) { transpose_item(args.in[11] + (size_t)l * 128 * 512, 512, 64 * (r / 16), 32 * (r % 16), RpPlain{w.w2, 384, 384, 256}, scr, lane); continue; } r -= I_UKV;
                if (r < I_BNA) { transpose_item(args.in[14] + (size_t)l * 256 * 1024, 1024, 64 * (r / 32), 32 * (r % 32), RpPlain{w.bna, 256, 0, 0}, scr, lane); continue; } r -= I_BNA;
                if (r < I_BMLA){ transpose_item(args.in[15] + (size_t)l * 256 * 1024, 1024, 64 * (r / 32), 32 * (r % 32), RpPlain{w.bmla, 256, 0, 0}, scr, lane); continue; } r -= I_BMLA;
                if (r < I_BGQA){ transpose_item(args.in[16] + (size_t)l * 512 * 1024, 1024, 64 * (r / 32), 32 * (r % 32), RpPlain{w.bgqa, 512, 0, 0}, scr, lane); continue; } r -= I_BGQA;
                if (r < I_OUT) { transpose_item(args.in[17] + (size_t)l * 1024 * 1024, 1024, 64 * (r / 32), 32 * (r % 32), RpPlain{w.wout, 1024, 0, 0}, scr, lane); continue; } r -= I_OUT;
                if (r < I_GU)  { transpose_item(args.in[18] + (size_t)l * DM * 2 * FFN, 2 * FFN, 64 * (r / 176), 32 * (r % 176), RpGU{w.wgu}, scr, lane); continue; } r -= I_GU;
                transpose_item(args.in[19] + (size_t)l * FFN * DM, DM, 64 * (r / 32), 32 * (r % 32), RpPlain{w.wdn, FFN, 0, 0}, scr, lane);
            }
            const v4u z = {0u, 0u, 0u, 0u};
            for (int i = bx * NWAVES * 64 + tid; i < 96 * 128; i += G * NWAVES * 64) *(GAS v4u*)(w.w1 + (size_t)N1_USED * DM + (size_t)i * 8) = z;
            for (int i = bx * NWAVES * 64 + tid; i < 1024 * 48; i += G * NWAVES * 64) { const int row = i / 48, ch = i % 48, col = ch * 8;
                const bool zero = row < 384 ? (col >= 256) : row < 896 ? (col < 256) : true;
                if (zero) *(GAS v4u*)(w.w2 + (size_t)row * 384 + col) = z; }
        }
    }
    PHASE_END()
    { const int l_chk = 0; (void)l_chk; CHK(0); CHK(1); }

    for (int l = 0; l < DEPTH; ++l) {
        const LayerW w = layer_w(ws, l);
        const float* mod = modp + (size_t)l * BATCH * NMOD * DM;
        const float* xcur = (l == 0) ? x_in : xres;
        const int l_chk = l; (void)l_chk;

        PHASE_BEGIN()
        { const int tid = opaque_v(threadIdx.x), lane = tid & 63, bx = opaque_s((int)blockIdx.x), G = opaque_s((int)gridDim.x), gw = opaque_s(gw0), NGW = G * NWAVES; (void)lane; (void)bx; (void)G; (void)gw; (void)NGW;
            const float* g = args.in[4] + (size_t)l * DM;
            for (int m = gw; m < M; m += NGW) {
                const int b = m / SEQ; const float* xr = xcur + (size_t)m * DM; const float* sh = mod + (size_t)b * NMOD * DM; const float* scl = sh + DM;
                f32x4 v[4]; float s = 0.f;
#pragma unroll
                for (int j = 0; j < 4; ++j) { v[j] = *(const f32x4*)(xr + 256 * j + 4 * lane); s += (v[j][0] * v[j][0] + v[j][1] * v[j][1]) + (v[j][2] * v[j][2] + v[j][3] * v[j][3]); }
                const float rstd = 1.0f / sqrtf(wave_sum(s) * (1.0f / DM) + NORM_EPS);
#pragma unroll
                for (int j = 0; j < 4; ++j) { const int c = 256 * j + 4 * lane; const f32x4 gg = *(const f32x4*)(g + c), s1 = *(const f32x4*)(scl + c), s0 = *(const f32x4*)(sh + c);
                    f32x4 y;
#pragma unroll
                    for (int e = 0; e < 4; ++e) y[e] = (v[j][e] * rstd * gg[e]) * (1.0f + s1[e]) + s0[e];
                    v2u o; o.x = pk2(y[0], y[1]); o.y = pk2(y[2], y[3]); *(v2u*)(Hb + (size_t)m * DM + c) = o; }
            }
        }
        PHASE_END()
        CHK(2);

        PHASE_BEGIN()
        { const int tid = opaque_v(threadIdx.x), lane = tid & 63, bx = opaque_s((int)blockIdx.x), G = opaque_s((int)gridDim.x), gw = opaque_s(gw0), NGW = G * NWAVES; (void)lane; (void)bx; (void)G; (void)gw; (void)NGW;
            pg8::Gemm g{Hb, w.w1, M, N1, DM, DM, DM}; pg8::StaticOrder S; S.init(M, N1, G, bx);
            pg8::EpiBf16<0> E{P1, N1};
            pg8::gemm_phase<pg8::EpiBf16<0>, pg8::StaticOrder, true, true>(ldsl + RING_OFF, g, S, E);
        }
        PHASE_END()
        CHK(3);

        PHASE_BEGIN()
        { const int tid = opaque_v(threadIdx.x), lane = tid & 63, bx = opaque_s((int)blockIdx.x), G = opaque_s((int)gridDim.x), gw = opaque_s(gw0), NGW = G * NWAVES; (void)lane; (void)bx; (void)G; (void)gw; (void)NGW;
            const float* gq = args.in[8] + (size_t)l * 256; const float* gkv = args.in[9] + (size_t)l * 128;
            const float* gqc = args.in[12] + (size_t)l * 64; const float* gkc = args.in[13] + (size_t)l * 64;
            for (int m = gw; m < M; m += NGW) {
                const int t = m % SEQ, prow = t / GRID_W, pcol = t % GRID_W; const bf16* pr = P1 + (size_t)m * N1;
                {
                    const v2u raw = *(const v2u*)(pr + C_CQ + 4 * lane); float v[4] = {bflo(raw.x), bfhi(raw.x), bflo(raw.y), bfhi(raw.y)};
                    const float rstd = 1.0f / sqrtf(wave_sum(v[0] * v[0] + v[1] * v[1] + v[2] * v[2] + v[3] * v[3]) * (1.0f / 256) + NORM_EPS);
                    const f32x4 gg = *(const f32x4*)(gq + 4 * lane); v2u o; o.x = pk2(v[0] * rstd * gg[0], v[1] * rstd * gg[1]); o.y = pk2(v[2] * rstd * gg[2], v[3] * rstd * gg[3]);
                    *(v2u*)(A2 + (size_t)m * 384 + 4 * lane) = o; }
                {
                    const unsigned raw = *(const unsigned*)(pr + C_CKV + 2 * lane); const float v0 = bflo(raw), v1 = bfhi(raw);
                    const float rstd = 1.0f / sqrtf(wave_sum(v0 * v0 + v1 * v1) * (1.0f / 128) + NORM_EPS);
                    *(unsigned*)(A2 + (size_t)m * 384 + 256 + 2 * lane) = pk2(v0 * rstd * gkv[2 * lane], v1 * rstd * gkv[2 * lane + 1]); }
                if (lane < 16) {
                    const float x1 = bf1(pr[C_KR + lane]), x2 = bf1(pr[C_KR + 16 + lane]); const float c = tabt[(size_t)t * 32 + lane], s = tabt[(size_t)t * 32 + 16 + lane];
                    KPE[(size_t)m * 32 + lane] = (bf16)f2bf(x1 * c - x2 * s); KPE[(size_t)m * 32 + 16 + lane] = (bf16)f2bf(x2 * c + x1 * s); }
#pragma unroll
                for (int pass = 0; pass < 2; ++pass) {
                    const bool act = pass == 0 || lane < 16;
                    const bf16* src = pr + (pass == 0 ? C_QC : C_KC) + 8 * (act ? lane : 0);
                    const v4u raw = *(const v4u*)src; float v[8] = {bflo(raw.x), bfhi(raw.x), bflo(raw.y), bfhi(raw.y), bflo(raw.z), bfhi(raw.z), bflo(raw.w), bfhi(raw.w)};
                    float ss = 0.f;
#pragma unroll
                    for (int e = 0; e < 8; ++e) ss += v[e] * v[e];
                    ss += __shfl_xor(ss, 1); ss += __shfl_xor(ss, 2); ss += __shfl_xor(ss, 4);
                    const float rstd = 1.0f / sqrtf(ss * (1.0f / 64) + NORM_EPS);
                    const int sidx = lane & 7; const float* gn = (pass == 0 ? gqc : gkc) + 8 * sidx;
                    float y[8], pv[8];
#pragma unroll
                    for (int e = 0; e < 8; ++e) y[e] = v[e] * rstd * gn[e];
#pragma unroll
                    for (int e = 0; e < 8; ++e) pv[e] = __shfl_xor(y[e], 2);
                    const int pos = (sidx < 4) ? prow : pcol; const float* tb = taba + (size_t)pos * 32 + (sidx & 1) * 8; const bool second = (sidx & 2) != 0;
                    float o[8];
#pragma unroll
                    for (int e = 0; e < 8; ++e) { const float c = tb[e], s = tb[16 + e]; o[e] = second ? (y[e] * c + pv[e] * s) : (y[e] * c - pv[e] * s); }
                    v4u ov; ov.x = pk2(o[0], o[1]); ov.y = pk2(o[2], o[3]); ov.z = pk2(o[4], o[5]); ov.w = pk2(o[6], o[7]);
                    if (act) { if (pass == 0) *(v4u*)(QC + (size_t)m * 512 + 8 * lane) = ov; else *(v4u*)(KC + (size_t)m * 128 + 8 * lane) = ov; }
                }
            }
        }
        PHASE_END()
        CHK(4);

        PHASE_BEGIN()
        { const int tid = opaque_v(threadIdx.x), lane = tid & 63, bx = opaque_s((int)blockIdx.x), G = opaque_s((int)gridDim.x), gw = opaque_s(gw0), NGW = G * NWAVES; (void)lane; (void)bx; (void)G; (void)gw; (void)NGW;
            pg8::Gemm g{A2, w.w2, M, 1024, 384, 384, 384}; pg8::StaticOrder S; S.init(M, 1024, G, bx);
            pg8::EpiBf16<0> E{P2, 1024};
            pg8::gemm_phase<pg8::EpiBf16<0>, pg8::StaticOrder, true, true>(ldsl + RING_OFF, g, S, E);
        }
        PHASE_END()
        CHK(5);

        PHASE_BEGIN()
        { const int tid = opaque_v(threadIdx.x), lane = tid & 63, bx = opaque_s((int)blockIdx.x), G = opaque_s((int)gridDim.x), gw = opaque_s(gw0), NGW = G * NWAVES; (void)lane; (void)bx; (void)G; (void)gw; (void)NGW;
            char* alds = (char*)lds + RING_OFF;
            {
                const int x8 = bx & 7, j32 = bx >> 3;
                {
                    const int grp = x8 * 4 + (j32 >> 3), qb = j32 & 7, b = grp >> 2, h = grp & 3; const size_t row0 = (size_t)b * SEQ;
                    att::attn_unit<32>(P2 + (row0 + qb * 256) * 1024 + h * 96, 1024, P2 + row0 * 1024 + 384 + h * 128, 1024, KPE + row0 * 32, 32,
                                       P2 + row0 * 1024 + 384 + h * 128 + 64, 1024, OCAT + (row0 + qb * 256) * 1024 + 256 + h * 64, 1024, SEQ, tabt + (size_t)(qb * 256) * 32, alds);
                }
                for (int i = 0; i < 2; ++i) {
                    const int grp = i * 8 + x8, b = grp >> 1, kvh = grp & 1, hq = kvh * 4 + (j32 >> 3), qb = j32 & 7; const size_t row0 = (size_t)b * SEQ;
                    att::attn_unit<0>(QC + (row0 + qb * 256) * 512 + hq * 64, 512, KC + row0 * 128 + kvh * 64, 128, nullptr, 0,
                                      P1 + row0 * N1 + C_VC + kvh * 64, N1, OCAT + (row0 + qb * 256) * 1024 + 512 + hq * 64, 1024, SEQ, nullptr, alds);
                }
            }
            const float* rpb = args.in[7] + (size_t)l * 4 * 15 * 31;
            for (int it = bx * NWAVES * 64 + tid; it < M * 4; it += G * NWAVES * 64) {
                const int m = it >> 2, h = it & 3, b = m / SEQ, t = m % SEQ, r = t / GRID_W, qc = t % GRID_W;
                const int rs = min(max(r - 4, 0), NROWS - 8), wst = min(max(qc - 8, 0), GRID_W - 16);
                float q[64], o[64];
                { const bf16* qp = P1 + (size_t)m * N1 + C_QA + h * 64;
#pragma unroll
                  for (int c = 0; c < 8; ++c) { const v4u raw = *(const v4u*)(qp + 8 * c); q[8 * c] = bflo(raw.x); q[8 * c + 1] = bfhi(raw.x); q[8 * c + 2] = bflo(raw.y); q[8 * c + 3] = bfhi(raw.y);
                      q[8 * c + 4] = bflo(raw.z); q[8 * c + 5] = bfhi(raw.z); q[8 * c + 6] = bflo(raw.w); q[8 * c + 7] = bfhi(raw.w); } }
#pragma unroll
                for (int d = 0; d < 64; ++d) o[d] = 0.f;
                float mx = -1e30f, lsum = 0.f;
                for (int i = 0; i < 8; ++i) {
                    const float* brow = rpb + ((size_t)h * 15 + (rs + i - r + 7)) * 31 + (wst - qc + 15);
                    for (int j = 0; j < 16; ++j) {
                        const size_t tk = (size_t)b * SEQ + (size_t)(rs + i) * GRID_W + wst + j; const bf16* kp = P1 + tk * N1 + C_KA + h * 64; const bf16* vp = P1 + tk * N1 + C_VA + h * 64;
                        float s = 0.f;
#pragma unroll
                        for (int c = 0; c < 8; ++c) { const v4u raw = *(const v4u*)(kp + 8 * c);
                            s += q[8 * c] * bflo(raw.x) + q[8 * c + 1] * bfhi(raw.x) + q[8 * c + 2] * bflo(raw.y) + q[8 * c + 3] * bfhi(raw.y)
                               + q[8 * c + 4] * bflo(raw.z) + q[8 * c + 5] * bfhi(raw.z) + q[8 * c + 6] * bflo(raw.w) + q[8 * c + 7] * bfhi(raw.w); }
                        s = s * 0.125f + brow[j];
                        const float mn = fmaxf(mx, s), a = __expf(mx - mn), p = __expf(s - mn); mx = mn; lsum = lsum * a + p;
#pragma unroll
                        for (int c = 0; c < 8; ++c) { const v4u raw = *(const v4u*)(vp + 8 * c);
                            o[8 * c] = o[8 * c] * a + p * bflo(raw.x); o[8 * c + 1] = o[8 * c + 1] * a + p * bfhi(raw.x); o[8 * c + 2] = o[8 * c + 2] * a + p * bflo(raw.y); o[8 * c + 3] = o[8 * c + 3] * a + p * bfhi(raw.y);
                            o[8 * c + 4] = o[8 * c + 4] * a + p * bflo(raw.z); o[8 * c + 5] = o[8 * c + 5] * a + p * bfhi(raw.z); o[8 * c + 6] = o[8 * c + 6] * a + p * bflo(raw.w); o[8 * c + 7] = o[8 * c + 7] * a + p * bfhi(raw.w); }
                    }
                }
                const float inv = 1.0f / lsum; bf16* op = OCAT + (size_t)m * 1024 + h * 64;
#pragma unroll
                for (int c = 0; c < 8; ++c) { v4u ov; ov.x = pk2(o[8 * c] * inv, o[8 * c + 1] * inv); ov.y = pk2(o[8 * c + 2] * inv, o[8 * c + 3] * inv); ov.z = pk2(o[8 * c + 4] * inv, o[8 * c + 5] * inv); ov.w = pk2(o[8 * c + 6] * inv, o[8 * c + 7] * inv);
                    *(v4u*)(op + 8 * c) = ov; }
            }
        }
        PHASE_END()
        CHK(6); CHK(7); CHK(8);

        PHASE_BEGIN()
        { const int tid = opaque_v(threadIdx.x), lane = tid & 63, bx = opaque_s((int)blockIdx.x), G = opaque_s((int)gridDim.x), gw = opaque_s(gw0), NGW = G * NWAVES; (void)lane; (void)bx; (void)G; (void)gw; (void)NGW;
            pg8::Gemm g{Hb, w.wg, M, NG, DM, DM, DM}; pg8::StaticOrder S; S.init(M, NG, G, bx);
            pg8::EpiBf16<1> E{GATES, NG};
            pg8::gemm_phase<pg8::EpiBf16<1>, pg8::StaticOrder, true, true>(ldsl + RING_OFF, g, S, E);
        }
        PHASE_END()
        CHK(9);

        PHASE_BEGIN()
        { const int tid = opaque_v(threadIdx.x), lane = tid & 63, bx = opaque_s((int)blockIdx.x), G = opaque_s((int)gridDim.x), gw = opaque_s(gw0), NGW = G * NWAVES; (void)lane; (void)bx; (void)G; (void)gw; (void)NGW;
            pg8::StaticOrder S; S.init(M, DM, G, bx);
            { pg8::Gemm g{OCAT, w.bna, M, DM, 256, 1024, 256}; pg8::EpiGateAcc E{Hb, DM, GATES, NG, 0, 1};
              pg8::gemm_phase<pg8::EpiGateAcc, pg8::StaticOrder, true, true>(ldsl + RING_OFF, g, S, E); }
            { pg8::Gemm g{OCAT + 256, w.bmla, M, DM, 256, 1024, 256}; pg8::EpiGateAcc E{Hb, DM, GATES, NG, 1024, 0};
              pg8::gemm_phase<pg8::EpiGateAcc, pg8::StaticOrder, true, true>(ldsl + RING_OFF, g, S, E); }
            { pg8::Gemm g{OCAT + 512, w.bgqa, M, DM, 512, 1024, 512}; pg8::EpiGateAcc E{Hb, DM, GATES, NG, 2048, 0};
              pg8::gemm_phase<pg8::EpiGateAcc, pg8::StaticOrder, true, true>(ldsl + RING_OFF, g, S, E); }
        }
        PHASE_END()
        CHK(10);

        PHASE_BEGIN()
        { const int tid = opaque_v(threadIdx.x), lane = tid & 63, bx = opaque_s((int)blockIdx.x), G = opaque_s((int)gridDim.x), gw = opaque_s(gw0), NGW = G * NWAVES; (void)lane; (void)bx; (void)G; (void)gw; (void)NGW;
            pg8::Gemm g{Hb, w.wout, M, DM, DM, DM, DM}; pg8::StaticOrder S; S.init(M, DM, G, bx);
            pg8::EpiResidual E{xcur, xres, DM, mod + 2 * DM, NMOD * DM, SEQ};
            pg8::gemm_phase<pg8::EpiResidual, pg8::StaticOrder, true, true>(ldsl + RING_OFF, g, S, E);
        }
        PHASE_END()
        CHK(11);

        PHASE_BEGIN()
        { const int tid = opaque_v(threadIdx.x), lane = tid & 63, bx = opaque_s((int)blockIdx.x), G = opaque_s((int)gridDim.x), gw = opaque_s(gw0), NGW = G * NWAVES; (void)lane; (void)bx; (void)G; (void)gw; (void)NGW;
            const float* g = args.in[5] + (size_t)l * DM;
            for (int m = gw; m < M; m += NGW) {
                const int b = m / SEQ; const float* xr = xres + (size_t)m * DM; const float* sh = mod + (size_t)b * NMOD * DM + 3 * DM; const float* scl = sh + DM;
                f32x4 v[4]; float s = 0.f;
#pragma unroll
                for (int j = 0; j < 4; ++j) { v[j] = *(const f32x4*)(xr + 256 * j + 4 * lane); s += (v[j][0] * v[j][0] + v[j][1] * v[j][1]) + (v[j][2] * v[j][2] + v[j][3] * v[j][3]); }
                const float rstd = 1.0f / sqrtf(wave_sum(s) * (1.0f / DM) + NORM_EPS);
#pragma unroll
                for (int j = 0; j < 4; ++j) { const int c = 256 * j + 4 * lane; const f32x4 gg = *(const f32x4*)(g + c), s1 = *(const f32x4*)(scl + c), s0 = *(const f32x4*)(sh + c);
                    f32x4 y;
#pragma unroll
                    for (int e = 0; e < 4; ++e) y[e] = (v[j][e] * rstd * gg[e]) * (1.0f + s1[e]) + s0[e];
                    v2u o; o.x = pk2(y[0], y[1]); o.y = pk2(y[2], y[3]); *(v2u*)(Hb + (size_t)m * DM + c) = o; }
            }
        }
        PHASE_END()
        CHK(12);

        PHASE_BEGIN()
        { const int tid = opaque_v(threadIdx.x), lane = tid & 63, bx = opaque_s((int)blockIdx.x), G = opaque_s((int)gridDim.x), gw = opaque_s(gw0), NGW = G * NWAVES; (void)lane; (void)bx; (void)G; (void)gw; (void)NGW;
            pg8::Gemm g{Hb, w.wgu, M, 2 * FFN, DM, DM, DM}; pg8::StaticOrder S; S.init(M, 2 * FFN, G, bx);
            pg8::EpiSwiGLU E{ACT, FFN};
            pg8::gemm_phase<pg8::EpiSwiGLU, pg8::StaticOrder, true, true>(ldsl + RING_OFF, g, S, E);
        }
        PHASE_END()
        CHK(13);

        PHASE_BEGIN()
        { const int tid = opaque_v(threadIdx.x), lane = tid & 63, bx = opaque_s((int)blockIdx.x), G = opaque_s((int)gridDim.x), gw = opaque_s(gw0), NGW = G * NWAVES; (void)lane; (void)bx; (void)G; (void)gw; (void)NGW;
            pg8::Gemm g{ACT, w.wdn, M, DM, FFN, FFN, FFN}; pg8::StaticOrder S; S.init(M, DM, G, bx);
            pg8::EpiResidual E{xres, xres, DM, mod + 5 * DM, NMOD * DM, SEQ};
            pg8::gemm_phase<pg8::EpiResidual, pg8::StaticOrder, true, true>(ldsl + RING_OFF, g, S, E);
        }
        PHASE_END()
        CHK(14);
    }

    PHASE_BEGIN()
    { const int tid = opaque_v(threadIdx.x), lane = tid & 63, bx = opaque_s((int)blockIdx.x), G = opaque_s((int)gridDim.x), gw = opaque_s(gw0), NGW = G * NWAVES; (void)lane; (void)bx; (void)G; (void)gw; (void)NGW;
        const float* g = args.in[20];
        for (int m = gw; m < M; m += NGW) {
            float* xr = xres + (size_t)m * DM;
            f32x4 v[4]; float s = 0.f;
#pragma unroll
            for (int j = 0; j < 4; ++j) { v[j] = *(const f32x4*)(xr + 256 * j + 4 * lane); s += (v[j][0] * v[j][0] + v[j][1] * v[j][1]) + (v[j][2] * v[j][2] + v[j][3] * v[j][3]); }
            const float rstd = 1.0f / sqrtf(wave_sum(s) * (1.0f / DM) + NORM_EPS);
#pragma unroll
            for (int j = 0; j < 4; ++j) { const int c = 256 * j + 4 * lane; const f32x4 gg = *(const f32x4*)(g + c); f32x4 y;
#pragma unroll
                for (int e = 0; e < 4; ++e) y[e] = v[j][e] * rstd * gg[e];
                *(f32x4*)(xr + c) = y; }
        }
    }
    PHASE_END()
#if SELFCHECK
        xcd_barrier(bar);
        if (blockIdx.x == 0 && threadIdx.x == 0) { const unsigned fl = __hip_atomic_load((unsigned*)(ctl + CW_FLAGS), RLX_AGENT); unsigned c[12]; for (int i = 0; i < 12; ++i) c[i] = __hip_atomic_load((unsigned*)(ctl + CW_FLAGS + 2 + i), RLX_AGENT);
        unsigned tot = c[0] + c[1] + c[2] + c[3], bad_ = c[6] + c[7] + c[8] + c[9]; int d1 = (c[6] ? 1 : 0) | (c[7] ? 2 : 0) | (c[8] ? 4 : 0) | (c[9] ? 8 : 0); int d2 = tot ? (int)(9.99f * (float)bad_ / (float)tot) : 0;
        { int k1 = 0, k2 = 0; while ((c[0] >> k1) != 0) ++k1; while ((c[1] >> k2) != 0) ++k2; d1 = k1 / 2; d2 = k2 / 2; if (d1 > 9) d1 = 9; if (d2 > 9) d2 = 9; args.out[0] = 100.0f * (float)(10 * d1 + d2 + 1); return; }
        args.out[0] = 100.0f * (float)((((fl >> 15) & 1u) * 2u + ((fl >> 10) & 1u)) + 1u); }
#endif
#undef PHASE_BEGIN
#undef PHASE_END
}

constexpr int N_PHASES = 1 + DEPTH * 11 + 1;
#ifndef MK_PER_PHASE
#define MK_PER_PHASE 0
#endif

extern "C" void kernel_launch(void* const* d_in, const int* in_sizes, int n_in, void* d_out, int out_size, void* d_ws, size_t ws_size, hipStream_t stream) {
    static int grid = 0;
    if (grid == 0) {
        if (n_in != 21 || in_sizes[0] != M * DM || out_size != M * DM || ws_size < WS_END) { fprintf(stderr, "kernel_launch: unexpected shapes (n_in %d in0 %d out %d ws %zu)\n", n_in, n_in > 0 ? in_sizes[0] : -1, out_size, ws_size); grid = -1; return; }
        int dev = 0, cus = 0;
        if (hipGetDevice(&dev) != hipSuccess || hipDeviceGetAttribute(&cus, hipDeviceAttributeMultiprocessorCount, dev) != hipSuccess) { grid = -1; return; }
        if (hipFuncSetAttribute((const void*)hybrid_fwd, hipFuncAttributeMaxDynamicSharedMemorySize, LDS_BYTES) != hipSuccess) { fprintf(stderr, "kernel_launch: hipFuncSetAttribute failed\n"); grid = -1; return; }
        (void)hipGetLastError();
        grid = cus;
    }
    if (grid < 0) return;
    (void)hipMemsetAsync((char*)d_ws + WS_CTL, 0, CTL_ZERO_BYTES, stream);
    Args a{};
    for (int i = 0; i < 21; ++i) a.in[i] = (const float*)d_in[i];
    a.out = (float*)d_out; a.ws = (unsigned char*)d_ws;
#if MK_PER_PHASE
    for (int p = 0; p < N_PHASES; ++p) { a.ph_lo = p; a.ph_hi = p + 1; hipLaunchKernelGGL(hybrid_fwd, dim3(grid), dim3(NWAVES * 64), LDS_BYTES, stream, a); }
#else
#if SELFCHECK
    a.ph_lo = 0; a.ph_hi = 12;
#else
    a.ph_lo = 0; a.ph_hi = N_PHASES;
#endif
    hipLaunchKernelGGL(hybrid_fwd, dim3(grid), dim3(NWAVES * 64), LDS_BYTES, stream, a);
#endif
    const hipError_t le = hipPeekAtLastError();
    if (le != hipSuccess) fprintf(stderr, "kernel_launch: launch failed: %s\n", hipGetErrorName(le));
}
```

```cpp
#define SELFCHECK 0
#include <hip/hip_runtime.h>
#include <hip/hip_bf16.h>
#include <cstdio>
#include <cstdint>

__device__ __forceinline__ int opaque_v(int v) { asm volatile("" : "+v"(v)); return v; }
__device__ __forceinline__ int opaque_s(int v) { asm volatile("" : "+s"(v)); return v; }
namespace pg8 {
#define PG8_LAS __attribute__((address_space(3)))
typedef unsigned short bf16_t;
typedef short bf16x8 __attribute__((ext_vector_type(8)));
typedef float f32x4 __attribute__((ext_vector_type(4)));
typedef unsigned u32x4 __attribute__((ext_vector_type(4)));
constexpr int BM = 256, BK = 64, HALF = 128, HTB = HALF * BK * 2, STAGE_BYTES = 8 * HTB, NXCD = 8, WGM = 8;

__host__ __device__ __forceinline__ int lds_byte(int r, int c) { const int st = (r >> 4) * 2 + (c >> 5), rr = r & 15, cc = c & 31, ob = rr * 64 + cc * 2; return st * 1024 + (ob ^ (((ob >> 9) & 1) << 5)); }
__host__ __device__ __forceinline__ void stage_rc(int b, int& R, int& C) { const int st = b / 1024, sb = b % 1024, swz = sb ^ (((sb >> 9) & 1) << 5); R = (st >> 1) * 16 + swz / 64; C = (st & 1) * 32 + (swz % 64) / 2; }
__host__ __device__ __forceinline__ int perm32(int rho) { const int n = rho >> 4, i = rho & 15; return 8 * (i >> 2) + 4 * n + (i & 3); }

struct Unit { int pm, pn; };
struct Gemm { const bf16_t* A; const bf16_t* Bt; int M, N, K, lda, ldb; };

struct StaticOrder {
    int nM, nN, nwg, G, c;
    __host__ __device__ void init(int M, int N, int G_, int c_) { nM = M / BM; nN = N / BM; nwg = nM * nN; G = G_; c = c_; }
    __host__ __device__ bool next(int i, Unit& u) const {
        const long L = (long)i * G + c; if (L >= nwg) return false;
        int wgid = (int)L; { const int q = nwg / NXCD, r = nwg % NXCD, xcd = wgid % NXCD, off = wgid / NXCD; wgid = (xcd < r ? xcd * (q + 1) : r * (q + 1) + (xcd - r) * q) + off; }
        const int nig = WGM * nN, gid = wgid / nig, fm = gid * WGM, gsz = (nM - fm) < WGM ? (nM - fm) : WGM;
        u.pm = fm + ((wgid % nig) % gsz); u.pn = (wgid % nig) / gsz; return true;
    }
    __device__ __forceinline__ void a_ready(const Unit&) const {}
    __device__ __forceinline__ void done(const Unit&) const {}
};

typedef float f32x2_t __attribute__((ext_vector_type(2))); typedef __bf16 bf16x2_t __attribute__((ext_vector_type(2)));
__device__ __forceinline__ unsigned cvt_pk_bf16(float lo, float hi) { f32x2_t v = {lo, hi}; bf16x2_t b = __builtin_convertvector(v, bf16x2_t); return __builtin_bit_cast(unsigned, b); }
__device__ __forceinline__ float bf_lo(unsigned w) { return __uint_as_float(w << 16); }
__device__ __forceinline__ float bf_hi(unsigned w) { return __uint_as_float(w & 0xffff0000u); }
__device__ __forceinline__ float sigmoidf_(float v) { return __builtin_amdgcn_rcpf(1.0f + __builtin_amdgcn_exp2f(-1.4426950408889634f * v)); }

template <int ACT  > struct EpiBf16 {
    static constexpr bool PERM = true, AFTER_DRAIN = false;
    bf16_t* O; int ldc;
    __device__ __forceinline__ void operator()(const f32x4 (&acc)[2][2][4][2], const Unit& u, int wr, int wc, int fr, int fq) const {
        const int row0 = u.pm * BM + wr * 64 + fr, col0 = u.pn * BM + wc * 32 + 8 * fq;
#pragma unroll
        for (int ai = 0; ai < 2; ++ai)
#pragma unroll
            for (int m = 0; m < 4; ++m) { bf16_t* rowp = O + (size_t)(row0 + ai * HALF + m * 16) * ldc + col0;
#pragma unroll
                for (int bj = 0; bj < 2; ++bj) { f32x4 v0 = acc[ai][bj][m][0], v1 = acc[ai][bj][m][1];
                    if (ACT == 1) {
#pragma unroll
                        for (int e = 0; e < 4; ++e) { v0[e] = sigmoidf_(v0[e]); v1[e] = sigmoidf_(v1[e]); } }
                    u32x4 w; w.x = cvt_pk_bf16(v0[0], v0[1]); w.y = cvt_pk_bf16(v0[2], v0[3]); w.z = cvt_pk_bf16(v1[0], v1[1]); w.w = cvt_pk_bf16(v1[2], v1[3]);
                    *(u32x4*)(rowp + bj * HALF) = w; } }
    }
};
struct EpiGateAcc {
    static constexpr bool PERM = true, AFTER_DRAIN = false;
    bf16_t* O; int ldc; const bf16_t* G; int ldg; int goff; int first;
    __device__ __forceinline__ void operator()(const f32x4 (&acc)[2][2][4][2], const Unit& u, int wr, int wc, int fr, int fq) const {
        const int row0 = u.pm * BM + wr * 64 + fr, col0 = u.pn * BM + wc * 32 + 8 * fq;
#pragma unroll
        for (int ai = 0; ai < 2; ++ai)
#pragma unroll
            for (int m = 0; m < 4; ++m) { const size_t r = (size_t)(row0 + ai * HALF + m * 16); bf16_t* rowp = O + r * ldc + col0; const bf16_t* gp = G + r * ldg + goff + col0;
#pragma unroll
                for (int bj = 0; bj < 2; ++bj) { const f32x4 v0 = acc[ai][bj][m][0], v1 = acc[ai][bj][m][1];
                    const u32x4 g = *(const u32x4*)(gp + bj * HALF);
                    float o[8];
                    o[0] = bf_lo(g.x) * v0[0]; o[1] = bf_hi(g.x) * v0[1]; o[2] = bf_lo(g.y) * v0[2]; o[3] = bf_hi(g.y) * v0[3];
                    o[4] = bf_lo(g.z) * v1[0]; o[5] = bf_hi(g.z) * v1[1]; o[6] = bf_lo(g.w) * v1[2]; o[7] = bf_hi(g.w) * v1[3];
                    if (!first) { const u32x4 p = *(const u32x4*)(rowp + bj * HALF);
                        o[0] += bf_lo(p.x); o[1] += bf_hi(p.x); o[2] += bf_lo(p.y); o[3] += bf_hi(p.y); o[4] += bf_lo(p.z); o[5] += bf_hi(p.z); o[6] += bf_lo(p.w); o[7] += bf_hi(p.w); }
                    u32x4 w; w.x = cvt_pk_bf16(o[0], o[1]); w.y = cvt_pk_bf16(o[2], o[3]); w.z = cvt_pk_bf16(o[4], o[5]); w.w = cvt_pk_bf16(o[6], o[7]);
                    *(u32x4*)(rowp + bj * HALF) = w; } }
    }
};
struct EpiSwiGLU {
    static constexpr bool PERM = true, AFTER_DRAIN = false;
    bf16_t* O; int ldc;
    __device__ __forceinline__ void operator()(const f32x4 (&acc)[2][2][4][2], const Unit& u, int wr, int wc, int fr, int fq) const {
        const int row0 = u.pm * BM + wr * 64 + fr, col0 = u.pn * HALF + wc * 32 + 8 * fq;
#pragma unroll
        for (int ai = 0; ai < 2; ++ai)
#pragma unroll
            for (int m = 0; m < 4; ++m) { bf16_t* rowp = O + (size_t)(row0 + ai * HALF + m * 16) * ldc + col0;
                float o[8];
#pragma unroll
                for (int n = 0; n < 2; ++n)
#pragma unroll
                    for (int e = 0; e < 4; ++e) { const float g = acc[ai][0][m][n][e], up = acc[ai][1][m][n][e]; o[n * 4 + e] = g * sigmoidf_(g) * up; }
                u32x4 w; w.x = cvt_pk_bf16(o[0], o[1]); w.y = cvt_pk_bf16(o[2], o[3]); w.z = cvt_pk_bf16(o[4], o[5]); w.w = cvt_pk_bf16(o[6], o[7]);
                *(u32x4*)rowp = w; }
    }
};
struct EpiResidual {
    static constexpr bool PERM = false, AFTER_DRAIN = false;
    const float* xin; float* xout; int ldc; const float* gvec; int gstride; int rows_per_batch;
    __device__ __forceinline__ void operator()(const f32x4 (&acc)[2][2][4][2], const Unit& u, int wr, int wc, int fr, int fq) const {
        const int row0 = u.pm * BM + wr * 64 + fr, col0 = u.pn * BM + wc * 32 + 4 * fq;
        const int b = (u.pm * BM) / rows_per_batch;
        f32x4 gv[2][2];
#pragma unroll
        for (int bj = 0; bj < 2; ++bj)
#pragma unroll
            for (int n = 0; n < 2; ++n) gv[bj][n] = *(const f32x4*)(gvec + (size_t)b * gstride + col0 + bj * HALF + n * 16);
#pragma unroll
        for (int ai = 0; ai < 2; ++ai)
#pragma unroll
            for (int m = 0; m < 4; ++m) { const size_t off = (size_t)(row0 + ai * HALF + m * 16) * ldc + col0;
#pragma unroll
                for (int bj = 0; bj < 2; ++bj)
#pragma unroll
                    for (int n = 0; n < 2; ++n) { const f32x4 xi = *(const f32x4*)(xin + off + bj * HALF + n * 16);
                        *(f32x4*)(xout + off + bj * HALF + n * 16) = xi + gv[bj][n] * acc[ai][bj][m][n]; } }
    }
};

template <class Epi, class Sched, bool ALIGN_EPI = false, bool SP2 = false>
__device__ __forceinline__ void gemm_phase(PG8_LAS unsigned char* lds, const Gemm g, const Sched& S, const Epi& E) {
    const int tid = opaque_v(threadIdx.x), wid = __builtin_amdgcn_readfirstlane(tid >> 6), lane = tid & 63, wr = wid >> 2, wc = wid & 3, fr = lane & 15, fq = lane >> 4;
    const int K = g.K, nt = K / BK;
    unsigned voffA[2], voffB[2];
#pragma unroll
    for (int i = 0; i < 2; ++i) { int R, C; stage_rc(tid * 16 + i * 8192, R, C); const int Rb = Epi::PERM ? ((R & ~31) + perm32(R & 31)) : R;
        voffA[i] = (unsigned)(R * g.lda + C) * 2u; voffB[i] = (unsigned)(Rb * g.ldb + C) * 2u; }
    const size_t kstep = (size_t)(BK * 2);
    const size_t hstepA = (size_t)HALF * g.lda * 2, hstepB = (size_t)HALF * g.ldb * 2;
    const size_t tstepA = 2 * hstepA, tstepB = 2 * hstepB;
    const unsigned ldsw = (unsigned)wid * 1024u;
    const int aoff = lds_byte(wr * 64 + fr, fq * 8), boff = lds_byte(wc * 32 + fr, fq * 8);
#define PG8_SA(b, h) (((b) * 2 + (h)) * HTB)
#define PG8_SB(b, h) ((4 + (b) * 2 + (h)) * HTB)
#define PG8_STAGE(bufoff, gbase, voff) do { _Pragma("unroll") for (int _i = 0; _i < 2; ++_i) \
        __builtin_amdgcn_global_load_lds((const unsigned*)((const char*)(gbase) + (voff)[_i]), (PG8_LAS unsigned*)(lds + (bufoff) + ldsw + _i * 8192), 16, 0, 0); } while (0)
#define PG8_LDA(dst, b, h) do { _Pragma("unroll") for (int m = 0; m < 4; ++m) _Pragma("unroll") for (int k = 0; k < 2; ++k) dst[m][k] = *(const PG8_LAS bf16x8*)(lds + PG8_SA(b, h) + aoff + m * 2048 + k * 1024); } while (0)
#define PG8_LDB(dst, b, h) do { _Pragma("unroll") for (int n = 0; n < 2; ++n) _Pragma("unroll") for (int k = 0; k < 2; ++k) dst[n][k] = *(const PG8_LAS bf16x8*)(lds + PG8_SB(b, h) + boff + n * 2048 + k * 1024); } while (0)
#define PG8_MMA(ai, bj, At, Bt) do { __builtin_amdgcn_s_setprio(1); _Pragma("unroll") for (int m = 0; m < 4; ++m) _Pragma("unroll") for (int n = 0; n < 2; ++n) _Pragma("unroll") for (int k = 0; k < 2; ++k) \
        acc[ai][bj][m][n] = __builtin_amdgcn_mfma_f32_16x16x32_bf16(Bt[n][k], At[m][k], acc[ai][bj][m][n], 0, 0, 0); __builtin_amdgcn_s_setprio(0); } while (0)
#define PG8_WAIT_V(n) asm volatile("s_waitcnt vmcnt(" #n ")" ::: "memory")
#define PG8_WAIT_L(n) asm volatile("s_waitcnt lgkmcnt(" #n ")" ::: "memory")
#define PG8_BAR __builtin_amdgcn_s_barrier()
#define PG8_SCHED __builtin_amdgcn_sched_barrier(0)
    Unit cur, nxt; int ui = 0;
    if (!S.next(0, cur)) return;
    f32x4 acc[2][2][4][2];
#pragma unroll
    for (int a = 0; a < 2; ++a)
#pragma unroll
        for (int b = 0; b < 2; ++b)
#pragma unroll
            for (int m = 0; m < 4; ++m)
#pragma unroll
                for (int n = 0; n < 2; ++n) acc[a][b][m][n] = (f32x4){0.f, 0.f, 0.f, 0.f};
    bf16x8 At[4][2], B0[2][2], B1[2][2];
    const char* cA = (const char*)g.A + (size_t)cur.pm * tstepA; const char* cB = (const char*)g.Bt + (size_t)cur.pn * tstepB;
    S.a_ready(cur);
    if constexpr (SP2) {
        PG8_STAGE(PG8_SB(0, 0), cB, voffB); PG8_STAGE(PG8_SB(0, 1), cB + hstepB, voffB); PG8_STAGE(PG8_SA(0, 0), cA, voffA); PG8_STAGE(PG8_SA(0, 1), cA + hstepA, voffA);
        if (wr == 1) PG8_BAR;
        PG8_WAIT_V(2); PG8_BAR;
        PG8_STAGE(PG8_SB(1, 0), cB + kstep, voffB); PG8_STAGE(PG8_SA(1, 0), cA + kstep, voffA); PG8_STAGE(PG8_SB(1, 1), cB + hstepB + kstep, voffB);
        PG8_WAIT_V(6); PG8_BAR;
    } else {
        PG8_STAGE(PG8_SB(0, 0), cB, voffB); PG8_STAGE(PG8_SA(0, 0), cA, voffA); PG8_STAGE(PG8_SB(0, 1), cB + hstepB, voffB); PG8_STAGE(PG8_SA(0, 1), cA + hstepA, voffA);
        if (wr == 1) PG8_BAR;
        PG8_WAIT_V(4); PG8_BAR;
        PG8_STAGE(PG8_SB(1, 0), cB + kstep, voffB); PG8_STAGE(PG8_SA(1, 0), cA + kstep, voffA); PG8_STAGE(PG8_SB(1, 1), cB + hstepB + kstep, voffB);
        PG8_WAIT_V(6); PG8_BAR;
    }
    for (;;) {
        const bool has_next = S.next(ui + 1, nxt);
        const char* nA = has_next ? (const char*)g.A + (size_t)nxt.pm * tstepA : cA; const char* nB = has_next ? (const char*)g.Bt + (size_t)nxt.pn * tstepB : cB;
#pragma unroll 1
        for (int t = 0; t < nt; t += 2) {
            const bool last = (t == nt - 2);
            const char* a1 = cA + (size_t)(t + 1) * kstep;
            const char* a2 = last ? nA : cA + (size_t)(t + 2) * kstep; const char* b2 = last ? nB : cB + (size_t)(t + 2) * kstep;
            const char* a3 = a2 + kstep; const char* b3 = b2 + kstep;
            if (last && has_next) S.a_ready(nxt);
            if constexpr (SP2) {
            PG8_LDB(B0, 0, 0); PG8_LDB(B1, 0, 1); PG8_SCHED; PG8_LDA(At, 0, 0); PG8_STAGE(PG8_SA(1, 1), a1 + hstepA, voffA);
            PG8_WAIT_V(8); PG8_WAIT_L(0); PG8_BAR; PG8_MMA(0, 0, At, B0); PG8_MMA(0, 1, At, B1); PG8_BAR; PG8_SCHED;
            PG8_LDA(At, 0, 1); PG8_STAGE(PG8_SB(0, 0), b2, voffB); PG8_STAGE(PG8_SB(0, 1), b2 + hstepB, voffB); PG8_STAGE(PG8_SA(0, 0), a2, voffA);
            PG8_WAIT_V(8); PG8_WAIT_L(0); PG8_BAR; PG8_MMA(1, 0, At, B0); PG8_MMA(1, 1, At, B1); PG8_BAR; PG8_SCHED;
            PG8_LDB(B0, 1, 0); PG8_LDB(B1, 1, 1); PG8_SCHED; PG8_LDA(At, 1, 0); PG8_STAGE(PG8_SA(0, 1), a2 + hstepA, voffA);
            PG8_WAIT_V(8); PG8_WAIT_L(0); PG8_BAR; PG8_MMA(0, 0, At, B0); PG8_MMA(0, 1, At, B1); PG8_BAR; PG8_SCHED;
            PG8_LDA(At, 1, 1); PG8_STAGE(PG8_SB(1, 0), b3, voffB); PG8_STAGE(PG8_SB(1, 1), b3 + hstepB, voffB); PG8_STAGE(PG8_SA(1, 0), a3, voffA);
            PG8_WAIT_V(8); PG8_WAIT_L(0); PG8_BAR; PG8_MMA(1, 0, At, B0); PG8_MMA(1, 1, At, B1); PG8_BAR; PG8_SCHED;
            } else {
            PG8_LDB(B0, 0, 0); PG8_SCHED; PG8_LDA(At, 0, 0); PG8_STAGE(PG8_SA(1, 1), a1 + hstepA, voffA);
            PG8_WAIT_L(8); PG8_BAR; PG8_WAIT_L(0); PG8_MMA(0, 0, At, B0); PG8_BAR; PG8_SCHED;
            PG8_LDB(B1, 0, 1); PG8_STAGE(PG8_SB(0, 0), b2, voffB);
            PG8_BAR; PG8_WAIT_L(0); PG8_MMA(0, 1, At, B1); PG8_BAR;
            PG8_LDA(At, 0, 1); PG8_STAGE(PG8_SA(0, 0), a2, voffA);
            PG8_BAR; PG8_WAIT_L(0); PG8_MMA(1, 0, At, B0); PG8_BAR; PG8_SCHED;
            PG8_STAGE(PG8_SB(0, 1), b2 + hstepB, voffB);
            PG8_WAIT_V(6); PG8_BAR; PG8_MMA(1, 1, At, B1); PG8_BAR;
            PG8_LDB(B0, 1, 0); PG8_SCHED; PG8_LDA(At, 1, 0); PG8_STAGE(PG8_SA(0, 1), a2 + hstepA, voffA);
            PG8_WAIT_L(8); PG8_BAR; PG8_WAIT_L(0); PG8_MMA(0, 0, At, B0); PG8_BAR; PG8_SCHED;
            PG8_LDB(B1, 1, 1); PG8_STAGE(PG8_SB(1, 0), b3, voffB);
            PG8_BAR; PG8_WAIT_L(0); PG8_MMA(0, 1, At, B1); PG8_BAR;
            PG8_LDA(At, 1, 1); PG8_STAGE(PG8_SA(1, 0), a3, voffA);
            PG8_BAR; PG8_WAIT_L(0); PG8_MMA(1, 0, At, B0); PG8_BAR; PG8_SCHED;
            PG8_STAGE(PG8_SB(1, 1), b3 + hstepB, voffB);
            PG8_WAIT_V(6); PG8_BAR; PG8_MMA(1, 1, At, B1); PG8_BAR;
            }
        }
        if constexpr (ALIGN_EPI) { if (wr == 0) PG8_BAR; }
        if constexpr (!Epi::AFTER_DRAIN) { E(acc, cur, wr, wc, fr, fq); S.done(cur); }
        if (!has_next) break;
#pragma unroll
        for (int a = 0; a < 2; ++a)
#pragma unroll
            for (int b = 0; b < 2; ++b)
#pragma unroll
                for (int m = 0; m < 4; ++m)
#pragma unroll
                    for (int n = 0; n < 2; ++n) acc[a][b][m][n] = (f32x4){0.f, 0.f, 0.f, 0.f};
        cur = nxt; cA = nA; cB = nB; ++ui;
        if constexpr (ALIGN_EPI) { if (wr == 1) PG8_BAR; }
    }
    PG8_WAIT_V(0);
    if constexpr (!ALIGN_EPI) { if (wr == 0) PG8_BAR; }
    PG8_BAR;
#undef PG8_SA
#undef PG8_SB
#undef PG8_STAGE
#undef PG8_LDA
#undef PG8_LDB
#undef PG8_MMA
#undef PG8_WAIT_V
#undef PG8_WAIT_L
#undef PG8_BAR
#undef PG8_SCHED
}
}

namespace att {
using bf16x8 = __attribute__((ext_vector_type(8))) short;
using s16x4  = __attribute__((ext_vector_type(4))) short;
using f32x16 = __attribute__((ext_vector_type(16))) float;
using f32x4  = __attribute__((ext_vector_type(4))) float;
using u32x4  = __attribute__((ext_vector_type(4))) unsigned;
typedef unsigned short bf16_t;
constexpr int NW = 8, QBLK = 32, KVBLK = 64;
constexpr int SHM_V = 8192, SHM_KN = 8192, SHM_KR = 4096;
constexpr int OFF_V = 0, OFF_KN = 2 * SHM_V, OFF_KR = OFF_KN + 2 * SHM_KN, OFF_WS = OFF_KR + 2 * SHM_KR, OFF_BIAS = OFF_WS + NW * 64 * 4 + 1024  , LDS_BYTES = OFF_BIAS + 15 * 32 * 4 + 1024;
#define ATT_SBAR() __builtin_amdgcn_sched_barrier(0)
__device__ __forceinline__ int crow(int r, int hi) { return (r & 3) + 8 * (r >> 2) + 4 * hi; }
__device__ __forceinline__ unsigned cvtpk(float lo, float hi) { return pg8::cvt_pk_bf16(lo, hi); }
__device__ __forceinline__ float bf2f(short s) { return __uint_as_float(((unsigned)(unsigned short)s) << 16); }
__device__ __forceinline__ int kn_off(int row, int chunk) { return row * 128 + ((chunk ^ ((row >> 1) & 7)) << 4); }
__device__ __forceinline__ int kr_off(int row, int chunk) { return row * 64 + ((chunk ^ ((row >> 2) & 3)) << 4); }
__device__ __forceinline__ int v_st(int k, int c) { const int kk = (k & ~0xC) | ((k & 4) << 1) | ((k & 8) >> 1); return ((kk >> 3) * 2 + (c >> 5)) * 512 + ((kk & 7) * 32 + (c & 31)) * 2; }
__device__ __forceinline__ int v_rd_base(int lane) { return ((lane & 3) << 3) | (((lane >> 2) & 3) << 6) | (((lane >> 4) & 1) << 5) | (((lane >> 5) & 1) << 8); }
constexpr int v_rd_off(int d0, int ks, int half) { return d0 * 512 + ks * 2048 + half * 1024; }
template <int OFF> __device__ __forceinline__ s16x4 tr_read(int vb) { s16x4 r; asm volatile("ds_read_b64_tr_b16 %0, %1 offset:%2" : "=&v"(r) : "v"(vb), "i"(OFF) : "memory"); return r; }

template <int D0> __device__ __forceinline__ void pv_one(f32x16& od, int vb, bf16x8 pa0, bf16x8 pa1, bf16x8 pa2, bf16x8 pa3) {
  const s16x4 l0 = tr_read<v_rd_off(D0, 0, 0)>(vb), h0 = tr_read<v_rd_off(D0, 0, 1)>(vb), l1 = tr_read<v_rd_off(D0, 1, 0)>(vb), h1 = tr_read<v_rd_off(D0, 1, 1)>(vb);
  const s16x4 l2 = tr_read<v_rd_off(D0, 2, 0)>(vb), h2 = tr_read<v_rd_off(D0, 2, 1)>(vb), l3 = tr_read<v_rd_off(D0, 3, 0)>(vb), h3 = tr_read<v_rd_off(D0, 3, 1)>(vb);
  asm volatile("s_waitcnt lgkmcnt(0)" ::: "memory"); ATT_SBAR();
#define ATT_PK(L, H) (bf16x8){L[0], L[1], L[2], L[3], H[0], H[1], H[2], H[3]}
  od = __builtin_amdgcn_mfma_f32_32x32x16_bf16(pa0, ATT_PK(l0, h0), od, 0, 0, 0);
  od = __builtin_amdgcn_mfma_f32_32x32x16_bf16(pa1, ATT_PK(l1, h1), od, 0, 0, 0);
  od = __builtin_amdgcn_mfma_f32_32x32x16_bf16(pa2, ATT_PK(l2, h2), od, 0, 0, 0);
  od = __builtin_amdgcn_mfma_f32_32x32x16_bf16(pa3, ATT_PK(l3, h3), od, 0, 0, 0);
#undef ATT_PK
}

template <int DKR> struct Cst { static constexpr float SCALE = DKR ? 0.10206207261596577f : 0.125f; static constexpr float C = SCALE * 1.4426950408889634f; };

template <int DKR> __device__ __forceinline__ void partialSM(f32x16& p0, f32x16& p1, float& m_reg, float& alpha) {
  constexpr float C = Cst<DKR>::C;
  float pmax = p0[0];
#pragma unroll
  for (int r = 1; r < 16; ++r) pmax = fmaxf(pmax, p0[r]);
#pragma unroll
  for (int r = 0; r < 16; ++r) pmax = fmaxf(pmax, p1[r]);
  { auto rr = __builtin_amdgcn_permlane32_swap(__float_as_uint(pmax), __float_as_uint(pmax), false, false);
    pmax = fmaxf(__uint_as_float(rr[0]), __uint_as_float(rr[1])); }
  float mn;
  if (__builtin_expect(__all(pmax <= m_reg), 1)) { mn = m_reg; alpha = 1.f; }
  else { mn = fmaxf(m_reg, pmax); alpha = __builtin_amdgcn_exp2f((m_reg - mn) * C); m_reg = mn; }
  const float mnC = -mn * C;
#pragma unroll
  for (int r = 0; r < 16; ++r) p0[r] = fmaf(p0[r], C, mnC);
#pragma unroll
  for (int r = 0; r < 16; ++r) p1[r] = fmaf(p1[r], C, mnC);
#pragma unroll
  for (int r = 0; r < 16; ++r) p0[r] = __builtin_amdgcn_exp2f(p0[r]);
}
__device__ __forceinline__ void finishSM(f32x16& p0, f32x16& p1, float alpha, float& l_reg, bf16x8& pa0, bf16x8& pa1, bf16x8& pa2, bf16x8& pa3) {
#pragma unroll
  for (int r = 0; r < 16; ++r) p1[r] = __builtin_amdgcn_exp2f(p1[r]);
  float ps = 0;
#pragma unroll
  for (int r = 0; r < 16; ++r) ps += p0[r];
#pragma unroll
  for (int r = 0; r < 16; ++r) ps += p1[r];
  { auto rr = __builtin_amdgcn_permlane32_swap(__float_as_uint(ps), __float_as_uint(ps), false, false);
    ps = __uint_as_float(rr[0]) + __uint_as_float(rr[1]); }
  l_reg = l_reg * alpha + ps;
#define ATT_PK4(P, BASE, OUT) do { unsigned a0 = cvtpk(P[BASE + 0], P[BASE + 1]), a1 = cvtpk(P[BASE + 2], P[BASE + 3]);   \
    unsigned b0 = cvtpk(P[BASE + 4], P[BASE + 5]), b1 = cvtpk(P[BASE + 6], P[BASE + 7]);                              \
    auto r0 = __builtin_amdgcn_permlane32_swap(a0, b0, false, false); auto r1 = __builtin_amdgcn_permlane32_swap(a1, b1, false, false); \
    u32x4 w = {r0[0], r1[0], r0[1], r1[1]}; OUT = *reinterpret_cast<bf16x8*>(&w); } while (0)
  ATT_PK4(p0, 0, pa0); ATT_PK4(p0, 8, pa1); ATT_PK4(p1, 0, pa2); ATT_PK4(p1, 8, pa3);
#undef ATT_PK4
}
template <int DKR> __device__ __forceinline__ void qkt(f32x16& p0, f32x16& p1, const char* Kn, const char* Kr, const bf16x8* qr, int r32, int hi) {
  p0 = f32x16{}; p1 = f32x16{};
#pragma unroll
  for (int d0 = 0; d0 < 4; ++d0) {
    const bf16x8 b0 = *reinterpret_cast<const bf16x8*>(Kn + kn_off(r32, d0 * 2 + hi));
    const bf16x8 b1 = *reinterpret_cast<const bf16x8*>(Kn + kn_off(32 + r32, d0 * 2 + hi));
    p0 = __builtin_amdgcn_mfma_f32_32x32x16_bf16(b0, qr[d0], p0, 0, 0, 0);
    p1 = __builtin_amdgcn_mfma_f32_32x32x16_bf16(b1, qr[d0], p1, 0, 0, 0); }
  if constexpr (DKR != 0) {
#pragma unroll
    for (int d0 = 0; d0 < 2; ++d0) {
      const bf16x8 b0 = *reinterpret_cast<const bf16x8*>(Kr + kr_off(r32, d0 * 2 + hi));
      const bf16x8 b1 = *reinterpret_cast<const bf16x8*>(Kr + kr_off(32 + r32, d0 * 2 + hi));
      p0 = __builtin_amdgcn_mfma_f32_32x32x16_bf16(b0, qr[4 + d0], p0, 0, 0, 0);
      p1 = __builtin_amdgcn_mfma_f32_32x32x16_bf16(b1, qr[4 + d0], p1, 0, 0, 0); }
  }
}

__device__ __forceinline__ void na_mask(f32x16& p0, f32x16& p1, const char* brow_b, int a, bool tile_ok) {
  const float NEG = -INFINITY;
#pragma unroll
  for (int r = 0; r < 16; ++r) { const int cr = (r & 3) + 8 * (r >> 2);
    const float b0 = *reinterpret_cast<const float*>(brow_b + cr * 4), b1 = *reinterpret_cast<const float*>(brow_b + (cr + 32) * 4);
    const bool v0 = tile_ok && ((unsigned)(cr + a) < 16u), v1 = tile_ok && ((unsigned)(cr + 32 + a) < 16u);
    p0[r] = v0 ? fmaf(8.0f, b0, p0[r]) : NEG; p1[r] = v1 ? fmaf(8.0f, b1, p1[r]) : NEG; }
}
template <int DKR, bool NA = false>
__device__ __forceinline__ void attn_unit(const bf16_t* __restrict__ Qb, int ldq, const bf16_t* __restrict__ Kn, int ldk, const bf16_t* __restrict__ Kr, int ldkr,
                                          const bf16_t* __restrict__ Vh, int ldv, bf16_t* __restrict__ Ob, int ldo, int seq, const float* __restrict__ qtab, char* lds,
                                          const float* __restrict__ rpb_h = nullptr, int r0 = 0, int kstart = 0) {
  const int tid = opaque_v(threadIdx.x), wid = tid >> 6, lane = tid & 63, r32 = lane & 31, hi = lane >> 5;
  char* V_lds = lds + OFF_V; char* KN_lds = lds + OFF_KN; char* KR_lds = lds + OFF_KR;
  float* ws = (float*)(lds + OFF_WS) + wid * 64; float* li_l = ws; float* al_l = ws + 32;
  float m_reg = -1e30f, l_reg = 0; f32x16 o[2] = {}; bf16x8 qr[DKR ? 6 : 4];
  const bf16_t* Qw = Qb + (long)(wid * QBLK + r32) * ldq + hi * 8;
#pragma unroll
  for (int d0 = 0; d0 < 4; ++d0) qr[d0] = *reinterpret_cast<const bf16x8*>(Qw + d0 * 16);
  if constexpr (DKR != 0) {
    const bf16x8 x1 = *reinterpret_cast<const bf16x8*>(Qw + 64), x2 = *reinterpret_cast<const bf16x8*>(Qw + 80);
    const float* tb = qtab + (long)(wid * QBLK + r32) * 32 + hi * 8;
    const f32x4 c0 = *(const f32x4*)(tb), c1 = *(const f32x4*)(tb + 4), s0 = *(const f32x4*)(tb + 16), s1 = *(const f32x4*)(tb + 20);
    float y1[8], y2[8];
#pragma unroll
    for (int j = 0; j < 8; ++j) { const float a = bf2f(x1[j]), b = bf2f(x2[j]); const float cc = j < 4 ? c0[j & 3] : c1[j & 3], ss = j < 4 ? s0[j & 3] : s1[j & 3];
      y1[j] = a * cc - b * ss; y2[j] = b * cc + a * ss; }
    u32x4 w1 = {cvtpk(y1[0], y1[1]), cvtpk(y1[2], y1[3]), cvtpk(y1[4], y1[5]), cvtpk(y1[6], y1[7])};
    u32x4 w2 = {cvtpk(y2[0], y2[1]), cvtpk(y2[2], y2[3]), cvtpk(y2[4], y2[5]), cvtpk(y2[6], y2[7])};
    qr[4] = *reinterpret_cast<bf16x8*>(&w1); qr[5] = *reinterpret_cast<bf16x8*>(&w2);
  }
  const int sr = tid >> 3, sc8 = tid & 7, knst = kn_off(sr, sc8), vst = v_st(sr, sc8 * 8);
  const int rr_ = (tid >> 2) & 63, rc_ = tid & 3, krst = kr_off(rr_, rc_);
  const bool do_kr = (DKR != 0) && (tid < 256);
  const int vb0 = (int)(uintptr_t)V_lds + v_rd_base(lane);
  bf16x8 sK0, sV0, sR0, sK1, sV1, sR1;
  sR0 = bf16x8{}; sR1 = bf16x8{};
#define ATT_SLOAD(SK, SV, SR, k0) do { SK = *reinterpret_cast<const bf16x8*>(Kn + (long)((k0) + sr) * ldk + sc8 * 8); SV = *reinterpret_cast<const bf16x8*>(Vh + (long)((k0) + sr) * ldv + sc8 * 8); \
    if (do_kr) SR = *reinterpret_cast<const bf16x8*>(Kr + (long)((k0) + rr_) * ldkr + rc_ * 8); } while (0)
#define ATT_SWRITE(b, SK, SV, SR) do { *(bf16x8*)(V_lds + (b) * SHM_V + vst) = SV; *(bf16x8*)(KN_lds + (b) * SHM_KN + knst) = SK; \
    if (do_kr) *(bf16x8*)(KR_lds + (b) * SHM_KR + krst) = SR; } while (0)
#define ATT_RESC(a) do { if (__any((a) < 1.f)) { if (hi == 0) al_l[r32] = (a); asm volatile("s_waitcnt lgkmcnt(0)" ::: "memory"); \
    _Pragma("unroll") for (int d = 0; d < 2; ++d) _Pragma("unroll") for (int r = 0; r < 16; ++r) o[d][r] *= al_l[crow(r, hi)]; } } while (0)
  f32x16 pA0, pA1, pB0, pB1; float alA, alB; bf16x8 pa0, pa1, pa2, pa3; const int NT = seq / KVBLK;
  const int na_r = r0 + (wid >> 1), na_rs = min(max(na_r - 4, 0), 24), na_qc = (wid & 1) * 32 + r32, na_ws = min(max(na_qc - 8, 0), 48);
  const int na_a = 4 * hi - na_ws; const char* na_b0 = lds + OFF_BIAS + (4 * hi - na_qc + 15) * 4;
  if constexpr (NA) { float* bt = (float*)(lds + OFF_BIAS); if (tid < 15 * 32) bt[tid] = ((tid & 31) < 31) ? rpb_h[(tid >> 5) * 31 + (tid & 31)] : 0.f; }
#define ATT_NAMASK(P0, P1, t) do { if constexpr (NA) { const int kr_ = kstart + (t); const bool ok_ = (unsigned)(kr_ - na_rs) < 8u; const int ro_ = min(max(kr_ - na_r + 7, 0), 14); \
    na_mask(P0, P1, na_b0 + ro_ * 128, na_a, ok_); } } while (0)
  ATT_SLOAD(sK0, sV0, sR0, 0); ATT_SWRITE(0, sK0, sV0, sR0); __syncthreads();
  qkt<DKR>(pA0, pA1, KN_lds, KR_lds, qr, r32, hi); ATT_NAMASK(pA0, pA1, 0); partialSM<DKR>(pA0, pA1, m_reg, alA);
  ATT_SLOAD(sK1, sV1, sR1, KVBLK); if (2 < NT) ATT_SLOAD(sK0, sV0, sR0, 2 * KVBLK);
  ATT_SWRITE(1, sK1, sV1, sR1); __syncthreads();
  for (int j = 1; j + 1 < NT; j += 2) {
    ATT_SBAR(); qkt<DKR>(pB0, pB1, KN_lds + SHM_KN, KR_lds + SHM_KR, qr, r32, hi); ATT_NAMASK(pB0, pB1, j);
    finishSM(pA0, pA1, alA, l_reg, pa0, pa1, pa2, pa3); ATT_SBAR();
    ATT_SLOAD(sK1, sV1, sR1, (j + 2) * KVBLK); ATT_SBAR();
    pv_one<0>(o[0], vb0, pa0, pa1, pa2, pa3); pv_one<1>(o[1], vb0, pa0, pa1, pa2, pa3); partialSM<DKR>(pB0, pB1, m_reg, alB);
    __syncthreads(); ATT_SWRITE(0, sK0, sV0, sR0);
    ATT_RESC(alB); __syncthreads();
    ATT_SBAR(); qkt<DKR>(pA0, pA1, KN_lds, KR_lds, qr, r32, hi); ATT_NAMASK(pA0, pA1, j + 1);
    finishSM(pB0, pB1, alB, l_reg, pa0, pa1, pa2, pa3); ATT_SBAR();
    if (j + 3 < NT) ATT_SLOAD(sK0, sV0, sR0, (j + 3) * KVBLK); ATT_SBAR();
    pv_one<0>(o[0], vb0 + SHM_V, pa0, pa1, pa2, pa3); pv_one<1>(o[1], vb0 + SHM_V, pa0, pa1, pa2, pa3); partialSM<DKR>(pA0, pA1, m_reg, alA);
    __syncthreads(); ATT_SWRITE(1, sK1, sV1, sR1);
    ATT_RESC(alA); __syncthreads();
  }
  ATT_SBAR(); qkt<DKR>(pB0, pB1, KN_lds + SHM_KN, KR_lds + SHM_KR, qr, r32, hi); ATT_NAMASK(pB0, pB1, NT - 1);
  finishSM(pA0, pA1, alA, l_reg, pa0, pa1, pa2, pa3); ATT_SBAR();
  pv_one<0>(o[0], vb0, pa0, pa1, pa2, pa3); pv_one<1>(o[1], vb0, pa0, pa1, pa2, pa3); partialSM<DKR>(pB0, pB1, m_reg, alB);
  __syncthreads(); ATT_RESC(alB);
  finishSM(pB0, pB1, alB, l_reg, pa0, pa1, pa2, pa3); ATT_SBAR();
  pv_one<0>(o[0], vb0 + SHM_V, pa0, pa1, pa2, pa3); pv_one<1>(o[1], vb0 + SHM_V, pa0, pa1, pa2, pa3);
  if (hi == 0) li_l[r32] = l_reg; asm volatile("s_waitcnt lgkmcnt(0)" ::: "memory");
  float rli[16];
#pragma unroll
  for (int r = 0; r < 16; ++r) rli[r] = __builtin_amdgcn_rcpf(li_l[crow(r, hi)]);
  bf16_t* Ow = Ob + (long)(wid * QBLK) * ldo;
#pragma unroll
  for (int r = 0; r < 16; ++r) { const int orow = crow(r, hi);
#pragma unroll
    for (int d0 = 0; d0 < 2; ++d0) { const float v = o[d0][r] * rli[r]; Ow[(long)orow * ldo + d0 * 32 + r32] = (bf16_t)(cvtpk(v, v) & 0xffffu); } }
  __syncthreads();
#undef ATT_SLOAD
#undef ATT_SWRITE
#undef ATT_RESC
#undef ATT_NAMASK
}
#undef ATT_SBAR
}

constexpr int NWAVES = 8;
constexpr int BATCH = 8, SEQ = 2048, DM = 1024, DEPTH = 2, M = BATCH * SEQ;
constexpr int GRID_W = 64, NROWS = SEQ / GRID_W;
constexpr int IN_COLS = 5024, N1 = 2048  , NG = 3072, N1_USED = 1952;
constexpr int FFN = 2816, NMOD = 6;
constexpr float NORM_EPS = 1e-6f;
constexpr int C_QA = 0, C_KA = 256, C_VA = 512, C_CQ = 768, C_CKV = 1024, C_KR = 1152, C_QC = 1184, C_KC = 1696, C_VC = 1824;

constexpr size_t MiB = 1u << 20;
constexpr size_t WS_CTL = 0, CTL_ZERO_BYTES = 64 * 1024;
constexpr size_t WS_MOD = 1 * MiB;
constexpr size_t WS_TABT = WS_MOD + 512 * 1024;
constexpr size_t WS_TABA = WS_TABT + 256 * 1024;
constexpr size_t WS_W = 2 * MiB;
constexpr size_t W_1 = 0, W_G = W_1 + (size_t)N1 * DM * 2, W_2 = W_G + (size_t)NG * DM * 2, W_BNA = W_2 + (size_t)1024 * 384 * 2, W_BMLA = W_BNA + (size_t)1024 * 256 * 2,
                 W_BGQA = W_BMLA + (size_t)1024 * 256 * 2, W_OUT = W_BGQA + (size_t)1024 * 512 * 2, W_GU = W_OUT + (size_t)1024 * 1024 * 2, W_DN = W_GU + (size_t)2 * FFN * DM * 2,
                 LAYER_W_BYTES = W_DN + (size_t)DM * FFN * 2;
static_assert(LAYER_W_BYTES == 32768000, "weights per layer");
constexpr size_t WS_H = 66 * MiB;
constexpr size_t WS_P1 = 98 * MiB;
constexpr size_t WS_KPE = 162 * MiB;
constexpr size_t WS_QC = 163 * MiB;
constexpr size_t WS_KC = 179 * MiB;
constexpr size_t WS_P2 = 183 * MiB;
constexpr size_t WS_OCAT = 215 * MiB;
constexpr size_t WS_A2 = 215 * MiB;
constexpr size_t WS_GATES = 98 * MiB;
constexpr size_t WS_ACT = 98 * MiB;
constexpr size_t WS_END = 247 * MiB;
static_assert(WS_W + 2 * LAYER_W_BYTES <= WS_H && WS_GATES + (size_t)M * NG * 2 <= WS_OCAT && WS_ACT + (size_t)M * FFN * 2 <= WS_OCAT, "ws map");
constexpr int CW_BAR = 4096;

constexpr int RING_OFF = 0, RING_BYTES = 131072;
constexpr int LDSCTL_OFF = RING_BYTES, MISC_OFF = LDSCTL_OFF + 320;
constexpr int LDS_BYTES = 147456;

#define GAS __attribute__((address_space(1)))
#define LAS __attribute__((address_space(3)))
typedef unsigned short bf16;
typedef unsigned v4u __attribute__((ext_vector_type(4)));
typedef unsigned v2u __attribute__((ext_vector_type(2)));
typedef float f32x4 __attribute__((ext_vector_type(4)));
typedef short bf16x8 __attribute__((ext_vector_type(8)));
typedef GAS unsigned gu32;
#define RLX_AGENT __ATOMIC_RELAXED, __HIP_MEMORY_SCOPE_AGENT
#define LDS_WAIT() asm volatile("s_waitcnt lgkmcnt(0)" ::: "memory")
__device__ __forceinline__ unsigned f2bf(float f) { unsigned u = __builtin_bit_cast(unsigned, f); return (u + 0x7fffu + ((u >> 16) & 1u)) >> 16; }
__device__ __forceinline__ unsigned pk2(float lo, float hi) { return f2bf(lo) | (f2bf(hi) << 16); }
__device__ __forceinline__ float bflo(unsigned w) { return __uint_as_float(w << 16); }
__device__ __forceinline__ float bfhi(unsigned w) { return __uint_as_float(w & 0xffff0000u); }
__device__ __forceinline__ float bf1(bf16 s) { return __uint_as_float(((unsigned)s) << 16); }

#define XB_TMO      128
#define XB_XCNT(j)  (256  + 64 * (j))
#define XB_XSUB(j)  (1280 + 64 * (j))
#define XB_XGEN(j)  (2304 + 64 * (j))
#define XB_TOP      3328
#define XB_TOPGEN   3392
#define XCD_BAR_WORDS 3456
#define XB_SPIN_CAP (1u << 18)
__device__ __forceinline__ unsigned xb_ld(unsigned* p)              { return __hip_atomic_load(p, __ATOMIC_RELAXED, __HIP_MEMORY_SCOPE_AGENT); }
__device__ __forceinline__ unsigned xb_add(unsigned* p, unsigned v) { return __hip_atomic_fetch_add(p, v, __ATOMIC_RELAXED, __HIP_MEMORY_SCOPE_AGENT); }
__device__ __forceinline__ unsigned xb_xcc_id() { return (unsigned)__builtin_amdgcn_s_getreg((3 << 11) | 20) & 0xFu; }
#define XB_SPIN(cond, bar) do { unsigned _sp = 0; while (cond) { __builtin_amdgcn_s_sleep(1); \
    if ((++_sp & 255u) == 0u) { if (xb_ld(&(bar)[XB_TMO])) break; if (_sp > XB_SPIN_CAP) { atomicAdd(&(bar)[XB_TMO], 1u); break; } } } } while (0)
struct XcdBarrier { unsigned* bar; unsigned x; volatile LAS unsigned* st; };
__device__ __forceinline__ XcdBarrier xcd_barrier_post(unsigned* bar, volatile LAS unsigned* st) {
    XcdBarrier b; b.bar = bar; b.x = xb_xcc_id(); b.st = st;
    if (threadIdx.x == 0) (void)xb_add(&bar[XB_XCNT(b.x)], 1u);
    return b;
}
__device__ __forceinline__ void xcd_barrier_complete(unsigned* bar, unsigned x, unsigned& nloc, unsigned& nx) {
    const unsigned G = gridDim.x * gridDim.y * gridDim.z;
    unsigned sum, cnt, mine, sp = 0u;
    for (;;) {
        sum = 0u; cnt = 0u; mine = 0u;
#pragma unroll
        for (unsigned j = 0; j < 16; ++j) { const unsigned c = xb_ld(&bar[XB_XCNT(j)]); sum += c; cnt += (c > 0u) ? 1u : 0u; mine = (j == x) ? c : mine; }
        if (sum == G) break;
        __builtin_amdgcn_s_sleep(1);
        if ((++sp & 255u) == 0u) { if (xb_ld(&bar[XB_TMO])) break; if (sp > XB_SPIN_CAP) { atomicAdd(&bar[XB_TMO], 1u); break; } }
    }
    nloc = mine > 0u ? mine : 1u; nx = cnt > 0u ? cnt : 1u;
}
__device__ __forceinline__ void xcd_barrier(const XcdBarrier& b) {
    asm volatile("s_waitcnt vmcnt(0)" ::: "memory");
    __syncthreads();
    if (threadIdx.x == 0) {
        unsigned* bar = b.bar;
        __builtin_amdgcn_s_waitcnt(0);
        unsigned nloc = b.st[0], nx = b.st[1];
        if (nloc == 0u) { xcd_barrier_complete(bar, b.x, nloc, nx); b.st[0] = nloc; b.st[1] = nx; }
        const unsigned old = xb_add(&bar[XB_XSUB(b.x)], 1u);
        const unsigned gen = old / nloc;
        if (old + 1u == (gen + 1u) * nloc) {
            __builtin_amdgcn_fence(__ATOMIC_RELEASE, "agent");
            asm volatile("s_waitcnt vmcnt(0)" ::: "memory");
            const unsigned og = xb_add(&bar[XB_TOP], 1u);
            const unsigned tg = og / nx;
            if (og + 1u == (tg + 1u) * nx) xb_add(&bar[XB_TOPGEN], 1u);
            else XB_SPIN(xb_ld(&bar[XB_TOPGEN]) == tg, bar);
            __builtin_amdgcn_fence(__ATOMIC_ACQUIRE, "agent");
            xb_add(&bar[XB_XGEN(b.x)], 1u);
            asm volatile("s_waitcnt vmcnt(0)" ::: "memory");
        } else {
            XB_SPIN(xb_ld(&bar[XB_XGEN(b.x)]) == gen, bar);
            __builtin_amdgcn_fence(__ATOMIC_ACQUIRE, "agent");
            asm volatile("s_waitcnt vmcnt(0)" ::: "memory");
        }
    }
    __syncthreads();
}

struct Args { const float* in[21]; float* out; unsigned char* ws; int ph_lo, ph_hi; };
struct LayerW { bf16 *w1, *wg, *w2, *bna, *bmla, *bgqa, *wout, *wgu, *wdn; };
__device__ __forceinline__ LayerW layer_w(unsigned char* ws, int l) {
    unsigned char* b = ws + WS_W + (size_t)l * LAYER_W_BYTES; LayerW w;
    w.w1 = (bf16*)(b + W_1); w.wg = (bf16*)(b + W_G); w.w2 = (bf16*)(b + W_2); w.bna = (bf16*)(b + W_BNA); w.bmla = (bf16*)(b + W_BMLA); w.bgqa = (bf16*)(b + W_BGQA);
    w.wout = (bf16*)(b + W_OUT); w.wgu = (bf16*)(b + W_GU); w.wdn = (bf16*)(b + W_DN); return w;
}
__device__ __forceinline__ float wave_sum(float v) {
#pragma unroll
    for (int o = 1; o < 64; o <<= 1) v += __shfl_xor(v, o);
    return v;
}
__device__ __forceinline__ void sincos_d(double x, double& s, double& c) {
    const double k = __builtin_rint(x * 0.15915494309189535);
    double r = __builtin_fma(-k, 6.283185307179586, x); r = __builtin_fma(-k, 2.4492935982947064e-16, r);
    const double r2 = r * r; double tc = 1.0, ts = 1.0, cs = 1.0, ss = 1.0;
#pragma unroll 1
    for (int n = 1; n <= 15; ++n) { tc *= -r2 / (double)((2 * n - 1) * (2 * n)); cs += tc; ts *= -r2 / (double)((2 * n) * (2 * n + 1)); ss += ts; }
    s = r * ss; c = cs;
}
__device__ __forceinline__ float inv_freq(int i) {
    const float q[4] = {1.0f, 0.5623413251903491f, 0.31622776601683794f, 0.17782794100389228f};
    const float p[4] = {1.0f, 0.1f, 0.01f, 0.001f};
    float a = (i & 3) == 0 ? q[0] : (i & 3) == 1 ? q[1] : (i & 3) == 2 ? q[2] : q[3];
    float b = (i >> 2) == 0 ? p[0] : (i >> 2) == 1 ? p[1] : (i >> 2) == 2 ? p[2] : p[3];
    return (float)((double)a * (double)b);
}

template <class RowPtr>
__device__ __forceinline__ void transpose_item(const float* W, int N, int k0, int n0, const RowPtr& rp, LAS float* scr, int lane) {
#pragma unroll 8
    for (int i = 0; i < 32; ++i) { const int kk = 2 * i + (lane >> 5); scr[kk * 33 + (lane & 31)] = W[(size_t)(k0 + kk) * N + n0 + (lane & 31)]; }
    LDS_WAIT(); asm volatile("" ::: "memory");
    const int c = lane & 7;
#pragma unroll
    for (int j = 0; j < 4; ++j) { const int n = (lane >> 3) + 8 * j; const LAS float* s = scr + (8 * c) * 33 + n;
        v4u o; o.x = pk2(s[0 * 33], s[1 * 33]); o.y = pk2(s[2 * 33], s[3 * 33]); o.z = pk2(s[4 * 33], s[5 * 33]); o.w = pk2(s[6 * 33], s[7 * 33]);
        *(GAS v4u*)(rp(n0 + n) + k0 + 8 * c) = o; }
    LDS_WAIT(); asm volatile("" ::: "memory");
}
struct RpPlain { bf16* base; int ld; int roff; int koff; __device__ __forceinline__ bf16* operator()(int n) const { return base + (size_t)(n + roff) * ld + koff; } };
struct RpWin { bf16* w1; bf16* wg; __device__ __forceinline__ bf16* operator()(int n) const { return n < N1_USED ? w1 + (size_t)n * DM : wg + (size_t)(n - N1_USED) * DM; } };
struct RpGU { bf16* base; __device__ __forceinline__ bf16* operator()(int n) const { const int j = n < FFN ? n : n - FFN; return base + (size_t)(256 * (j >> 7) + (n < FFN ? 0 : 128) + (j & 127)) * DM; } };


#ifndef SELFCHECK
#define SELFCHECK 0
#endif
#if SELFCHECK
constexpr size_t WS_SAVE = WS_TABA + 16 * 1024;
constexpr int CW_FLAGS = 64;
__device__ __forceinline__ unsigned hash_u(unsigned x) { x ^= x >> 16; x *= 0x7feb352dU; x ^= x >> 15; x *= 0x846ca68bU; x ^= x >> 16; return x; }
__device__ __forceinline__ bool nclose(float a, float ref, float tol) { return !(fabsf(a - ref) <= tol); }
__device__ __forceinline__ int save_row(int s) { return (s * 509 + 13) % M; }
template <int ST> __device__ __forceinline__ void selfcheck(const Args& args, int l, unsigned* flags) {
    unsigned char* ws = args.ws;
    const int gtid = opaque_v(blockIdx.x * (NWAVES * 64) + threadIdx.x);
    const unsigned hsh = hash_u((unsigned)gtid * 2654435761u + ST * 977u + l * 7919u);
    const float* modp = (const float*)(ws + WS_MOD); const float* tabt = (const float*)(ws + WS_TABT); const float* taba = (const float*)(ws + WS_TABA);
    const bf16* Hb = (const bf16*)(ws + WS_H); const bf16* P1 = (const bf16*)(ws + WS_P1); const bf16* KPE = (const bf16*)(ws + WS_KPE); const bf16* QC = (const bf16*)(ws + WS_QC); const bf16* KC = (const bf16*)(ws + WS_KC);
    const bf16* P2 = (const bf16*)(ws + WS_P2); const bf16* OCAT = (const bf16*)(ws + WS_OCAT); const bf16* A2 = (const bf16*)(ws + WS_A2); const bf16* GATES = (const bf16*)(ws + WS_GATES); const bf16* ACT = (const bf16*)(ws + WS_ACT);
    float* saved = (float*)(ws + WS_SAVE);
    const float* mod = modp + (size_t)l * BATCH * NMOD * DM;
    const float* xcur = (l == 0) ? args.in[0] : args.out; const float* xres = args.out;
    bool bad = false;
    const int m = hsh % M, b = m / SEQ, t = m % SEQ; const unsigned h2 = hsh >> 14;
    if constexpr (ST == 0) {
        const int ll = hsh & 1, bb = (hsh >> 1) & 7, j = (hsh >> 4) % (NMOD * DM); float ref = args.in[3][(size_t)ll * NMOD * DM + j];
        for (int k = 0; k < DM; ++k) { const float v = args.in[1][bb * DM + k]; ref += (v / (1.0f + expf(-v))) * args.in[2][((size_t)ll * DM + k) * (NMOD * DM) + j]; }
        bad = nclose(modp[((size_t)ll * BATCH + bb) * (NMOD * DM) + j], ref, 1e-3f + 1e-3f * fabsf(ref));
    } else if constexpr (ST == 1) {
        const int tt = hsh % SEQ, i = (hsh >> 11) & 15, p = (hsh >> 15) & 63;
        const float a1 = (float)tt * inv_freq(i), a2 = (float)p * inv_freq(i);
        bad = nclose(tabt[tt * 32 + i], cosf(a1), 2e-4f) || nclose(tabt[tt * 32 + 16 + i], sinf(a1), 2e-4f) || nclose(taba[p * 32 + i], cosf(a2), 2e-4f) || nclose(taba[p * 32 + 16 + i], sinf(a2), 2e-4f);
    } else if constexpr (ST == 2 || ST == 12) {
        const float* x = (ST == 2 ? xcur : xres) + (size_t)m * DM; const int c = h2 % DM; float ss = 0.f;
        for (int k = 0; k < DM; ++k) ss += x[k] * x[k];
        const float rstd = 1.0f / sqrtf(ss / DM + NORM_EPS); const float* g = args.in[ST == 2 ? 4 : 5] + (size_t)l * DM; const float* sh = mod + (size_t)b * NMOD * DM + (ST == 2 ? 0 : 3 * DM);
        const float ref = (x[c] * rstd * g[c]) * (1.0f + sh[DM + c]) + sh[c];
        bad = nclose(bf1(Hb[(size_t)m * DM + c]), ref, 0.01f + 0.01f * fabsf(ref));
    } else if constexpr (ST == 3 || ST == 9) {
        const int n = h2 % (ST == 3 ? N1_USED : NG); const int ncol = ST == 3 ? n : N1_USED + n; const float* W = args.in[6] + (size_t)l * DM * IN_COLS + ncol; float ref = 0.f, s2 = 0.f;
        for (int k = 0; k < DM; ++k) { const float p = bf1(Hb[(size_t)m * DM + k]) * W[(size_t)k * IN_COLS]; ref += p; s2 += p * p; }
        if (ST == 3) bad = nclose(bf1(P1[(size_t)m * N1 + n]), ref, 0.02f * sqrtf(s2) + 0.01f * fabsf(ref) + 1e-3f);
        else { const size_t gi = (size_t)m * NG + n; const unsigned wsys = __hip_atomic_load((unsigned*)(GATES + (gi & ~(size_t)1)), __ATOMIC_RELAXED, __HIP_MEMORY_SCOPE_SYSTEM);
            const bf16 vsys = (bf16)((gi & 1) ? (wsys >> 16) : (wsys & 0xffffu)); const bf16 vpl = GATES[gi];
            bad = nclose(bf1(vsys), 1.0f / (1.0f + expf(-ref)), 0.03f); if (vpl != vsys) atomicOr(flags, 1u << 15);
            { pg8::StaticOrder So; So.init(M, NG, 256, 0); int ui = 3; for (int L = 0; L < 768; ++L) { pg8::StaticOrder S1 = So; S1.c = L & 255; pg8::Unit u; S1.next(L >> 8, u); if (u.pm == m / 256 && u.pn == n / 256) ui = L >> 8; }
              atomicAdd(flags + 2 + ui, 1u); if (bad) atomicAdd(flags + 8 + ui, 1u); } }
    } else if constexpr (ST == 4) {
        const bf16* pr = P1 + (size_t)m * N1; const int which = h2 & 3; const unsigned h3 = hsh >> 16; const int prow = t / GRID_W, pcol = t % GRID_W;
        if (which == 0) { const int j = h3 % 384; const int base = j < 256 ? C_CQ : C_CKV, n = j < 256 ? 256 : 128, jj = j < 256 ? j : j - 256; float ss = 0.f;
            for (int k = 0; k < n; ++k) { const float v = bf1(pr[base + k]); ss += v * v; }
            const float g = j < 256 ? args.in[8][(size_t)l * 256 + jj] : args.in[9][(size_t)l * 128 + jj];
            const float ref = bf1(pr[base + jj]) / sqrtf(ss / n + NORM_EPS) * g; bad = nclose(bf1(A2[(size_t)m * 384 + j]), ref, 0.02f + 0.01f * fabsf(ref));
        } else if (which == 1) { const int j = h3 % 32, i = j & 15; const float x1 = bf1(pr[C_KR + i]), x2 = bf1(pr[C_KR + 16 + i]), c = tabt[t * 32 + i], sn = tabt[t * 32 + 16 + i];
            const float ref = j < 16 ? x1 * c - x2 * sn : x2 * c + x1 * sn; bad = nclose(bf1(KPE[(size_t)m * 32 + j]), ref, 0.02f + 0.01f * fabsf(ref));
        } else { const bool isq = which == 2; const int j = h3 % (isq ? 512 : 128), hd = j / 64, d = j % 64; const bf16* src = pr + (isq ? C_QC : C_KC) + hd * 64; float ss = 0.f;
            for (int k = 0; k < 64; ++k) { const float v = bf1(src[k]); ss += v * v; }
            const float rstd = 1.0f / sqrtf(ss / 64 + NORM_EPS); const float* g = args.in[isq ? 12 : 13] + (size_t)l * 64;
            const int part = d / 32, i = (d % 32) % 16; const bool second = (d % 32) >= 16; const int dp = second ? d - 16 : d + 16; const int pos = part == 0 ? prow : pcol;
            const float y = bf1(src[d]) * rstd * g[d], yp = bf1(src[dp]) * rstd * g[dp], c = taba[pos * 32 + i], sn = taba[pos * 32 + 16 + i];
            const float ref = second ? y * c + yp * sn : y * c - yp * sn;
            bad = nclose(bf1(isq ? QC[(size_t)m * 512 + j] : KC[(size_t)m * 128 + j]), ref, 0.02f + 0.01f * fabsf(ref)); }
    } else if constexpr (ST == 5) {
        const int n = h2 % 896; float ref = 0.f, s2 = 0.f;
        if (n < 384) { const float* W = args.in[10] + (size_t)l * 256 * 384 + n; for (int k = 0; k < 256; ++k) { const float p = bf1(A2[(size_t)m * 384 + k]) * W[(size_t)k * 384]; ref += p; s2 += p * p; } }
        else { const float* W = args.in[11] + (size_t)l * 128 * 512 + (n - 384); for (int k = 0; k < 128; ++k) { const float p = bf1(A2[(size_t)m * 384 + 256 + k]) * W[(size_t)k * 512]; ref += p; s2 += p * p; } }
        bad = nclose(bf1(P2[(size_t)m * 1024 + n]), ref, 0.02f * sqrtf(s2) + 0.01f * fabsf(ref) + 1e-3f);
    } else if constexpr (ST == 6) {
        if (blockIdx.x < 16) { const int h = h2 & 3, d = (h2 >> 2) & 63; const bf16* qp = P2 + (size_t)m * 1024 + h * 96; float q[96];
#pragma unroll
            for (int i = 0; i < 64; ++i) q[i] = bf1(qp[i]);
#pragma unroll
            for (int i = 0; i < 16; ++i) { const float x1 = bf1(qp[64 + i]), x2 = bf1(qp[80 + i]), c = tabt[t * 32 + i], sn = tabt[t * 32 + 16 + i]; q[64 + i] = x1 * c - x2 * sn; q[80 + i] = x2 * c + x1 * sn; }
            float mx = -1e30f, lsum = 0.f, o = 0.f;
            for (int kk = 0; kk < SEQ; ++kk) { const size_t mk = (size_t)b * SEQ + kk; const bf16* kn = P2 + mk * 1024 + 384 + h * 128; const bf16* kr = KPE + mk * 32; float sc = 0.f;
#pragma unroll
                for (int i = 0; i < 64; ++i) sc += q[i] * bf1(kn[i]);
#pragma unroll
                for (int i = 0; i < 32; ++i) sc += q[64 + i] * bf1(kr[i]);
                sc *= 0.10206207261596577f; const float mn = fmaxf(mx, sc), a = expf(mx - mn), p = expf(sc - mn); mx = mn; lsum = lsum * a + p; o = o * a + p * bf1(kn[64 + d]); }
            const float ref = o / lsum; bad = nclose(bf1(OCAT[(size_t)m * 1024 + 256 + h * 64 + d]), ref, 0.002f + 0.02f * fabsf(ref)); }
    } else if constexpr (ST == 7) {
        if (blockIdx.x < 16) { const int hq = h2 & 7, kvh = hq >> 2, d = (h2 >> 3) & 63; const bf16* qp = QC + (size_t)m * 512 + hq * 64; float q[64];
#pragma unroll
            for (int i = 0; i < 64; ++i) q[i] = bf1(qp[i]);
            float mx = -1e30f, lsum = 0.f, o = 0.f;
            for (int kk = 0; kk < SEQ; ++kk) { const size_t mk = (size_t)b * SEQ + kk; const bf16* kn = KC + mk * 128 + kvh * 64; float sc = 0.f;
#pragma unroll
                for (int i = 0; i < 64; ++i) sc += q[i] * bf1(kn[i]);
                sc *= 0.125f; const float mn = fmaxf(mx, sc), a = expf(mx - mn), p = expf(sc - mn); mx = mn; lsum = lsum * a + p; o = o * a + p * bf1(P1[mk * N1 + C_VC + kvh * 64 + d]); }
            const float ref = o / lsum; bad = nclose(bf1(OCAT[(size_t)m * 1024 + 512 + hq * 64 + d]), ref, 0.002f + 0.02f * fabsf(ref)); }
    } else if constexpr (ST == 8) {
        const int h = h2 & 3, d = (h2 >> 2) & 63, r = t / GRID_W, qc = t % GRID_W; const int rs = min(max(r - 4, 0), NROWS - 8), wst = min(max(qc - 8, 0), GRID_W - 16);
        const bf16* qp = P1 + (size_t)m * N1 + C_QA + h * 64; const float* rpb = args.in[7] + (size_t)l * 4 * 15 * 31; float mx = -1e30f, lsum = 0.f, o = 0.f;
        for (int i = 0; i < 8; ++i)
            for (int j = 0; j < 16; ++j) { const size_t tk = (size_t)b * SEQ + (size_t)(rs + i) * GRID_W + wst + j; const bf16* kp = P1 + tk * N1 + C_KA + h * 64; float s_ = 0.f;
                for (int k = 0; k < 64; ++k) s_ += bf1(qp[k]) * bf1(kp[k]);
                s_ = s_ * 0.125f + rpb[((size_t)h * 15 + (rs + i - r + 7)) * 31 + (wst + j - qc + 15)];
                const float mn = fmaxf(mx, s_), a = expf(mx - mn), p = expf(s_ - mn); mx = mn; lsum = lsum * a + p; o = o * a + p * bf1(P1[tk * N1 + C_VA + h * 64 + d]); }
        const float ref = o / lsum; bad = nclose(bf1(OCAT[(size_t)m * 1024 + h * 64 + d]), ref, 0.003f + 0.02f * fabsf(ref));
    } else if constexpr (ST == 10) {
        const int c = h2 % DM; float ref = 0.f;
        for (int br = 0; br < 3; ++br) { const int kk = br == 2 ? 512 : 256, off = br * 256; const float* W = args.in[14 + br] + (size_t)l * kk * DM + c; float y = 0.f;
            for (int k = 0; k < kk; ++k) y += bf1(OCAT[(size_t)m * 1024 + off + k]) * W[(size_t)k * DM];
            ref += bf1(GATES[(size_t)m * NG + br * 1024 + c]) * y; }
        bad = nclose(bf1(Hb[(size_t)m * DM + c]), ref, 0.002f + 0.03f * fabsf(ref));
        if (bad) atomicAdd(flags + 2, 1u); if (nclose(bf1(Hb[(size_t)m * DM + c]), ref, 0.01f + 0.15f * fabsf(ref))) atomicAdd(flags + 3, 1u);
        if (gtid < 32 * DM) saved[gtid] = xcur[(size_t)save_row(gtid / DM) * DM + (gtid % DM)];
    } else if constexpr (ST == 11 || ST == 14) {
        if (gtid < 32 * DM) { const int s = gtid / DM, c = gtid % DM, mm = save_row(s), bb = mm / SEQ; float acc = 0.f, s2 = 0.f;
            if (ST == 11) { const float* W = args.in[17] + (size_t)l * DM * DM + c; for (int k = 0; k < DM; ++k) { const float p = bf1(Hb[(size_t)mm * DM + k]) * W[(size_t)k * DM]; acc += p; s2 += p * p; } }
            else { const float* W = args.in[19] + (size_t)l * FFN * DM + c; for (int k = 0; k < FFN; ++k) { const float p = bf1(ACT[(size_t)mm * FFN + k]) * W[(size_t)k * DM]; acc += p; s2 += p * p; } }
            const float g = mod[(size_t)bb * NMOD * DM + (ST == 11 ? 2 : 5) * DM + c]; const float ref = saved[gtid] + g * acc;
            bad = nclose(xres[(size_t)mm * DM + c], ref, 1e-3f + fabsf(g) * 0.02f * sqrtf(s2) + 1e-3f * fabsf(ref)); }
    } else if constexpr (ST == 13) {
        const int j = h2 % FFN; const float* W = args.in[18] + (size_t)l * DM * 2 * FFN; float gt = 0.f, up = 0.f, s2 = 0.f;
        for (int k = 0; k < DM; ++k) { const float hv = bf1(Hb[(size_t)m * DM + k]); const float p1 = hv * W[(size_t)k * 2 * FFN + j], p2 = hv * W[(size_t)k * 2 * FFN + FFN + j]; gt += p1; up += p2; s2 += p1 * p1 + p2 * p2; }
        const float ref = gt / (1.0f + expf(-gt)) * up; bad = nclose(bf1(ACT[(size_t)m * FFN + j]), ref, 0.03f * sqrtf(s2) * (1.0f + fabsf(gt) + fabsf(up)) + 0.02f * fabsf(ref) + 2e-3f);
        if (gtid < 32 * DM) saved[gtid] = xres[(size_t)save_row(gtid / DM) * DM + (gtid % DM)];
    }
    if (bad) atomicOr(flags, 1u << (ST + 16 * l));
}
#ifndef CHKMASK
#define CHKMASK 0xffff
#endif
#define CHK(ST) do { if constexpr (((CHKMASK >> (ST)) & 1) != 0) if (ph <= hi && ph > lo) { selfcheck<ST>(args, l_chk, (unsigned*)(ctl + CW_FLAGS)); xcd_barrier(bar); } } while (0)
#else
#define CHK(ST) do { } while (0)
#endif

__global__ void __launch_bounds__(NWAVES * 64, 2) hybrid_fwd(Args args) {
    extern __shared__ __attribute__((aligned(16))) unsigned char lds[];
    LAS unsigned char* ldsl = (LAS unsigned char*)lds;
    volatile LAS unsigned* MISC = (volatile LAS unsigned*)(ldsl + MISC_OFF);
    const int tid = threadIdx.x, lane = tid & 63, wave = __builtin_amdgcn_readfirstlane(tid >> 6);
    const int G = gridDim.x; const int bx = blockIdx.x; const int vcu = (G % 8 == 0) ? (bx % 8) * (G / 8) + bx / 8 : bx;
    if (G != 256) return;
    unsigned char* ws = args.ws;
    gu32* ctl = (gu32*)(ws + WS_CTL);
    for (int u = tid; u < (LDS_BYTES - LDSCTL_OFF) / 4; u += NWAVES * 64) ((LAS unsigned*)(ldsl + LDSCTL_OFF))[u] = 0u;
    __syncthreads();
    XcdBarrier bar = xcd_barrier_post((unsigned*)(ctl + CW_BAR), MISC + 8);
    const int gw0 = vcu * NWAVES + wave;
    const int lo = args.ph_lo, hi = args.ph_hi; int ph = 0;
#define PHASE_BEGIN() if (lo <= ph && ph < hi) {
#define PHASE_END() if (SELFCHECK || ph + 1 < hi) xcd_barrier(bar); } ++ph;

    float* modp = (float*)(ws + WS_MOD); float* tabt = (float*)(ws + WS_TABT); float* taba = (float*)(ws + WS_TABA);
    bf16* Hb = (bf16*)(ws + WS_H); bf16* P1 = (bf16*)(ws + WS_P1); bf16* KPE = (bf16*)(ws + WS_KPE); bf16* QC = (bf16*)(ws + WS_QC); bf16* KC = (bf16*)(ws + WS_KC);
    bf16* P2 = (bf16*)(ws + WS_P2); bf16* OCAT = (bf16*)(ws + WS_OCAT); bf16* A2 = (bf16*)(ws + WS_A2); bf16* GATES = (bf16*)(ws + WS_GATES); bf16* ACT = (bf16*)(ws + WS_ACT);
    const float* x_in = args.in[0]; float* xres = args.out;

    PHASE_BEGIN()
    { const int tid = opaque_v(threadIdx.x), lane = tid & 63, bx = opaque_s((int)blockIdx.x), G = opaque_s((int)gridDim.x), gw = opaque_s(gw0), NGW = G * NWAVES; (void)lane; (void)bx; (void)G; (void)gw; (void)NGW;
        LAS float* sc = (LAS float*)(ldsl + RING_OFF);
        const float* cin = args.in[1];
        for (int i = tid; i < BATCH * DM; i += NWAVES * 64) { const int b = i / DM, k = i % DM; const float v = cin[i]; sc[k * 8 + b] = v / (1.0f + __expf(-v)); }
        __syncthreads();
        if (wave == 0 && bx < 192) {
            const int l = bx / 96, cg = bx % 96; const float* W = args.in[2] + (size_t)l * DM * (NMOD * DM) + cg * 64 + lane;
            float acc[8];
#pragma unroll
            for (int b = 0; b < 8; ++b) acc[b] = 0.f;
#pragma unroll 8
            for (int k = 0; k < DM; ++k) { const float w = W[(size_t)k * (NMOD * DM)]; const f32x4 s0 = *(const LAS f32x4*)(sc + k * 8), s1 = *(const LAS f32x4*)(sc + k * 8 + 4);
                acc[0] += s0[0] * w; acc[1] += s0[1] * w; acc[2] += s0[2] * w; acc[3] += s0[3] * w; acc[4] += s1[0] * w; acc[5] += s1[1] * w; acc[6] += s1[2] * w; acc[7] += s1[3] * w; }
            const float bias = args.in[3][(size_t)l * NMOD * DM + cg * 64 + lane];
#pragma unroll
            for (int b = 0; b < 8; ++b) modp[((size_t)l * BATCH + b) * (NMOD * DM) + cg * 64 + lane] = acc[b] + bias;
        }
        for (int i = bx * NWAVES * 64 + tid; i < (SEQ + 64) * 16; i += G * NWAVES * 64) {
            const int p = i >> 4, fi = i & 15; const int pos = p < SEQ ? p : p - SEQ; float* dst = p < SEQ ? tabt + (size_t)p * 32 : taba + (size_t)(p - SEQ) * 32;
            const float ang = (float)pos * inv_freq(fi); double s, c; sincos_d((double)ang, s, c); dst[fi] = (float)c; dst[16 + fi] = (float)s;
        }
        LAS float* scr = (LAS float*)(ldsl + RING_OFF + 32768 + wave * 8704);
        for (int l = 0; l < DEPTH; ++l) {
            const LayerW w = layer_w(ws, l);
            constexpr int I_IN = 16 * 157, I_UQ = 4 * 12, I_UKV = 2 * 16, I_BNA = 4 * 32, I_BMLA = 4 * 32, I_BGQA = 8 * 32, I_OUT = 16 * 32, I_GU = 16 * 176, I_DN = 44 * 32;
            constexpr int NITEMS = I_IN + I_UQ + I_UKV + I_BNA + I_BMLA + I_BGQA + I_OUT + I_GU + I_DN;
            for (int it = gw; it < NITEMS; it += NGW) {
                int r = it;
                if (r < I_IN)  { transpose_item(args.in[6] + (size_t)l * DM * IN_COLS, IN_COLS, 64 * (r / 157), 32 * (r % 157), RpWin{w.w1, w.wg}, scr, lane); continue; } r -= I_IN;
                if (r < I_UQ)  { transpose_item(args.in[10] + (size_t)l * 256 * 384, 384, 64 * (r / 12), 32 * (r % 12), RpPlain{w.w2, 384, 0, 0}, scr, lane); continue; } r -= I_UQ;
                if (r < I_UKV) { transpose_item(args.in[11] + (size_t)l * 128 * 512, 512, 64 * (r / 16), 32 * (r % 16), RpPlain{w.w2, 384, 384, 256}, scr, lane); continue; } r -= I_UKV;
                if (r < I_BNA) { transpose_item(args.in[14] + (size_t)l * 256 * 1024, 1024, 64 * (r / 32), 32 * (r % 32), RpPlain{w.bna, 256, 0, 0}, scr, lane); continue; } r -= I_BNA;
                if (r < I_BMLA){ transpose_item(args.in[15] + (size_t)l * 256 * 1024, 1024, 64 * (r / 32), 32 * (r % 32), RpPlain{w.bmla, 256, 0, 0}, scr, lane); continue; } r -= I_BMLA;
                if (r < I_BGQA){ transpose_item(args.in[16] + (size_t)l * 512 * 1024, 1024, 64 * (r / 32), 32 * (r % 32), RpPlain{w.bgqa, 512, 0, 0}, scr, lane); continue; } r -= I_BGQA;
                if (r < I_OUT) { transpose_item(args.in[17] + (size_t)l * 1024 * 1024, 1024, 64 * (r / 32), 32 * (r % 32), RpPlain{w.wout, 1024, 0, 0}, scr, lane); continue; } r -= I_OUT;
                if (r < I_GU)  { transpose_item(args.in[18] + (size_t)l * DM * 2 * FFN, 2 * FFN, 64 * (r / 176), 32 * (r % 176), RpGU{w.wgu}, scr, lane); continue; } r -= I_GU;
                transpose_item(args.in[19] + (size_t)l * FFN * DM, DM, 64 * (r / 32), 32 * (r % 32), RpPlain{w.wdn, FFN, 0, 0}, scr, lane);
            }
            const v4u z = {0u, 0u, 0u, 0u};
            for (int i = bx * NWAVES * 64 + tid; i < 96 * 128; i += G * NWAVES * 64) *(GAS v4u*)(w.w1 + (size_t)N1_USED * DM + (size_t)i * 8) = z;
            for (int i = bx * NWAVES * 64 + tid; i < 1024 * 48; i += G * NWAVES * 64) { const int row = i / 48, ch = i % 48, col = ch * 8;
                const bool zero = row < 384 ? (col >= 256) : row < 896 ? (col < 256) : true;
                if (zero) *(GAS v4u*)(w.w2 + (size_t)row * 384 + col) = z; }
        }
    }
    PHASE_END()
    { const int l_chk = 0; (void)l_chk; CHK(0); CHK(1); }

    for (int l = 0; l < DEPTH; ++l) {
        const LayerW w = layer_w(ws, l);
        const float* mod = modp + (size_t)l * BATCH * NMOD * DM;
        const float* xcur = (l == 0) ? x_in : xres;
        const int l_chk = l; (void)l_chk;

        PHASE_BEGIN()
        { const int tid = opaque_v(threadIdx.x), lane = tid & 63, bx = opaque_s((int)blockIdx.x), G = opaque_s((int)gridDim.x), gw = opaque_s(gw0), NGW = G * NWAVES; (void)lane; (void)bx; (void)G; (void)gw; (void)NGW;
            const float* g = args.in[4] + (size_t)l * DM;
            for (int m = gw; m < M; m += NGW) {
                const int b = m / SEQ; const float* xr = xcur + (size_t)m * DM; const float* sh = mod + (size_t)b * NMOD * DM; const float* scl = sh + DM;
                f32x4 v[4]; float s = 0.f;
#pragma unroll
                for (int j = 0; j < 4; ++j) { v[j] = *(const f32x4*)(xr + 256 * j + 4 * lane); s += (v[j][0] * v[j][0] + v[j][1] * v[j][1]) + (v[j][2] * v[j][2] + v[j][3] * v[j][3]); }
                const float rstd = 1.0f / sqrtf(wave_sum(s) * (1.0f / DM) + NORM_EPS);
#pragma unroll
                for (int j = 0; j < 4; ++j) { const int c = 256 * j + 4 * lane; const f32x4 gg = *(const f32x4*)(g + c), s1 = *(const f32x4*)(scl + c), s0 = *(const f32x4*)(sh + c);
                    f32x4 y;
#pragma unroll
                    for (int e = 0; e < 4; ++e) y[e] = (v[j][e] * rstd * gg[e]) * (1.0f + s1[e]) + s0[e];
                    v2u o; o.x = pk2(y[0], y[1]); o.y = pk2(y[2], y[3]); *(v2u*)(Hb + (size_t)m * DM + c) = o; }
            }
        }
        PHASE_END()
        CHK(2);

        PHASE_BEGIN()
        { const int tid = opaque_v(threadIdx.x), lane = tid & 63, bx = opaque_s((int)blockIdx.x), G = opaque_s((int)gridDim.x), gw = opaque_s(gw0), NGW = G * NWAVES; (void)lane; (void)bx; (void)G; (void)gw; (void)NGW;
            pg8::Gemm g{Hb, w.w1, M, N1, DM, DM, DM}; pg8::StaticOrder S; S.init(M, N1, G, bx);
            pg8::EpiBf16<0> E{P1, N1};
            pg8::gemm_phase<pg8::EpiBf16<0>, pg8::StaticOrder, true, true>(ldsl + RING_OFF, g, S, E);
        }
        PHASE_END()
        CHK(3);

        PHASE_BEGIN()
        { const int tid = opaque_v(threadIdx.x), lane = tid & 63, bx = opaque_s((int)blockIdx.x), G = opaque_s((int)gridDim.x), gw = opaque_s(gw0), NGW = G * NWAVES; (void)lane; (void)bx; (void)G; (void)gw; (void)NGW;
            const float* gq = args.in[8] + (size_t)l * 256; const float* gkv = args.in[9] + (size_t)l * 128;
            const float* gqc = args.in[12] + (size_t)l * 64; const float* gkc = args.in[13] + (size_t)l * 64;
            for (int m = gw; m < M; m += NGW) {
                const int t = m % SEQ, prow = t / GRID_W, pcol = t % GRID_W; const bf16* pr = P1 + (size_t)m * N1;
                {
                    const v2u raw = *(const v2u*)(pr + C_CQ + 4 * lane); float v[4] = {bflo(raw.x), bfhi(raw.x), bflo(raw.y), bfhi(raw.y)};
                    const float rstd = 1.0f / sqrtf(wave_sum(v[0] * v[0] + v[1] * v[1] + v[2] * v[2] + v[3] * v[3]) * (1.0f / 256) + NORM_EPS);
                    const f32x4 gg = *(const f32x4*)(gq + 4 * lane); v2u o; o.x = pk2(v[0] * rstd * gg[0], v[1] * rstd * gg[1]); o.y = pk2(v[2] * rstd * gg[2], v[3] * rstd * gg[3]);
                    *(v2u*)(A2 + (size_t)m * 384 + 4 * lane) = o; }
                {
                    const unsigned raw = *(const unsigned*)(pr + C_CKV + 2 * lane); const float v0 = bflo(raw), v1 = bfhi(raw);
                    const float rstd = 1.0f / sqrtf(wave_sum(v0 * v0 + v1 * v1) * (1.0f / 128) + NORM_EPS);
                    *(unsigned*)(A2 + (size_t)m * 384 + 256 + 2 * lane) = pk2(v0 * rstd * gkv[2 * lane], v1 * rstd * gkv[2 * lane + 1]); }
                if (lane < 16) {
                    const float x1 = bf1(pr[C_KR + lane]), x2 = bf1(pr[C_KR + 16 + lane]); const float c = tabt[(size_t)t * 32 + lane], s = tabt[(size_t)t * 32 + 16 + lane];
                    KPE[(size_t)m * 32 + lane] = (bf16)f2bf(x1 * c - x2 * s); KPE[(size_t)m * 32 + 16 + lane] = (bf16)f2bf(x2 * c + x1 * s); }
#pragma unroll
                for (int pass = 0; pass < 2; ++pass) {
                    const bool act = pass == 0 || lane < 16;
                    const bf16* src = pr + (pass == 0 ? C_QC : C_KC) + 8 * (act ? lane : 0);
                    const v4u raw = *(const v4u*)src; float v[8] = {bflo(raw.x), bfhi(raw.x), bflo(raw.y), bfhi(raw.y), bflo(raw.z), bfhi(raw.z), bflo(raw.w), bfhi(raw.w)};
                    float ss = 0.f;
#pragma unroll
                    for (int e = 0; e < 8; ++e) ss += v[e] * v[e];
                    ss += __shfl_xor(ss, 1); ss += __shfl_xor(ss, 2); ss += __shfl_xor(ss, 4);
                    const float rstd = 1.0f / sqrtf(ss * (1.0f / 64) + NORM_EPS);
                    const int sidx = lane & 7; const float* gn = (pass == 0 ? gqc : gkc) + 8 * sidx;
                    float y[8], pv[8];
#pragma unroll
                    for (int e = 0; e < 8; ++e) y[e] = v[e] * rstd * gn[e];
#pragma unroll
                    for (int e = 0; e < 8; ++e) pv[e] = __shfl_xor(y[e], 2);
                    const int pos = (sidx < 4) ? prow : pcol; const float* tb = taba + (size_t)pos * 32 + (sidx & 1) * 8; const bool second = (sidx & 2) != 0;
                    float o[8];
#pragma unroll
                    for (int e = 0; e < 8; ++e) { const float c = tb[e], s = tb[16 + e]; o[e] = second ? (y[e] * c + pv[e] * s) : (y[e] * c - pv[e] * s); }
                    v4u ov; ov.x = pk2(o[0], o[1]); ov.y = pk2(o[2], o[3]); ov.z = pk2(o[4], o[5]); ov.w = pk2(o[6], o[7]);
                    if (act) { if (pass == 0) *(v4u*)(QC + (size_t)m * 512 + 8 * lane) = ov; else *(v4u*)(KC + (size_t)m * 128 + 8 * lane) = ov; }
                }
            }
        }
        PHASE_END()
        CHK(4);

        PHASE_BEGIN()
        { const int tid = opaque_v(threadIdx.x), lane = tid & 63, bx = opaque_s((int)blockIdx.x), G = opaque_s((int)gridDim.x), gw = opaque_s(gw0), NGW = G * NWAVES; (void)lane; (void)bx; (void)G; (void)gw; (void)NGW;
            pg8::Gemm g{A2, w.w2, M, 1024, 384, 384, 384}; pg8::StaticOrder S; S.init(M, 1024, G, bx);
            pg8::EpiBf16<0> E{P2, 1024};
            pg8::gemm_phase<pg8::EpiBf16<0>, pg8::StaticOrder, true, true>(ldsl + RING_OFF, g, S, E);
        }
        PHASE_END()
        CHK(5);

        PHASE_BEGIN()
        { const int tid = opaque_v(threadIdx.x), lane = tid & 63, bx = opaque_s((int)blockIdx.x), G = opaque_s((int)gridDim.x), gw = opaque_s(gw0), NGW = G * NWAVES; (void)lane; (void)bx; (void)G; (void)gw; (void)NGW;
            char* alds = (char*)lds + RING_OFF;
            {
                const int x8 = bx & 7, j32 = bx >> 3;
                {
                    const int grp = x8 * 4 + (j32 >> 3), qb = j32 & 7, b = grp >> 2, h = grp & 3; const size_t row0 = (size_t)b * SEQ;
                    att::attn_unit<32>(P2 + (row0 + qb * 256) * 1024 + h * 96, 1024, P2 + row0 * 1024 + 384 + h * 128, 1024, KPE + row0 * 32, 32,
                                       P2 + row0 * 1024 + 384 + h * 128 + 64, 1024, OCAT + (row0 + qb * 256) * 1024 + 256 + h * 64, 1024, SEQ, tabt + (size_t)(qb * 256) * 32, alds);
                }
                for (int i = 0; i < 2; ++i) {
                    const int grp = i * 8 + x8, b = grp >> 1, kvh = grp & 1, hq = kvh * 4 + (j32 >> 3), qb = j32 & 7; const size_t row0 = (size_t)b * SEQ;
                    att::attn_unit<0>(QC + (row0 + qb * 256) * 512 + hq * 64, 512, KC + row0 * 128 + kvh * 64, 128, nullptr, 0,
                                      P1 + row0 * N1 + C_VC + kvh * 64, N1, OCAT + (row0 + qb * 256) * 1024 + 512 + hq * 64, 1024, SEQ, nullptr, alds);
                }
            }
            {
                const int x8 = bx & 7, j32 = bx >> 3; const int grp = x8 * 4 + (j32 >> 3), i = j32 & 7, b = grp >> 2, h = grp & 3; const size_t row0 = (size_t)b * SEQ;
                const int r0 = 4 * i, kst = min(max(r0 - 4, 0), 24), nt = (i == 0 || i == 7) ? 8 : 12;
                const bf16* base = P1 + (row0 + (size_t)kst * GRID_W) * N1;
                att::attn_unit<0, true>(P1 + (row0 + (size_t)r0 * GRID_W) * N1 + C_QA + h * 64, N1, base + C_KA + h * 64, N1, nullptr, 0, base + C_VA + h * 64, N1,
                                        OCAT + (row0 + (size_t)r0 * GRID_W) * 1024 + h * 64, 1024, nt * 64, nullptr, alds, args.in[7] + ((size_t)l * 4 + h) * 15 * 31, r0, kst);
            }
        }
        PHASE_END()
        CHK(6); CHK(7); CHK(8);

        PHASE_BEGIN()
        { const int tid = opaque_v(threadIdx.x), lane = tid & 63, bx = opaque_s((int)blockIdx.x), G = opaque_s((int)gridDim.x), gw = opaque_s(gw0), NGW = G * NWAVES; (void)lane; (void)bx; (void)G; (void)gw; (void)NGW;
            pg8::Gemm g{Hb, w.wg, M, NG, DM, DM, DM}; pg8::StaticOrder S; S.init(M, NG, G, bx);
            pg8::EpiBf16<1> E{GATES, NG};
            pg8::gemm_phase<pg8::EpiBf16<1>, pg8::StaticOrder, true, true>(ldsl + RING_OFF, g, S, E);
        }
        PHASE_END()
        CHK(9);

        PHASE_BEGIN()
        { const int tid = opaque_v(threadIdx.x), lane = tid & 63, bx = opaque_s((int)blockIdx.x), G = opaque_s((int)gridDim.x), gw = opaque_s(gw0), NGW = G * NWAVES; (void)lane; (void)bx; (void)G; (void)gw; (void)NGW;
            pg8::StaticOrder S; S.init(M, DM, G, bx);
            { pg8::Gemm g{OCAT, w.bna, M, DM, 256, 1024, 256}; pg8::EpiGateAcc E{Hb, DM, GATES, NG, 0, 1};
              pg8::gemm_phase<pg8::EpiGateAcc, pg8::StaticOrder, true, true>(ldsl + RING_OFF, g, S, E); }
            { pg8::Gemm g{OCAT + 256, w.bmla, M, DM, 256, 1024, 256}; pg8::EpiGateAcc E{Hb, DM, GATES, NG, 1024, 0};
              pg8::gemm_phase<pg8::EpiGateAcc, pg8::StaticOrder, true, true>(ldsl + RING_OFF, g, S, E); }
            { pg8::Gemm g{OCAT + 512, w.bgqa, M, DM, 512, 1024, 512}; pg8::EpiGateAcc E{Hb, DM, GATES, NG, 2048, 0};
              pg8::gemm_phase<pg8::EpiGateAcc, pg8::StaticOrder, true, true>(ldsl + RING_OFF, g, S, E); }
        }
        PHASE_END()
        CHK(10);

        PHASE_BEGIN()
        { const int tid = opaque_v(threadIdx.x), lane = tid & 63, bx = opaque_s((int)blockIdx.x), G = opaque_s((int)gridDim.x), gw = opaque_s(gw0), NGW = G * NWAVES; (void)lane; (void)bx; (void)G; (void)gw; (void)NGW;
            pg8::Gemm g{Hb, w.wout, M, DM, DM, DM, DM}; pg8::StaticOrder S; S.init(M, DM, G, bx);
            pg8::EpiResidual E{xcur, xres, DM, mod + 2 * DM, NMOD * DM, SEQ};
            pg8::gemm_phase<pg8::EpiResidual, pg8::StaticOrder, true, true>(ldsl + RING_OFF, g, S, E);
        }
        PHASE_END()
        CHK(11);

        PHASE_BEGIN()
        { const int tid = opaque_v(threadIdx.x), lane = tid & 63, bx = opaque_s((int)blockIdx.x), G = opaque_s((int)gridDim.x), gw = opaque_s(gw0), NGW = G * NWAVES; (void)lane; (void)bx; (void)G; (void)gw; (void)NGW;
            const float* g = args.in[5] + (size_t)l * DM;
            for (int m = gw; m < M; m += NGW) {
                const int b = m / SEQ; const float* xr = xres + (size_t)m * DM; const float* sh = mod + (size_t)b * NMOD * DM + 3 * DM; const float* scl = sh + DM;
                f32x4 v[4]; float s = 0.f;
#pragma unroll
                for (int j = 0; j < 4; ++j) { v[j] = *(const f32x4*)(xr + 256 * j + 4 * lane); s += (v[j][0] * v[j][0] + v[j][1] * v[j][1]) + (v[j][2] * v[j][2] + v[j][3] * v[j][3]); }
                const float rstd = 1.0f / sqrtf(wave_sum(s) * (1.0f / DM) + NORM_EPS);
#pragma unroll
                for (int j = 0; j < 4; ++j) { const int c = 256 * j + 4 * lane; const f32x4 gg = *(const f32x4*)(g + c), s1 = *(const f32x4*)(scl + c), s0 = *(const f32x4*)(sh + c);
                    f32x4 y;
#pragma unroll
                    for (int e = 0; e < 4; ++e) y[e] = (v[j][e] * rstd * gg[e]) * (1.0f + s1[e]) + s0[e];
                    v2u o; o.x = pk2(y[0], y[1]); o.y = pk2(y[2], y[3]); *(v2u*)(Hb + (size_t)m * DM + c) = o; }
            }
        }
        PHASE_END()
        CHK(12);

        PHASE_BEGIN()
        { const int tid = opaque_v(threadIdx.x), lane = tid & 63, bx = opaque_s((int)blockIdx.x), G = opaque_s((int)gridDim.x), gw = opaque_s(gw0), NGW = G * NWAVES; (void)lane; (void)bx; (void)G; (void)gw; (void)NGW;
            pg8::Gemm g{Hb, w.wgu, M, 2 * FFN, DM, DM, DM}; pg8::StaticOrder S; S.init(M, 2 * FFN, G, bx);
            pg8::EpiSwiGLU E{ACT, FFN};
            pg8::gemm_phase<pg8::EpiSwiGLU, pg8::StaticOrder, true, true>(ldsl + RING_OFF, g, S, E);
        }
        PHASE_END()
        CHK(13);

        PHASE_BEGIN()
        { const int tid = opaque_v(threadIdx.x), lane = tid & 63, bx = opaque_s((int)blockIdx.x), G = opaque_s((int)gridDim.x), gw = opaque_s(gw0), NGW = G * NWAVES; (void)lane; (void)bx; (void)G; (void)gw; (void)NGW;
            pg8::Gemm g{ACT, w.wdn, M, DM, FFN, FFN, FFN}; pg8::StaticOrder S; S.init(M, DM, G, bx);
            pg8::EpiResidual E{xres, xres, DM, mod + 5 * DM, NMOD * DM, SEQ};
            pg8::gemm_phase<pg8::EpiResidual, pg8::StaticOrder, true, true>(ldsl + RING_OFF, g, S, E);
        }
        PHASE_END()
        CHK(14);
    }

    PHASE_BEGIN()
    { const int tid = opaque_v(threadIdx.x), lane = tid & 63, bx = opaque_s((int)blockIdx.x), G = opaque_s((int)gridDim.x), gw = opaque_s(gw0), NGW = G * NWAVES; (void)lane; (void)bx; (void)G; (void)gw; (void)NGW;
        const float* g = args.in[20];
        for (int m = gw; m < M; m += NGW) {
            float* xr = xres + (size_t)m * DM;
            f32x4 v[4]; float s = 0.f;
#pragma unroll
            for (int j = 0; j < 4; ++j) { v[j] = *(const f32x4*)(xr + 256 * j + 4 * lane); s += (v[j][0] * v[j][0] + v[j][1] * v[j][1]) + (v[j][2] * v[j][2] + v[j][3] * v[j][3]); }
            const float rstd = 1.0f / sqrtf(wave_sum(s) * (1.0f / DM) + NORM_EPS);
#pragma unroll
            for (int j = 0; j < 4; ++j) { const int c = 256 * j + 4 * lane; const f32x4 gg = *(const f32x4*)(g + c); f32x4 y;
#pragma unroll
                for (int e = 0; e < 4; ++e) y[e] = v[j][e] * rstd * gg[e];
                *(f32x4*)(xr + c) = y; }
        }
    }
    PHASE_END()
#if SELFCHECK
        xcd_barrier(bar);
        if (blockIdx.x == 0 && threadIdx.x == 0) { const unsigned fl = __hip_atomic_load((unsigned*)(ctl + CW_FLAGS), RLX_AGENT); unsigned c[12]; for (int i = 0; i < 12; ++i) c[i] = __hip_atomic_load((unsigned*)(ctl + CW_FLAGS + 2 + i), RLX_AGENT);
        unsigned tot = c[0] + c[1] + c[2] + c[3], bad_ = c[6] + c[7] + c[8] + c[9]; int d1 = (c[6] ? 1 : 0) | (c[7] ? 2 : 0) | (c[8] ? 4 : 0) | (c[9] ? 8 : 0); int d2 = tot ? (int)(9.99f * (float)bad_ / (float)tot) : 0;
        { int k1 = 0, k2 = 0; while ((c[0] >> k1) != 0) ++k1; while ((c[1] >> k2) != 0) ++k2; d1 = k1 / 2; d2 = k2 / 2; if (d1 > 9) d1 = 9; if (d2 > 9) d2 = 9; args.out[0] = 100.0f * (float)(10 * d1 + d2 + 1); return; }
        args.out[0] = 100.0f * (float)((((fl >> 15) & 1u) * 2u + ((fl >> 10) & 1u)) + 1u); }
#endif
#undef PHASE_BEGIN
#undef PHASE_END
}

constexpr int N_PHASES = 1 + DEPTH * 11 + 1;
#ifndef MK_PER_PHASE
#define MK_PER_PHASE 0
#endif

extern "C" void kernel_launch(void* const* d_in, const int* in_sizes, int n_in, void* d_out, int out_size, void* d_ws, size_t ws_size, hipStream_t stream) {
    static int grid = 0;
    if (grid == 0) {
        if (n_in != 21 || in_sizes[0] != M * DM || out_size != M * DM || ws_size < WS_END) { fprintf(stderr, "kernel_launch: unexpected shapes (n_in %d in0 %d out %d ws %zu)\n", n_in, n_in > 0 ? in_sizes[0] : -1, out_size, ws_size); grid = -1; return; }
        int dev = 0, cus = 0;
        if (hipGetDevice(&dev) != hipSuccess || hipDeviceGetAttribute(&cus, hipDeviceAttributeMultiprocessorCount, dev) != hipSuccess) { grid = -1; return; }
        if (hipFuncSetAttribute((const void*)hybrid_fwd, hipFuncAttributeMaxDynamicSharedMemorySize, LDS_BYTES) != hipSuccess) { fprintf(stderr, "kernel_launch: hipFuncSetAttribute failed\n"); grid = -1; return; }
        (void)hipGetLastError();
        grid = cus;
    }
    if (grid < 0) return;
    (void)hipMemsetAsync((char*)d_ws + WS_CTL, 0, CTL_ZERO_BYTES, stream);
    Args a{};
    for (int i = 0; i < 21; ++i) a.in[i] = (const float*)d_in[i];
    a.out = (float*)d_out; a.ws = (unsigned char*)d_ws;
#if MK_PER_PHASE
    for (int p = 0; p < N_PHASES; ++p) { a.ph_lo = p; a.ph_hi = p + 1; hipLaunchKernelGGL(hybrid_fwd, dim3(grid), dim3(NWAVES * 64), LDS_BYTES, stream, a); }
#else
#if SELFCHECK
    a.ph_lo = 0; a.ph_hi = 12;
#else
    a.ph_lo = 0; a.ph_hi = N_PHASES;
#endif
    hipLaunchKernelGGL(hybrid_fwd, dim3(grid), dim3(NWAVES * 64), LDS_BYTES, stream, a);
#endif
    const hipError_t le = hipPeekAtLastError();
    if (le != hipSuccess) fprintf(stderr, "kernel_launch: launch failed: %s\n", hipGetErrorName(le));
}
```

```cpp
#define SELFCHECK 0
#include <hip/hip_runtime.h>
#include <hip/hip_bf16.h>
#include <cstdio>
#include <cstdint>

__device__ __forceinline__ int opaque_v(int v) { asm volatile("" : "+v"(v)); return v; }
__device__ __forceinline__ int opaque_s(int v) { asm volatile("" : "+s"(v)); return v; }
namespace pg8 {
#define PG8_LAS __attribute__((address_space(3)))
typedef unsigned short bf16_t;
typedef short bf16x8 __attribute__((ext_vector_type(8)));
typedef float f32x4 __attribute__((ext_vector_type(4)));
typedef unsigned u32x4 __attribute__((ext_vector_type(4)));
constexpr int BM = 256, BK = 64, HALF = 128, HTB = HALF * BK * 2, STAGE_BYTES = 8 * HTB, NXCD = 8, WGM = 8;

__host__ __device__ __forceinline__ int lds_byte(int r, int c) { const int st = (r >> 4) * 2 + (c >> 5), rr = r & 15, cc = c & 31, ob = rr * 64 + cc * 2; return st * 1024 + (ob ^ (((ob >> 9) & 1) << 5)); }
__host__ __device__ __forceinline__ void stage_rc(int b, int& R, int& C) { const int st = b / 1024, sb = b % 1024, swz = sb ^ (((sb >> 9) & 1) << 5); R = (st >> 1) * 16 + swz / 64; C = (st & 1) * 32 + (swz % 64) / 2; }
__host__ __device__ __forceinline__ int perm32(int rho) { const int n = rho >> 4, i = rho & 15; return 8 * (i >> 2) + 4 * n + (i & 3); }

struct Unit { int pm, pn; };
struct Gemm { const bf16_t* A; const bf16_t* Bt; int M, N, K, lda, ldb; };

struct StaticOrder {
    int nM, nN, nwg, G, c;
    __host__ __device__ void init(int M, int N, int G_, int c_) { nM = M / BM; nN = N / BM; nwg = nM * nN; G = G_; c = c_; }
    __host__ __device__ bool next(int i, Unit& u) const {
        const long L = (long)i * G + c; if (L >= nwg) return false;
        int wgid = (int)L; { const int q = nwg / NXCD, r = nwg % NXCD, xcd = wgid % NXCD, off = wgid / NXCD; wgid = (xcd < r ? xcd * (q + 1) : r * (q + 1) + (xcd - r) * q) + off; }
        const int nig = WGM * nN, gid = wgid / nig, fm = gid * WGM, gsz = (nM - fm) < WGM ? (nM - fm) : WGM;
        u.pm = fm + ((wgid % nig) % gsz); u.pn = (wgid % nig) / gsz; return true;
    }
    __device__ __forceinline__ void a_ready(const Unit&) const {}
    __device__ __forceinline__ void done(const Unit&) const {}
};

typedef float f32x2_t __attribute__((ext_vector_type(2))); typedef __bf16 bf16x2_t __attribute__((ext_vector_type(2)));
__device__ __forceinline__ unsigned cvt_pk_bf16(float lo, float hi) { f32x2_t v = {lo, hi}; bf16x2_t b = __builtin_convertvector(v, bf16x2_t); return __builtin_bit_cast(unsigned, b); }
__device__ __forceinline__ float bf_lo(unsigned w) { return __uint_as_float(w << 16); }
__device__ __forceinline__ float bf_hi(unsigned w) { return __uint_as_float(w & 0xffff0000u); }
__device__ __forceinline__ float sigmoidf_(float v) { return __builtin_amdgcn_rcpf(1.0f + __builtin_amdgcn_exp2f(-1.4426950408889634f * v)); }

template <int ACT  > struct EpiBf16 {
    static constexpr bool PERM = true, AFTER_DRAIN = false;
    bf16_t* O; int ldc;
    __device__ __forceinline__ void operator()(const f32x4 (&acc)[2][2][4][2], const Unit& u, int wr, int wc, int fr, int fq) const {
        const int row0 = u.pm * BM + wr * 64 + fr, col0 = u.pn * BM + wc * 32 + 8 * fq;
#pragma unroll
        for (int ai = 0; ai < 2; ++ai)
#pragma unroll
            for (int m = 0; m < 4; ++m) { bf16_t* rowp = O + (size_t)(row0 + ai * HALF + m * 16) * ldc + col0;
#pragma unroll
                for (int bj = 0; bj < 2; ++bj) { f32x4 v0 = acc[ai][bj][m][0], v1 = acc[ai][bj][m][1];
                    if (ACT == 1) {
#pragma unroll
                        for (int e = 0; e < 4; ++e) { v0[e] = sigmoidf_(v0[e]); v1[e] = sigmoidf_(v1[e]); } }
                    u32x4 w; w.x = cvt_pk_bf16(v0[0], v0[1]); w.y = cvt_pk_bf16(v0[2], v0[3]); w.z = cvt_pk_bf16(v1[0], v1[1]); w.w = cvt_pk_bf16(v1[2], v1[3]);
                    *(u32x4*)(rowp + bj * HALF) = w; } }
    }
};
struct EpiGateAcc {
    static constexpr bool PERM = true, AFTER_DRAIN = false;
    bf16_t* O; int ldc; const bf16_t* G; int ldg; int goff; int first;
    __device__ __forceinline__ void operator()(const f32x4 (&acc)[2][2][4][2], const Unit& u, int wr, int wc, int fr, int fq) const {
        const int row0 = u.pm * BM + wr * 64 + fr, col0 = u.pn * BM + wc * 32 + 8 * fq;
#pragma unroll
        for (int ai = 0; ai < 2; ++ai)
#pragma unroll
            for (int m = 0; m < 4; ++m) { const size_t r = (size_t)(row0 + ai * HALF + m * 16); bf16_t* rowp = O + r * ldc + col0; const bf16_t* gp = G + r * ldg + goff + col0;
#pragma unroll
                for (int bj = 0; bj < 2; ++bj) { const f32x4 v0 = acc[ai][bj][m][0], v1 = acc[ai][bj][m][1];
                    const u32x4 g = *(const u32x4*)(gp + bj * HALF);
                    float o[8];
                    o[0] = bf_lo(g.x) * v0[0]; o[1] = bf_hi(g.x) * v0[1]; o[2] = bf_lo(g.y) * v0[2]; o[3] = bf_hi(g.y) * v0[3];
                    o[4] = bf_lo(g.z) * v1[0]; o[5] = bf_hi(g.z) * v1[1]; o[6] = bf_lo(g.w) * v1[2]; o[7] = bf_hi(g.w) * v1[3];
                    if (!first) { const u32x4 p = *(const u32x4*)(rowp + bj * HALF);
                        o[0] += bf_lo(p.x); o[1] += bf_hi(p.x); o[2] += bf_lo(p.y); o[3] += bf_hi(p.y); o[4] += bf_lo(p.z); o[5] += bf_hi(p.z); o[6] += bf_lo(p.w); o[7] += bf_hi(p.w); }
                    u32x4 w; w.x = cvt_pk_bf16(o[0], o[1]); w.y = cvt_pk_bf16(o[2], o[3]); w.z = cvt_pk_bf16(o[4], o[5]); w.w = cvt_pk_bf16(o[6], o[7]);
                    *(u32x4*)(rowp + bj * HALF) = w; } }
    }
};
struct EpiSwiGLU {
    static constexpr bool PERM = true, AFTER_DRAIN = false;
    bf16_t* O; int ldc;
    __device__ __forceinline__ void operator()(const f32x4 (&acc)[2][2][4][2], const Unit& u, int wr, int wc, int fr, int fq) const {
        const int row0 = u.pm * BM + wr * 64 + fr, col0 = u.pn * HALF + wc * 32 + 8 * fq;
#pragma unroll
        for (int ai = 0; ai < 2; ++ai)
#pragma unroll
            for (int m = 0; m < 4; ++m) { bf16_t* rowp = O + (size_t)(row0 + ai * HALF + m * 16) * ldc + col0;
                float o[8];
#pragma unroll
                for (int n = 0; n < 2; ++n)
#pragma unroll
                    for (int e = 0; e < 4; ++e) { const float g = acc[ai][0][m][n][e], up = acc[ai][1][m][n][e]; o[n * 4 + e] = g * sigmoidf_(g) * up; }
                u32x4 w; w.x = cvt_pk_bf16(o[0], o[1]); w.y = cvt_pk_bf16(o[2], o[3]); w.z = cvt_pk_bf16(o[4], o[5]); w.w = cvt_pk_bf16(o[6], o[7]);
                *(u32x4*)rowp = w; }
    }
};
struct EpiResidual {
    static constexpr bool PERM = false, AFTER_DRAIN = false;
    const float* xin; float* xout; int ldc; const float* gvec; int gstride; int rows_per_batch;
    __device__ __forceinline__ void operator()(const f32x4 (&acc)[2][2][4][2], const Unit& u, int wr, int wc, int fr, int fq) const {
        const int row0 = u.pm * BM + wr * 64 + fr, col0 = u.pn * BM + wc * 32 + 4 * fq;
        const int b = (u.pm * BM) / rows_per_batch;
        f32x4 gv[2][2];
#pragma unroll
        for (int bj = 0; bj < 2; ++bj)
#pragma unroll
            for (int n = 0; n < 2; ++n) gv[bj][n] = *(const f32x4*)(gvec + (size_t)b * gstride + col0 + bj * HALF + n * 16);
#pragma unroll
        for (int ai = 0; ai < 2; ++ai)
#pragma unroll
            for (int m = 0; m < 4; ++m) { const size_t off = (size_t)(row0 + ai * HALF + m * 16) * ldc + col0;
#pragma unroll
                for (int bj = 0; bj < 2; ++bj)
#pragma unroll
                    for (int n = 0; n < 2; ++n) { const f32x4 xi = *(const f32x4*)(xin + off + bj * HALF + n * 16);
                        *(f32x4*)(xout + off + bj * HALF + n * 16) = xi + gv[bj][n] * acc[ai][bj][m][n]; } }
    }
};

template <int ACT  > struct EpiBf16N {
    static constexpr bool PERM = true, AFTER_DRAIN = false;
    bf16_t* O; int ldc; const float* rowss; const float* bias; int nb; int rows_per_batch;
    __device__ __forceinline__ void operator()(const f32x4 (&acc)[2][2][4][2], const Unit& u, int wr, int wc, int fr, int fq) const {
        const int row0 = u.pm * BM + wr * 64 + fr, col0 = u.pn * BM + wc * 32 + 8 * fq; const float* bp = bias + (size_t)((u.pm * BM) / rows_per_batch) * nb + col0;
        f32x4 bv[2][2];
#pragma unroll
        for (int bj = 0; bj < 2; ++bj) { bv[bj][0] = *(const f32x4*)(bp + bj * HALF); bv[bj][1] = *(const f32x4*)(bp + bj * HALF + 4); }
#pragma unroll
        for (int ai = 0; ai < 2; ++ai)
#pragma unroll
            for (int m = 0; m < 4; ++m) { const int row = row0 + ai * HALF + m * 16; const f32x4 rp = *(const f32x4*)(rowss + 4 * (size_t)row); const float rs = __builtin_amdgcn_rsqf(((rp[0] + rp[1]) + (rp[2] + rp[3])) * (1.0f / 1024.0f) + 1e-6f); bf16_t* rowp = O + (size_t)row * ldc + col0;
#pragma unroll
                for (int bj = 0; bj < 2; ++bj) { f32x4 v0 = acc[ai][bj][m][0] * rs + bv[bj][0], v1 = acc[ai][bj][m][1] * rs + bv[bj][1];
                    if (ACT == 1) {
#pragma unroll
                        for (int e = 0; e < 4; ++e) { v0[e] = sigmoidf_(v0[e]); v1[e] = sigmoidf_(v1[e]); } }
                    u32x4 w; w.x = cvt_pk_bf16(v0[0], v0[1]); w.y = cvt_pk_bf16(v0[2], v0[3]); w.z = cvt_pk_bf16(v1[0], v1[1]); w.w = cvt_pk_bf16(v1[2], v1[3]);
                    *(u32x4*)(rowp + bj * HALF) = w; } }
    }
};
struct EpiSwiGLUN {
    static constexpr bool PERM = true, AFTER_DRAIN = false;
    bf16_t* O; int ldc; const float* rowss; const float* bias; int nb; int rows_per_batch;
    __device__ __forceinline__ void operator()(const f32x4 (&acc)[2][2][4][2], const Unit& u, int wr, int wc, int fr, int fq) const {
        const int row0 = u.pm * BM + wr * 64 + fr, col0 = u.pn * HALF + wc * 32 + 8 * fq; const float* bp = bias + (size_t)((u.pm * BM) / rows_per_batch) * nb + u.pn * BM + wc * 32 + 8 * fq;
        f32x4 bv[2][2];
#pragma unroll
        for (int bj = 0; bj < 2; ++bj) { bv[bj][0] = *(const f32x4*)(bp + bj * HALF); bv[bj][1] = *(const f32x4*)(bp + bj * HALF + 4); }
#pragma unroll
        for (int ai = 0; ai < 2; ++ai)
#pragma unroll
            for (int m = 0; m < 4; ++m) { const int row = row0 + ai * HALF + m * 16; const f32x4 rp = *(const f32x4*)(rowss + 4 * (size_t)row); const float rs = __builtin_amdgcn_rsqf(((rp[0] + rp[1]) + (rp[2] + rp[3])) * (1.0f / 1024.0f) + 1e-6f); bf16_t* rowp = O + (size_t)row * ldc + col0;
                float o[8];
#pragma unroll
                for (int n = 0; n < 2; ++n)
#pragma unroll
                    for (int e = 0; e < 4; ++e) { const float g = acc[ai][0][m][n][e] * rs + bv[0][n][e], up = acc[ai][1][m][n][e] * rs + bv[1][n][e]; o[n * 4 + e] = g * sigmoidf_(g) * up; }
                u32x4 w; w.x = cvt_pk_bf16(o[0], o[1]); w.y = cvt_pk_bf16(o[2], o[3]); w.z = cvt_pk_bf16(o[4], o[5]); w.w = cvt_pk_bf16(o[6], o[7]);
                *(u32x4*)rowp = w; }
    }
};
struct EpiResidualN {
    static constexpr bool PERM = true, AFTER_DRAIN = false;
    const float* xin; float* xout; int ldc; const float* gvec; int gstride; int rows_per_batch; bf16_t* xg; const float* gn; const float* scn; float* rowss4; PG8_LAS float* lds_x;
    __device__ __forceinline__ void operator()(const f32x4 (&acc)[2][2][4][2], const Unit& u, int wr, int wc, int fr, int fq) const {
        const int row0 = u.pm * BM + wr * 64 + fr, col0 = u.pn * BM + wc * 32 + 8 * fq;
        const int b = (u.pm * BM) / rows_per_batch;
        float ss[2][4];
#pragma unroll
        for (int ai = 0; ai < 2; ++ai)
#pragma unroll
            for (int m = 0; m < 4; ++m) ss[ai][m] = 0.f;
#pragma unroll
        for (int bj = 0; bj < 2; ++bj) { const int c = col0 + bj * HALF;
            const f32x4 gv0 = *(const f32x4*)(gvec + (size_t)b * gstride + c), gv1 = *(const f32x4*)(gvec + (size_t)b * gstride + c + 4);
            f32x4 gs0 = {0.f, 0.f, 0.f, 0.f}, gs1 = {0.f, 0.f, 0.f, 0.f};
            if (xg) { gs0 = *(const f32x4*)(gn + c) * (*(const f32x4*)(scn + (size_t)b * gstride + c) + 1.0f); gs1 = *(const f32x4*)(gn + c + 4) * (*(const f32x4*)(scn + (size_t)b * gstride + c + 4) + 1.0f); }
#pragma unroll
            for (int ai = 0; ai < 2; ++ai)
#pragma unroll
                for (int m = 0; m < 4; ++m) { const size_t off = (size_t)(row0 + ai * HALF + m * 16) * ldc + c; const f32x4 xi0 = *(const f32x4*)(xin + off), xi1 = *(const f32x4*)(xin + off + 4);
                    const f32x4 xo0 = xi0 + gv0 * acc[ai][bj][m][0], xo1 = xi1 + gv1 * acc[ai][bj][m][1]; *(f32x4*)(xout + off) = xo0; *(f32x4*)(xout + off + 4) = xo1;
                    if (xg) { const f32x4 y0 = xo0 * gs0, y1 = xo1 * gs1; u32x4 w; w.x = cvt_pk_bf16(y0[0], y0[1]); w.y = cvt_pk_bf16(y0[2], y0[3]); w.z = cvt_pk_bf16(y1[0], y1[1]); w.w = cvt_pk_bf16(y1[2], y1[3]); *(u32x4*)(xg + off) = w;
                        ss[ai][m] += ((xo0[0] * xo0[0] + xo0[1] * xo0[1]) + (xo0[2] * xo0[2] + xo0[3] * xo0[3])) + ((xo1[0] * xo1[0] + xo1[1] * xo1[1]) + (xo1[2] * xo1[2] + xo1[3] * xo1[3])); } } }
        if (xg) {
#pragma unroll
            for (int ai = 0; ai < 2; ++ai)
#pragma unroll
                for (int m = 0; m < 4; ++m) { float v = ss[ai][m]; v += __shfl_xor(v, 16); v += __shfl_xor(v, 32); if (fq == 0) lds_x[wc * 256 + ai * HALF + wr * 64 + m * 16 + fr] = v; }
            asm volatile("s_waitcnt lgkmcnt(0)" ::: "memory"); __builtin_amdgcn_s_barrier(); asm volatile("" ::: "memory");
            const int t = threadIdx.x;
            if (t < 256) rowss4[4 * (size_t)(u.pm * BM + t) + u.pn] = (lds_x[t] + lds_x[256 + t]) + (lds_x[512 + t] + lds_x[768 + t]);
        }
    }
};

template <class Epi, class Sched, bool ALIGN_EPI = false, bool SP2 = false>
__device__ __forceinline__ void gemm_phase(PG8_LAS unsigned char* lds, const Gemm g, const Sched& S, const Epi& E) {
    const int tid = opaque_v(threadIdx.x), wid = __builtin_amdgcn_readfirstlane(tid >> 6), lane = tid & 63, wr = wid >> 2, wc = wid & 3, fr = lane & 15, fq = lane >> 4;
    const int K = g.K, nt = K / BK;
    unsigned voffA[2], voffB[2];
#pragma unroll
    for (int i = 0; i < 2; ++i) { int R, C; stage_rc(tid * 16 + i * 8192, R, C); const int Rb = Epi::PERM ? ((R & ~31) + perm32(R & 31)) : R;
        voffA[i] = (unsigned)(R * g.lda + C) * 2u; voffB[i] = (unsigned)(Rb * g.ldb + C) * 2u; }
    const size_t kstep = (size_t)(BK * 2);
    const size_t hstepA = (size_t)HALF * g.lda * 2, hstepB = (size_t)HALF * g.ldb * 2;
    const size_t tstepA = 2 * hstepA, tstepB = 2 * hstepB;
    const unsigned ldsw = (unsigned)wid * 1024u;
    const int aoff = lds_byte(wr * 64 + fr, fq * 8), boff = lds_byte(wc * 32 + fr, fq * 8);
#define PG8_SA(b, h) (((b) * 2 + (h)) * HTB)
#define PG8_SB(b, h) ((4 + (b) * 2 + (h)) * HTB)
#define PG8_STAGE(bufoff, gbase, voff) do { _Pragma("unroll") for (int _i = 0; _i < 2; ++_i) \
        __builtin_amdgcn_global_load_lds((const unsigned*)((const char*)(gbase) + (voff)[_i]), (PG8_LAS unsigned*)(lds + (bufoff) + ldsw + _i * 8192), 16, 0, 0); } while (0)
#define PG8_LDA(dst, b, h) do { _Pragma("unroll") for (int m = 0; m < 4; ++m) _Pragma("unroll") for (int k = 0; k < 2; ++k) dst[m][k] = *(const PG8_LAS bf16x8*)(lds + PG8_SA(b, h) + aoff + m * 2048 + k * 1024); } while (0)
#define PG8_LDB(dst, b, h) do { _Pragma("unroll") for (int n = 0; n < 2; ++n) _Pragma("unroll") for (int k = 0; k < 2; ++k) dst[n][k] = *(const PG8_LAS bf16x8*)(lds + PG8_SB(b, h) + boff + n * 2048 + k * 1024); } while (0)
#define PG8_MMA(ai, bj, At, Bt) do { __builtin_amdgcn_s_setprio(1); _Pragma("unroll") for (int m = 0; m < 4; ++m) _Pragma("unroll") for (int n = 0; n < 2; ++n) _Pragma("unroll") for (int k = 0; k < 2; ++k) \
        acc[ai][bj][m][n] = __builtin_amdgcn_mfma_f32_16x16x32_bf16(Bt[n][k], At[m][k], acc[ai][bj][m][n], 0, 0, 0); __builtin_amdgcn_s_setprio(0); } while (0)
#define PG8_WAIT_V(n) asm volatile("s_waitcnt vmcnt(" #n ")" ::: "memory")
#define PG8_WAIT_L(n) asm volatile("s_waitcnt lgkmcnt(" #n ")" ::: "memory")
#define PG8_BAR __builtin_amdgcn_s_barrier()
#define PG8_SCHED __builtin_amdgcn_sched_barrier(0)
    Unit cur, nxt; int ui = 0;
    if (!S.next(0, cur)) return;
    f32x4 acc[2][2][4][2];
#pragma unroll
    for (int a = 0; a < 2; ++a)
#pragma unroll
        for (int b = 0; b < 2; ++b)
#pragma unroll
            for (int m = 0; m < 4; ++m)
#pragma unroll
                for (int n = 0; n < 2; ++n) acc[a][b][m][n] = (f32x4){0.f, 0.f, 0.f, 0.f};
    bf16x8 At[4][2], B0[2][2], B1[2][2];
    const char* cA = (const char*)g.A + (size_t)cur.pm * tstepA; const char* cB = (const char*)g.Bt + (size_t)cur.pn * tstepB;
    S.a_ready(cur);
    if constexpr (SP2) {
        PG8_STAGE(PG8_SB(0, 0), cB, voffB); PG8_STAGE(PG8_SB(0, 1), cB + hstepB, voffB); PG8_STAGE(PG8_SA(0, 0), cA, voffA); PG8_STAGE(PG8_SA(0, 1), cA + hstepA, voffA);
        if (wr == 1) PG8_BAR;
        PG8_WAIT_V(2); PG8_BAR;
        PG8_STAGE(PG8_SB(1, 0), cB + kstep, voffB); PG8_STAGE(PG8_SA(1, 0), cA + kstep, voffA); PG8_STAGE(PG8_SB(1, 1), cB + hstepB + kstep, voffB);
        PG8_WAIT_V(6); PG8_BAR;
    } else {
        PG8_STAGE(PG8_SB(0, 0), cB, voffB); PG8_STAGE(PG8_SA(0, 0), cA, voffA); PG8_STAGE(PG8_SB(0, 1), cB + hstepB, voffB); PG8_STAGE(PG8_SA(0, 1), cA + hstepA, voffA);
        if (wr == 1) PG8_BAR;
        PG8_WAIT_V(4); PG8_BAR;
        PG8_STAGE(PG8_SB(1, 0), cB + kstep, voffB); PG8_STAGE(PG8_SA(1, 0), cA + kstep, voffA); PG8_STAGE(PG8_SB(1, 1), cB + hstepB + kstep, voffB);
        PG8_WAIT_V(6); PG8_BAR;
    }
    for (;;) {
        const bool has_next = S.next(ui + 1, nxt);
        const char* nA = has_next ? (const char*)g.A + (size_t)nxt.pm * tstepA : cA; const char* nB = has_next ? (const char*)g.Bt + (size_t)nxt.pn * tstepB : cB;
#pragma unroll 1
        for (int t = 0; t < nt; t += 2) {
            const bool last = (t == nt - 2);
            const char* a1 = cA + (size_t)(t + 1) * kstep;
            const char* a2 = last ? nA : cA + (size_t)(t + 2) * kstep; const char* b2 = last ? nB : cB + (size_t)(t + 2) * kstep;
            const char* a3 = a2 + kstep; const char* b3 = b2 + kstep;
            if (last && has_next) S.a_ready(nxt);
            if constexpr (SP2) {
            PG8_LDB(B0, 0, 0); PG8_LDB(B1, 0, 1); PG8_SCHED; PG8_LDA(At, 0, 0); PG8_STAGE(PG8_SA(1, 1), a1 + hstepA, voffA);
            PG8_WAIT_V(8); PG8_WAIT_L(0); PG8_BAR; PG8_MMA(0, 0, At, B0); PG8_MMA(0, 1, At, B1); PG8_BAR; PG8_SCHED;
            PG8_LDA(At, 0, 1); PG8_STAGE(PG8_SB(0, 0), b2, voffB); PG8_STAGE(PG8_SB(0, 1), b2 + hstepB, voffB); PG8_STAGE(PG8_SA(0, 0), a2, voffA);
            PG8_WAIT_V(8); PG8_WAIT_L(0); PG8_BAR; PG8_MMA(1, 0, At, B0); PG8_MMA(1, 1, At, B1); PG8_BAR; PG8_SCHED;
            PG8_LDB(B0, 1, 0); PG8_LDB(B1, 1, 1); PG8_SCHED; PG8_LDA(At, 1, 0); PG8_STAGE(PG8_SA(0, 1), a2 + hstepA, voffA);
            PG8_WAIT_V(8); PG8_WAIT_L(0); PG8_BAR; PG8_MMA(0, 0, At, B0); PG8_MMA(0, 1, At, B1); PG8_BAR; PG8_SCHED;
            PG8_LDA(At, 1, 1); PG8_STAGE(PG8_SB(1, 0), b3, voffB); PG8_STAGE(PG8_SB(1, 1), b3 + hstepB, voffB); PG8_STAGE(PG8_SA(1, 0), a3, voffA);
            PG8_WAIT_V(8); PG8_WAIT_L(0); PG8_BAR; PG8_MMA(1, 0, At, B0); PG8_MMA(1, 1, At, B1); PG8_BAR; PG8_SCHED;
            } else {
            PG8_LDB(B0, 0, 0); PG8_SCHED; PG8_LDA(At, 0, 0); PG8_STAGE(PG8_SA(1, 1), a1 + hstepA, voffA);
            PG8_WAIT_L(8); PG8_BAR; PG8_WAIT_L(0); PG8_MMA(0, 0, At, B0); PG8_BAR; PG8_SCHED;
            PG8_LDB(B1, 0, 1); PG8_STAGE(PG8_SB(0, 0), b2, voffB);
            PG8_BAR; PG8_WAIT_L(0); PG8_MMA(0, 1, At, B1); PG8_BAR;
            PG8_LDA(At, 0, 1); PG8_STAGE(PG8_SA(0, 0), a2, voffA);
            PG8_BAR; PG8_WAIT_L(0); PG8_MMA(1, 0, At, B0); PG8_BAR; PG8_SCHED;
            PG8_STAGE(PG8_SB(0, 1), b2 + hstepB, voffB);
            PG8_WAIT_V(6); PG8_BAR; PG8_MMA(1, 1, At, B1); PG8_BAR;
            PG8_LDB(B0, 1, 0); PG8_SCHED; PG8_LDA(At, 1, 0); PG8_STAGE(PG8_SA(0, 1), a2 + hstepA, voffA);
            PG8_WAIT_L(8); PG8_BAR; PG8_WAIT_L(0); PG8_MMA(0, 0, At, B0); PG8_BAR; PG8_SCHED;
            PG8_LDB(B1, 1, 1); PG8_STAGE(PG8_SB(1, 0), b3, voffB);
            PG8_BAR; PG8_WAIT_L(0); PG8_MMA(0, 1, At, B1); PG8_BAR;
            PG8_LDA(At, 1, 1); PG8_STAGE(PG8_SA(1, 0), a3, voffA);
            PG8_BAR; PG8_WAIT_L(0); PG8_MMA(1, 0, At, B0); PG8_BAR; PG8_SCHED;
            PG8_STAGE(PG8_SB(1, 1), b3 + hstepB, voffB);
            PG8_WAIT_V(6); PG8_BAR; PG8_MMA(1, 1, At, B1); PG8_BAR;
            }
        }
        if constexpr (ALIGN_EPI) { if (wr == 0) PG8_BAR; }
        if constexpr (!Epi::AFTER_DRAIN) { E(acc, cur, wr, wc, fr, fq); S.done(cur); }
        if (!has_next) break;
#pragma unroll
        for (int a = 0; a < 2; ++a)
#pragma unroll
            for (int b = 0; b < 2; ++b)
#pragma unroll
                for (int m = 0; m < 4; ++m)
#pragma unroll
                    for (int n = 0; n < 2; ++n) acc[a][b][m][n] = (f32x4){0.f, 0.f, 0.f, 0.f};
        cur = nxt; cA = nA; cB = nB; ++ui;
        if constexpr (ALIGN_EPI) { if (wr == 1) PG8_BAR; }
    }
    PG8_WAIT_V(0);
    if constexpr (!ALIGN_EPI) { if (wr == 0) PG8_BAR; }
    PG8_BAR;
#undef PG8_SA
#undef PG8_SB
#undef PG8_STAGE
#undef PG8_LDA
#undef PG8_LDB
#undef PG8_MMA
#undef PG8_WAIT_V
#undef PG8_WAIT_L
#undef PG8_BAR
#undef PG8_SCHED
}
}

namespace att {
using bf16x8 = __attribute__((ext_vector_type(8))) short;
using s16x4  = __attribute__((ext_vector_type(4))) short;
using f32x16 = __attribute__((ext_vector_type(16))) float;
using f32x4  = __attribute__((ext_vector_type(4))) float;
using u32x4  = __attribute__((ext_vector_type(4))) unsigned;
typedef unsigned short bf16_t;
constexpr int NW = 8, QBLK = 32, KVBLK = 64;
constexpr int SHM_V = 8192, SHM_KN = 8192, SHM_KR = 4096;
constexpr int OFF_V = 0, OFF_KN = 2 * SHM_V, OFF_KR = OFF_KN + 2 * SHM_KN, OFF_WS = OFF_KR + 2 * SHM_KR, OFF_BIAS = OFF_WS + NW * 64 * 4 + 1024  , LDS_BYTES = OFF_BIAS + 15 * 32 * 4 + 1024;
#define ATT_SBAR() __builtin_amdgcn_sched_barrier(0)
__device__ __forceinline__ int crow(int r, int hi) { return (r & 3) + 8 * (r >> 2) + 4 * hi; }
__device__ __forceinline__ unsigned cvtpk(float lo, float hi) { return pg8::cvt_pk_bf16(lo, hi); }
__device__ __forceinline__ float bf2f(short s) { return __uint_as_float(((unsigned)(unsigned short)s) << 16); }
__device__ __forceinline__ int kn_off(int row, int chunk) { return row * 128 + ((chunk ^ ((row >> 1) & 7)) << 4); }
__device__ __forceinline__ int kr_off(int row, int chunk) { return row * 64 + ((chunk ^ ((row >> 2) & 3)) << 4); }
__device__ __forceinline__ int v_st(int k, int c) { const int kk = (k & ~0xC) | ((k & 4) << 1) | ((k & 8) >> 1); return ((kk >> 3) * 2 + (c >> 5)) * 512 + ((kk & 7) * 32 + (c & 31)) * 2; }
__device__ __forceinline__ int v_rd_base(int lane) { return ((lane & 3) << 3) | (((lane >> 2) & 3) << 6) | (((lane >> 4) & 1) << 5) | (((lane >> 5) & 1) << 8); }
constexpr int v_rd_off(int d0, int ks, int half) { return d0 * 512 + ks * 2048 + half * 1024; }
template <int OFF> __device__ __forceinline__ s16x4 tr_read(int vb) { s16x4 r; asm volatile("ds_read_b64_tr_b16 %0, %1 offset:%2" : "=&v"(r) : "v"(vb), "i"(OFF) : "memory"); return r; }

template <int D0> __device__ __forceinline__ void pv_one(f32x16& od, int vb, bf16x8 pa0, bf16x8 pa1, bf16x8 pa2, bf16x8 pa3) {
  const s16x4 l0 = tr_read<v_rd_off(D0, 0, 0)>(vb), h0 = tr_read<v_rd_off(D0, 0, 1)>(vb), l1 = tr_read<v_rd_off(D0, 1, 0)>(vb), h1 = tr_read<v_rd_off(D0, 1, 1)>(vb);
  const s16x4 l2 = tr_read<v_rd_off(D0, 2, 0)>(vb), h2 = tr_read<v_rd_off(D0, 2, 1)>(vb), l3 = tr_read<v_rd_off(D0, 3, 0)>(vb), h3 = tr_read<v_rd_off(D0, 3, 1)>(vb);
  asm volatile("s_waitcnt lgkmcnt(0)" ::: "memory"); ATT_SBAR();
#define ATT_PK(L, H) (bf16x8){L[0], L[1], L[2], L[3], H[0], H[1], H[2], H[3]}
  od = __builtin_amdgcn_mfma_f32_32x32x16_bf16(pa0, ATT_PK(l0, h0), od, 0, 0, 0);
  od = __builtin_amdgcn_mfma_f32_32x32x16_bf16(pa1, ATT_PK(l1, h1), od, 0, 0, 0);
  od = __builtin_amdgcn_mfma_f32_32x32x16_bf16(pa2, ATT_PK(l2, h2), od, 0, 0, 0);
  od = __builtin_amdgcn_mfma_f32_32x32x16_bf16(pa3, ATT_PK(l3, h3), od, 0, 0, 0);
#undef ATT_PK
}

template <int DKR> struct Cst { static constexpr float SCALE = DKR ? 0.10206207261596577f : 0.125f; static constexpr float C = SCALE * 1.4426950408889634f; };

template <int DKR> __device__ __forceinline__ void partialSM(f32x16& p0, f32x16& p1, float& m_reg, float& alpha) {
  constexpr float C = Cst<DKR>::C;
  float pmax = p0[0];
#pragma unroll
  for (int r = 1; r < 16; ++r) pmax = fmaxf(pmax, p0[r]);
#pragma unroll
  for (int r = 0; r < 16; ++r) pmax = fmaxf(pmax, p1[r]);
  { auto rr = __builtin_amdgcn_permlane32_swap(__float_as_uint(pmax), __float_as_uint(pmax), false, false);
    pmax = fmaxf(__uint_as_float(rr[0]), __uint_as_float(rr[1])); }
  float mn;
  if (__builtin_expect(__all(pmax <= m_reg), 1)) { mn = m_reg; alpha = 1.f; }
  else { mn = fmaxf(m_reg, pmax); alpha = __builtin_amdgcn_exp2f((m_reg - mn) * C); m_reg = mn; }
  const float mnC = -mn * C;
#pragma unroll
  for (int r = 0; r < 16; ++r) p0[r] = fmaf(p0[r], C, mnC);
#pragma unroll
  for (int r = 0; r < 16; ++r) p1[r] = fmaf(p1[r], C, mnC);
#pragma unroll
  for (int r = 0; r < 16; ++r) p0[r] = __builtin_amdgcn_exp2f(p0[r]);
}
__device__ __forceinline__ void finishSM(f32x16& p0, f32x16& p1, float alpha, float& l_reg, bf16x8& pa0, bf16x8& pa1, bf16x8& pa2, bf16x8& pa3) {
#pragma unroll
  for (int r = 0; r < 16; ++r) p1[r] = __builtin_amdgcn_exp2f(p1[r]);
  float ps = 0;
#pragma unroll
  for (int r = 0; r < 16; ++r) ps += p0[r];
#pragma unroll
  for (int r = 0; r < 16; ++r) ps += p1[r];
  { auto rr = __builtin_amdgcn_permlane32_swap(__float_as_uint(ps), __float_as_uint(ps), false, false);
    ps = __uint_as_float(rr[0]) + __uint_as_float(rr[1]); }
  l_reg = l_reg * alpha + ps;
#define ATT_PK4(P, BASE, OUT) do { unsigned a0 = cvtpk(P[BASE + 0], P[BASE + 1]), a1 = cvtpk(P[BASE + 2], P[BASE + 3]);   \
    unsigned b0 = cvtpk(P[BASE + 4], P[BASE + 5]), b1 = cvtpk(P[BASE + 6], P[BASE + 7]);                              \
    auto r0 = __builtin_amdgcn_permlane32_swap(a0, b0, false, false); auto r1 = __builtin_amdgcn_permlane32_swap(a1, b1, false, false); \
    u32x4 w = {r0[0], r1[0], r0[1], r1[1]}; OUT = *reinterpret_cast<bf16x8*>(&w); } while (0)
  ATT_PK4(p0, 0, pa0); ATT_PK4(p0, 8, pa1); ATT_PK4(p1, 0, pa2); ATT_PK4(p1, 8, pa3);
#undef ATT_PK4
}
template <int DKR> __device__ __forceinline__ void qkt(f32x16& p0, f32x16& p1, const char* Kn, const char* Kr, const bf16x8* qr, int r32, int hi) {
  p0 = f32x16{}; p1 = f32x16{};
#pragma unroll
  for (int d0 = 0; d0 < 4; ++d0) {
    const bf16x8 b0 = *reinterpret_cast<const bf16x8*>(Kn + kn_off(r32, d0 * 2 + hi));
    const bf16x8 b1 = *reinterpret_cast<const bf16x8*>(Kn + kn_off(32 + r32, d0 * 2 + hi));
    p0 = __builtin_amdgcn_mfma_f32_32x32x16_bf16(b0, qr[d0], p0, 0, 0, 0);
    p1 = __builtin_amdgcn_mfma_f32_32x32x16_bf16(b1, qr[d0], p1, 0, 0, 0); }
  if constexpr (DKR != 0) {
#pragma unroll
    for (int d0 = 0; d0 < 2; ++d0) {
      const bf16x8 b0 = *reinterpret_cast<const bf16x8*>(Kr + kr_off(r32, d0 * 2 + hi));
      const bf16x8 b1 = *reinterpret_cast<const bf16x8*>(Kr + kr_off(32 + r32, d0 * 2 + hi));
      p0 = __builtin_amdgcn_mfma_f32_32x32x16_bf16(b0, qr[4 + d0], p0, 0, 0, 0);
      p1 = __builtin_amdgcn_mfma_f32_32x32x16_bf16(b1, qr[4 + d0], p1, 0, 0, 0); }
  }
}

__device__ __forceinline__ void na_mask(f32x16& p0, f32x16& p1, const char* brow_b, int a, bool tile_ok) {
  const float NEG = -INFINITY;
#pragma unroll
  for (int r = 0; r < 16; ++r) { const int cr = (r & 3) + 8 * (r >> 2);
    const float b0 = *reinterpret_cast<const float*>(brow_b + cr * 4), b1 = *reinterpret_cast<const float*>(brow_b + (cr + 32) * 4);
    const bool v0 = tile_ok && ((unsigned)(cr + a) < 16u), v1 = tile_ok && ((unsigned)(cr + 32 + a) < 16u);
    p0[r] = v0 ? fmaf(8.0f, b0, p0[r]) : NEG; p1[r] = v1 ? fmaf(8.0f, b1, p1[r]) : NEG; }
}
template <int DKR, bool NA = false>
__device__ __forceinline__ void attn_unit(const bf16_t* __restrict__ Qb, int ldq, const bf16_t* __restrict__ Kn, int ldk, const bf16_t* __restrict__ Kr, int ldkr,
                                          const bf16_t* __restrict__ Vh, int ldv, bf16_t* __restrict__ Ob, int ldo, int seq, const float* __restrict__ qtab, char* lds,
                                          const float* __restrict__ rpb_h = nullptr, int r0 = 0, int kstart = 0) {
  const int tid = opaque_v(threadIdx.x), wid = tid >> 6, lane = tid & 63, r32 = lane & 31, hi = lane >> 5;
  char* V_lds = lds + OFF_V; char* KN_lds = lds + OFF_KN; char* KR_lds = lds + OFF_KR;
  float* ws = (float*)(lds + OFF_WS) + wid * 64; float* li_l = ws; float* al_l = ws + 32;
  float m_reg = -1e30f, l_reg = 0; f32x16 o[2] = {}; bf16x8 qr[DKR ? 6 : 4];
  const bf16_t* Qw = Qb + (long)(wid * QBLK + r32) * ldq + hi * 8;
#pragma unroll
  for (int d0 = 0; d0 < 4; ++d0) qr[d0] = *reinterpret_cast<const bf16x8*>(Qw + d0 * 16);
  if constexpr (DKR != 0) {
    const bf16x8 x1 = *reinterpret_cast<const bf16x8*>(Qw + 64), x2 = *reinterpret_cast<const bf16x8*>(Qw + 80);
    const float* tb = qtab + (long)(wid * QBLK + r32) * 32 + hi * 8;
    const f32x4 c0 = *(const f32x4*)(tb), c1 = *(const f32x4*)(tb + 4), s0 = *(const f32x4*)(tb + 16), s1 = *(const f32x4*)(tb + 20);
    float y1[8], y2[8];
#pragma unroll
    for (int j = 0; j < 8; ++j) { const float a = bf2f(x1[j]), b = bf2f(x2[j]); const float cc = j < 4 ? c0[j & 3] : c1[j & 3], ss = j < 4 ? s0[j & 3] : s1[j & 3];
      y1[j] = a * cc - b * ss; y2[j] = b * cc + a * ss; }
    u32x4 w1 = {cvtpk(y1[0], y1[1]), cvtpk(y1[2], y1[3]), cvtpk(y1[4], y1[5]), cvtpk(y1[6], y1[7])};
    u32x4 w2 = {cvtpk(y2[0], y2[1]), cvtpk(y2[2], y2[3]), cvtpk(y2[4], y2[5]), cvtpk(y2[6], y2[7])};
    qr[4] = *reinterpret_cast<bf16x8*>(&w1); qr[5] = *reinterpret_cast<bf16x8*>(&w2);
  }
  const int sr = tid >> 3, sc8 = tid & 7, knst = kn_off(sr, sc8), vst = v_st(sr, sc8 * 8);
  const int rr_ = (tid >> 2) & 63, rc_ = tid & 3, krst = kr_off(rr_, rc_);
  const bool do_kr = (DKR != 0) && (tid < 256);
  const int vb0 = (int)(uintptr_t)V_lds + v_rd_base(lane);
  bf16x8 sK0, sV0, sR0, sK1, sV1, sR1;
  sR0 = bf16x8{}; sR1 = bf16x8{};
#define ATT_SLOAD(SK, SV, SR, k0) do { SK = *reinterpret_cast<const bf16x8*>(Kn + (long)((k0) + sr) * ldk + sc8 * 8); SV = *reinterpret_cast<const bf16x8*>(Vh + (long)((k0) + sr) * ldv + sc8 * 8); \
    if (do_kr) SR = *reinterpret_cast<const bf16x8*>(Kr + (long)((k0) + rr_) * ldkr + rc_ * 8); } while (0)
#define ATT_SWRITE(b, SK, SV, SR) do { *(bf16x8*)(V_lds + (b) * SHM_V + vst) = SV; *(bf16x8*)(KN_lds + (b) * SHM_KN + knst) = SK; \
    if (do_kr) *(bf16x8*)(KR_lds + (b) * SHM_KR + krst) = SR; } while (0)
#define ATT_RESC(a) do { if (__any((a) < 1.f)) { if (hi == 0) al_l[r32] = (a); asm volatile("s_waitcnt lgkmcnt(0)" ::: "memory"); \
    _Pragma("unroll") for (int d = 0; d < 2; ++d) _Pragma("unroll") for (int r = 0; r < 16; ++r) o[d][r] *= al_l[crow(r, hi)]; } } while (0)
  f32x16 pA0, pA1, pB0, pB1; float alA, alB; bf16x8 pa0, pa1, pa2, pa3; const int NT = seq / KVBLK;
  const int na_r = r0 + (wid >> 1), na_rs = min(max(na_r - 4, 0), 24), na_qc = (wid & 1) * 32 + r32, na_ws = min(max(na_qc - 8, 0), 48);
  const int na_a = 4 * hi - na_ws; const char* na_b0 = lds + OFF_BIAS + (4 * hi - na_qc + 15) * 4;
  if constexpr (NA) { float* bt = (float*)(lds + OFF_BIAS); if (tid < 15 * 32) bt[tid] = ((tid & 31) < 31) ? rpb_h[(tid >> 5) * 31 + (tid & 31)] : 0.f; }
#define ATT_NAMASK(P0, P1, t) do { if constexpr (NA) { const int kr_ = kstart + (t); const bool ok_ = (unsigned)(kr_ - na_rs) < 8u; const int ro_ = min(max(kr_ - na_r + 7, 0), 14); \
    na_mask(P0, P1, na_b0 + ro_ * 128, na_a, ok_); } } while (0)
  ATT_SLOAD(sK0, sV0, sR0, 0); ATT_SWRITE(0, sK0, sV0, sR0); __syncthreads();
  qkt<DKR>(pA0, pA1, KN_lds, KR_lds, qr, r32, hi); ATT_NAMASK(pA0, pA1, 0); partialSM<DKR>(pA0, pA1, m_reg, alA);
  ATT_SLOAD(sK1, sV1, sR1, KVBLK); if (2 < NT) ATT_SLOAD(sK0, sV0, sR0, 2 * KVBLK);
  ATT_SWRITE(1, sK1, sV1, sR1); __syncthreads();
  for (int j = 1; j + 1 < NT; j += 2) {
    ATT_SBAR(); qkt<DKR>(pB0, pB1, KN_lds + SHM_KN, KR_lds + SHM_KR, qr, r32, hi); ATT_NAMASK(pB0, pB1, j);
    finishSM(pA0, pA1, alA, l_reg, pa0, pa1, pa2, pa3); ATT_SBAR();
    ATT_SLOAD(sK1, sV1, sR1, (j + 2) * KVBLK); ATT_SBAR();
    pv_one<0>(o[0], vb0, pa0, pa1, pa2, pa3); pv_one<1>(o[1], vb0, pa0, pa1, pa2, pa3); partialSM<DKR>(pB0, pB1, m_reg, alB);
    __syncthreads(); ATT_SWRITE(0, sK0, sV0, sR0);
    ATT_RESC(alB); __syncthreads();
    ATT_SBAR(); qkt<DKR>(pA0, pA1, KN_lds, KR_lds, qr, r32, hi); ATT_NAMASK(pA0, pA1, j + 1);
    finishSM(pB0, pB1, alB, l_reg, pa0, pa1, pa2, pa3); ATT_SBAR();
    if (j + 3 < NT) ATT_SLOAD(sK0, sV0, sR0, (j + 3) * KVBLK); ATT_SBAR();
    pv_one<0>(o[0], vb0 + SHM_V, pa0, pa1, pa2, pa3); pv_one<1>(o[1], vb0 + SHM_V, pa0, pa1, pa2, pa3); partialSM<DKR>(pA0, pA1, m_reg, alA);
    __syncthreads(); ATT_SWRITE(1, sK1, sV1, sR1);
    ATT_RESC(alA); __syncthreads();
  }
  ATT_SBAR(); qkt<DKR>(pB0, pB1, KN_lds + SHM_KN, KR_lds + SHM_KR, qr, r32, hi); ATT_NAMASK(pB0, pB1, NT - 1);
  finishSM(pA0, pA1, alA, l_reg, pa0, pa1, pa2, pa3); ATT_SBAR();
  pv_one<0>(o[0], vb0, pa0, pa1, pa2, pa3); pv_one<1>(o[1], vb0, pa0, pa1, pa2, pa3); partialSM<DKR>(pB0, pB1, m_reg, alB);
  __syncthreads(); ATT_RESC(alB);
  finishSM(pB0, pB1, alB, l_reg, pa0, pa1, pa2, pa3); ATT_SBAR();
  pv_one<0>(o[0], vb0 + SHM_V, pa0, pa1, pa2, pa3); pv_one<1>(o[1], vb0 + SHM_V, pa0, pa1, pa2, pa3);
  if (hi == 0) li_l[r32] = l_reg; asm volatile("s_waitcnt lgkmcnt(0)" ::: "memory");
  float rli[16];
#pragma unroll
  for (int r = 0; r < 16; ++r) rli[r] = __builtin_amdgcn_rcpf(li_l[crow(r, hi)]);
  bf16_t* Ow = Ob + (long)(wid * QBLK) * ldo;
#pragma unroll
  for (int r = 0; r < 16; ++r) { const int orow = crow(r, hi);
#pragma unroll
    for (int d0 = 0; d0 < 2; ++d0) { const float v = o[d0][r] * rli[r]; Ow[(long)orow * ldo + d0 * 32 + r32] = (bf16_t)(cvtpk(v, v) & 0xffffu); } }
  __syncthreads();
#undef ATT_SLOAD
#undef ATT_SWRITE
#undef ATT_RESC
#undef ATT_NAMASK
}
#undef ATT_SBAR
}

constexpr int NWAVES = 8;
constexpr int BATCH = 8, SEQ = 2048, DM = 1024, DEPTH = 2, M = BATCH * SEQ;
constexpr int GRID_W = 64, NROWS = SEQ / GRID_W;
constexpr int IN_COLS = 5024, N1 = 2048  , NG = 3072, N1_USED = 1952;
constexpr int FFN = 2816, NMOD = 6;
constexpr float NORM_EPS = 1e-6f;
constexpr int C_QA = 0, C_KA = 256, C_VA = 512, C_CQ = 768, C_CKV = 1024, C_KR = 1152, C_QC = 1184, C_KC = 1696, C_VC = 1824;

constexpr size_t MiB = 1u << 20;
constexpr size_t WS_CTL = 0, CTL_ZERO_BYTES = 64 * 1024;
constexpr size_t WS_MOD = 1 * MiB;
constexpr size_t WS_TABT = WS_MOD + 512 * 1024;
constexpr size_t WS_TABA = WS_TABT + 256 * 1024;
constexpr size_t WS_W = 2 * MiB;
constexpr size_t W_1 = 0, W_G = W_1 + (size_t)N1 * DM * 2, W_2 = W_G + (size_t)NG * DM * 2, W_BNA = W_2 + (size_t)1024 * 384 * 2, W_BMLA = W_BNA + (size_t)1024 * 256 * 2,
                 W_BGQA = W_BMLA + (size_t)1024 * 256 * 2, W_OUT = W_BGQA + (size_t)1024 * 512 * 2, W_GU = W_OUT + (size_t)1024 * 1024 * 2, W_DN = W_GU + (size_t)2 * FFN * DM * 2,
                 LAYER_W_BYTES = W_DN + (size_t)DM * FFN * 2;
static_assert(LAYER_W_BYTES == 32768000, "weights per layer");
constexpr size_t WS_ROWSS_A = 64 * MiB + 512 * 1024, WS_ROWSS_B = WS_ROWSS_A + 256 * 1024;
constexpr size_t WS_BIAS = WS_ROWSS_B + 256 * 1024;
constexpr int NB1 = N1, NBG = NG, NBGU = 2 * FFN, BIAS_PER_LAYER = 8 * (NB1 + NBG + NBGU);
constexpr size_t WS_XG2 = 194 * MiB;
constexpr size_t WS_H = 66 * MiB;
constexpr size_t WS_P1 = 98 * MiB;
constexpr size_t WS_KPE = 162 * MiB;
constexpr size_t WS_QC = 163 * MiB;
constexpr size_t WS_KC = 179 * MiB;
constexpr size_t WS_P2 = 183 * MiB;
constexpr size_t WS_OCAT = 215 * MiB;
constexpr size_t WS_A2 = 215 * MiB;
constexpr size_t WS_GATES = 98 * MiB;
constexpr size_t WS_ACT = 98 * MiB;
constexpr size_t WS_END = 247 * MiB;
static_assert(WS_W + 2 * LAYER_W_BYTES <= WS_ROWSS_A && WS_BIAS + (size_t)2 * BIAS_PER_LAYER * 4 <= WS_H && WS_XG2 + (size_t)M * DM * 2 <= WS_END && WS_GATES + (size_t)M * NG * 2 <= WS_OCAT && WS_ACT + (size_t)M * FFN * 2 <= WS_OCAT, "ws map");
constexpr int CW_BAR = 4096;

constexpr int RING_OFF = 0, RING_BYTES = 131072;
constexpr int LDSCTL_OFF = RING_BYTES, MISC_OFF = LDSCTL_OFF + 320;
constexpr int EPIX_OFF = 132096;
constexpr int LDS_BYTES = 147456;

#define GAS __attribute__((address_space(1)))
#define LAS __attribute__((address_space(3)))
typedef unsigned short bf16;
typedef unsigned v4u __attribute__((ext_vector_type(4)));
typedef unsigned v2u __attribute__((ext_vector_type(2)));
typedef float f32x4 __attribute__((ext_vector_type(4)));
typedef short bf16x8 __attribute__((ext_vector_type(8)));
typedef GAS unsigned gu32;
#define RLX_AGENT __ATOMIC_RELAXED, __HIP_MEMORY_SCOPE_AGENT
#define LDS_WAIT() asm volatile("s_waitcnt lgkmcnt(0)" ::: "memory")
__device__ __forceinline__ unsigned f2bf(float f) { unsigned u = __builtin_bit_cast(unsigned, f); return (u + 0x7fffu + ((u >> 16) & 1u)) >> 16; }
__device__ __forceinline__ unsigned pk2(float lo, float hi) { return f2bf(lo) | (f2bf(hi) << 16); }
__device__ __forceinline__ float bflo(unsigned w) { return __uint_as_float(w << 16); }
__device__ __forceinline__ float bfhi(unsigned w) { return __uint_as_float(w & 0xffff0000u); }
__device__ __forceinline__ float bf1(bf16 s) { return __uint_as_float(((unsigned)s) << 16); }

#define XB_TMO      128
#define XB_XCNT(j)  (256  + 64 * (j))
#define XB_XSUB(j)  (1280 + 64 * (j))
#define XB_XGEN(j)  (2304 + 64 * (j))
#define XB_TOP      3328
#define XB_TOPGEN   3392
#define XCD_BAR_WORDS 3456
#define XB_SPIN_CAP (1u << 18)
__device__ __forceinline__ unsigned xb_ld(unsigned* p)              { return __hip_atomic_load(p, __ATOMIC_RELAXED, __HIP_MEMORY_SCOPE_AGENT); }
__device__ __forceinline__ unsigned xb_add(unsigned* p, unsigned v) { return __hip_atomic_fetch_add(p, v, __ATOMIC_RELAXED, __HIP_MEMORY_SCOPE_AGENT); }
__device__ __forceinline__ unsigned xb_xcc_id() { return (unsigned)__builtin_amdgcn_s_getreg((3 << 11) | 20) & 0xFu; }
#define XB_SPIN(cond, bar) do { unsigned _sp = 0; while (cond) { __builtin_amdgcn_s_sleep(1); \
    if ((++_sp & 255u) == 0u) { if (xb_ld(&(bar)[XB_TMO])) break; if (_sp > XB_SPIN_CAP) { atomicAdd(&(bar)[XB_TMO], 1u); break; } } } } while (0)
struct XcdBarrier { unsigned* bar; unsigned x; volatile LAS unsigned* st; };
__device__ __forceinline__ XcdBarrier xcd_barrier_post(unsigned* bar, volatile LAS unsigned* st) {
    XcdBarrier b; b.bar = bar; b.x = xb_xcc_id(); b.st = st;
    if (threadIdx.x == 0) (void)xb_add(&bar[XB_XCNT(b.x)], 1u);
    return b;
}
__device__ __forceinline__ void xcd_barrier_complete(unsigned* bar, unsigned x, unsigned& nloc, unsigned& nx) {
    const unsigned G = gridDim.x * gridDim.y * gridDim.z;
    unsigned sum, cnt, mine, sp = 0u;
    for (;;) {
        sum = 0u; cnt = 0u; mine = 0u;
#pragma unroll
        for (unsigned j = 0; j < 16; ++j) { const unsigned c = xb_ld(&bar[XB_XCNT(j)]); sum += c; cnt += (c > 0u) ? 1u : 0u; mine = (j == x) ? c : mine; }
        if (sum == G) break;
        __builtin_amdgcn_s_sleep(1);
        if ((++sp & 255u) == 0u) { if (xb_ld(&bar[XB_TMO])) break; if (sp > XB_SPIN_CAP) { atomicAdd(&bar[XB_TMO], 1u); break; } }
    }
    nloc = mine > 0u ? mine : 1u; nx = cnt > 0u ? cnt : 1u;
}
__device__ __forceinline__ void xcd_barrier(const XcdBarrier& b) {
    asm volatile("s_waitcnt vmcnt(0)" ::: "memory");
    __syncthreads();
    if (threadIdx.x == 0) {
        unsigned* bar = b.bar;
        __builtin_amdgcn_s_waitcnt(0);
        unsigned nloc = b.st[0], nx = b.st[1];
        if (nloc == 0u) { xcd_barrier_complete(bar, b.x, nloc, nx); b.st[0] = nloc; b.st[1] = nx; }
        const unsigned old = xb_add(&bar[XB_XSUB(b.x)], 1u);
        const unsigned gen = old / nloc;
        if (old + 1u == (gen + 1u) * nloc) {
            __builtin_amdgcn_fence(__ATOMIC_RELEASE, "agent");
            asm volatile("s_waitcnt vmcnt(0)" ::: "memory");
            const unsigned og = xb_add(&bar[XB_TOP], 1u);
            const unsigned tg = og / nx;
            if (og + 1u == (tg + 1u) * nx) xb_add(&bar[XB_TOPGEN], 1u);
            else XB_SPIN(xb_ld(&bar[XB_TOPGEN]) == tg, bar);
            __builtin_amdgcn_fence(__ATOMIC_ACQUIRE, "agent");
            xb_add(&bar[XB_XGEN(b.x)], 1u);
            asm volatile("s_waitcnt vmcnt(0)" ::: "memory");
        } else {
            XB_SPIN(xb_ld(&bar[XB_XGEN(b.x)]) == gen, bar);
            __builtin_amdgcn_fence(__ATOMIC_ACQUIRE, "agent");
            asm volatile("s_waitcnt vmcnt(0)" ::: "memory");
        }
    }
    __syncthreads();
}

struct Args { const float* in[21]; float* out; unsigned char* ws; int ph_lo, ph_hi; };
struct LayerW { bf16 *w1, *wg, *w2, *bna, *bmla, *bgqa, *wout, *wgu, *wdn; };
__device__ __forceinline__ LayerW layer_w(unsigned char* ws, int l) {
    unsigned char* b = ws + WS_W + (size_t)l * LAYER_W_BYTES; LayerW w;
    w.w1 = (bf16*)(b + W_1); w.wg = (bf16*)(b + W_G); w.w2 = (bf16*)(b + W_2); w.bna = (bf16*)(b + W_BNA); w.bmla = (bf16*)(b + W_BMLA); w.bgqa = (bf16*)(b + W_BGQA);
    w.wout = (bf16*)(b + W_OUT); w.wgu = (bf16*)(b + W_GU); w.wdn = (bf16*)(b + W_DN); return w;
}
__device__ __forceinline__ float wave_sum(float v) {
#pragma unroll
    for (int o = 1; o < 64; o <<= 1) v += __shfl_xor(v, o);
    return v;
}
__device__ __forceinline__ void sincos_d(double x, double& s, double& c) {
    const double k = __builtin_rint(x * 0.15915494309189535);
    double r = __builtin_fma(-k, 6.283185307179586, x); r = __builtin_fma(-k, 2.4492935982947064e-16, r);
    const double r2 = r * r; double tc = 1.0, ts = 1.0, cs = 1.0, ss = 1.0;
#pragma unroll 1
    for (int n = 1; n <= 15; ++n) { tc *= -r2 / (double)((2 * n - 1) * (2 * n)); cs += tc; ts *= -r2 / (double)((2 * n) * (2 * n + 1)); ss += ts; }
    s = r * ss; c = cs;
}
__device__ __forceinline__ float inv_freq(int i) {
    const float q[4] = {1.0f, 0.5623413251903491f, 0.31622776601683794f, 0.17782794100389228f};
    const float p[4] = {1.0f, 0.1f, 0.01f, 0.001f};
    float a = (i & 3) == 0 ? q[0] : (i & 3) == 1 ? q[1] : (i & 3) == 2 ? q[2] : q[3];
    float b = (i >> 2) == 0 ? p[0] : (i >> 2) == 1 ? p[1] : (i >> 2) == 2 ? p[2] : p[3];
    return (float)((double)a * (double)b);
}

template <class RowPtr>
__device__ __forceinline__ void transpose_item(const float* W, int N, int k0, int n0, const RowPtr& rp, LAS float* scr, int lane) {
#pragma unroll 8
    for (int i = 0; i < 32; ++i) { const int kk = 2 * i + (lane >> 5); scr[kk * 33 + (lane & 31)] = W[(size_t)(k0 + kk) * N + n0 + (lane & 31)]; }
    LDS_WAIT(); asm volatile("" ::: "memory");
    const int c = lane & 7;
#pragma unroll
    for (int j = 0; j < 4; ++j) { const int n = (lane >> 3) + 8 * j; const LAS float* s = scr + (8 * c) * 33 + n;
        v4u o; o.x = pk2(s[0 * 33], s[1 * 33]); o.y = pk2(s[2 * 33], s[3 * 33]); o.z = pk2(s[4 * 33], s[5 * 33]); o.w = pk2(s[6 * 33], s[7 * 33]);
        *(GAS v4u*)(rp(n0 + n) + k0 + 8 * c) = o; }
    LDS_WAIT(); asm volatile("" ::: "memory");
}
struct RpPlain { bf16* base; int ld; int roff; int koff; __device__ __forceinline__ bf16* operator()(int n) const { return base + (size_t)(n + roff) * ld + koff; } };
struct RpWin { bf16* w1; bf16* wg; __device__ __forceinline__ bf16* operator()(int n) const { return n < N1_USED ? w1 + (size_t)n * DM : wg + (size_t)(n - N1_USED) * DM; } };
struct RpGU { bf16* base; __device__ __forceinline__ bf16* operator()(int n) const { const int j = n < FFN ? n : n - FFN; return base + (size_t)(256 * (j >> 7) + (n < FFN ? 0 : 128) + (j & 127)) * DM; } };


#ifndef SELFCHECK
#define SELFCHECK 0
#endif
#if SELFCHECK
constexpr size_t WS_SAVE = WS_TABA + 16 * 1024;
constexpr int CW_FLAGS = 64;
__device__ __forceinline__ unsigned hash_u(unsigned x) { x ^= x >> 16; x *= 0x7feb352dU; x ^= x >> 15; x *= 0x846ca68bU; x ^= x >> 16; return x; }
__device__ __forceinline__ bool nclose(float a, float ref, float tol) { return !(fabsf(a - ref) <= tol); }
__device__ __forceinline__ int save_row(int s) { return (s * 509 + 13) % M; }
template <int ST> __device__ __forceinline__ void selfcheck(const Args& args, int l, unsigned* flags) {
    unsigned char* ws = args.ws;
    const int gtid = opaque_v(blockIdx.x * (NWAVES * 64) + threadIdx.x);
    const unsigned hsh = hash_u((unsigned)gtid * 2654435761u + ST * 977u + l * 7919u);
    const float* modp = (const float*)(ws + WS_MOD); const float* tabt = (const float*)(ws + WS_TABT); const float* taba = (const float*)(ws + WS_TABA);
    const bf16* Hb = (const bf16*)(ws + WS_H); const bf16* P1 = (const bf16*)(ws + WS_P1); const bf16* KPE = (const bf16*)(ws + WS_KPE); const bf16* QC = (const bf16*)(ws + WS_QC); const bf16* KC = (const bf16*)(ws + WS_KC);
    const bf16* P2 = (const bf16*)(ws + WS_P2); const bf16* OCAT = (const bf16*)(ws + WS_OCAT); const bf16* A2 = (const bf16*)(ws + WS_A2); const bf16* GATES = (const bf16*)(ws + WS_GATES); const bf16* ACT = (const bf16*)(ws + WS_ACT);
    float* saved = (float*)(ws + WS_SAVE);
    const float* mod = modp + (size_t)l * BATCH * NMOD * DM;
    const float* xcur = (l == 0) ? args.in[0] : args.out; const float* xres = args.out;
    bool bad = false;
    const int m = hsh % M, b = m / SEQ, t = m % SEQ; const unsigned h2 = hsh >> 14;
    if constexpr (ST == 0) {
        const int ll = hsh & 1, bb = (hsh >> 1) & 7, j = (hsh >> 4) % (NMOD * DM); float ref = args.in[3][(size_t)ll * NMOD * DM + j];
        for (int k = 0; k < DM; ++k) { const float v = args.in[1][bb * DM + k]; ref += (v / (1.0f + expf(-v))) * args.in[2][((size_t)ll * DM + k) * (NMOD * DM) + j]; }
        bad = nclose(modp[((size_t)ll * BATCH + bb) * (NMOD * DM) + j], ref, 1e-3f + 1e-3f * fabsf(ref));
    } else if constexpr (ST == 1) {
        const int tt = hsh % SEQ, i = (hsh >> 11) & 15, p = (hsh >> 15) & 63;
        const float a1 = (float)tt * inv_freq(i), a2 = (float)p * inv_freq(i);
        bad = nclose(tabt[tt * 32 + i], cosf(a1), 2e-4f) || nclose(tabt[tt * 32 + 16 + i], sinf(a1), 2e-4f) || nclose(taba[p * 32 + i], cosf(a2), 2e-4f) || nclose(taba[p * 32 + 16 + i], sinf(a2), 2e-4f);
    } else if constexpr (ST == 2 || ST == 12) {
        const float* x = (ST == 2 ? xcur : xres) + (size_t)m * DM; const int c = h2 % DM; float ss = 0.f;
        for (int k = 0; k < DM; ++k) ss += x[k] * x[k];
        const float rstd = 1.0f / sqrtf(ss / DM + NORM_EPS); const float* g = args.in[ST == 2 ? 4 : 5] + (size_t)l * DM; const float* sh = mod + (size_t)b * NMOD * DM + (ST == 2 ? 0 : 3 * DM);
        const float ref = (x[c] * rstd * g[c]) * (1.0f + sh[DM + c]) + sh[c];
        bad = nclose(bf1(Hb[(size_t)m * DM + c]), ref, 0.01f + 0.01f * fabsf(ref));
    } else if constexpr (ST == 3 || ST == 9) {
        const int n = h2 % (ST == 3 ? N1_USED : NG); const int ncol = ST == 3 ? n : N1_USED + n; const float* W = args.in[6] + (size_t)l * DM * IN_COLS + ncol; float ref = 0.f, s2 = 0.f;
        for (int k = 0; k < DM; ++k) { const float p = bf1(Hb[(size_t)m * DM + k]) * W[(size_t)k * IN_COLS]; ref += p; s2 += p * p; }
        if (ST == 3) bad = nclose(bf1(P1[(size_t)m * N1 + n]), ref, 0.02f * sqrtf(s2) + 0.01f * fabsf(ref) + 1e-3f);
        else { const size_t gi = (size_t)m * NG + n; const unsigned wsys = __hip_atomic_load((unsigned*)(GATES + (gi & ~(size_t)1)), __ATOMIC_RELAXED, __HIP_MEMORY_SCOPE_SYSTEM);
            const bf16 vsys = (bf16)((gi & 1) ? (wsys >> 16) : (wsys & 0xffffu)); const bf16 vpl = GATES[gi];
            bad = nclose(bf1(vsys), 1.0f / (1.0f + expf(-ref)), 0.03f); if (vpl != vsys) atomicOr(flags, 1u << 15);
            { pg8::StaticOrder So; So.init(M, NG, 256, 0); int ui = 3; for (int L = 0; L < 768; ++L) { pg8::StaticOrder S1 = So; S1.c = L & 255; pg8::Unit u; S1.next(L >> 8, u); if (u.pm == m / 256 && u.pn == n / 256) ui = L >> 8; }
              atomicAdd(flags + 2 + ui, 1u); if (bad) atomicAdd(flags + 8 + ui, 1u); } }
    } else if constexpr (ST == 4) {
        const bf16* pr = P1 + (size_t)m * N1; const int which = h2 & 3; const unsigned h3 = hsh >> 16; const int prow = t / GRID_W, pcol = t % GRID_W;
        if (which == 0) { const int j = h3 % 384; const int base = j < 256 ? C_CQ : C_CKV, n = j < 256 ? 256 : 128, jj = j < 256 ? j : j - 256; float ss = 0.f;
            for (int k = 0; k < n; ++k) { const float v = bf1(pr[base + k]); ss += v * v; }
            const float g = j < 256 ? args.in[8][(size_t)l * 256 + jj] : args.in[9][(size_t)l * 128 + jj];
            const float ref = bf1(pr[base + jj]) / sqrtf(ss / n + NORM_EPS) * g; bad = nclose(bf1(A2[(size_t)m * 384 + j]), ref, 0.02f + 0.01f * fabsf(ref));
        } else if (which == 1) { const int j = h3 % 32, i = j & 15; const float x1 = bf1(pr[C_KR + i]), x2 = bf1(pr[C_KR + 16 + i]), c = tabt[t * 32 + i], sn = tabt[t * 32 + 16 + i];
            const float ref = j < 16 ? x1 * c - x2 * sn : x2 * c + x1 * sn; bad = nclose(bf1(KPE[(size_t)m * 32 + j]), ref, 0.02f + 0.01f * fabsf(ref));
        } else { const bool isq = which == 2; const int j = h3 % (isq ? 512 : 128), hd = j / 64, d = j % 64; const bf16* src = pr + (isq ? C_QC : C_KC) + hd * 64; float ss = 0.f;
            for (int k = 0; k < 64; ++k) { const float v = bf1(src[k]); ss += v * v; }
            const float rstd = 1.0f / sqrtf(ss / 64 + NORM_EPS); const float* g = args.in[isq ? 12 : 13] + (size_t)l * 64;
            const int part = d / 32, i = (d % 32) % 16; const bool second = (d % 32) >= 16; const int dp = second ? d - 16 : d + 16; const int pos = part == 0 ? prow : pcol;
            const float y = bf1(src[d]) * rstd * g[d], yp = bf1(src[dp]) * rstd * g[dp], c = taba[pos * 32 + i], sn = taba[pos * 32 + 16 + i];
            const float ref = second ? y * c + yp * sn : y * c - yp * sn;
            bad = nclose(bf1(isq ? QC[(size_t)m * 512 + j] : KC[(size_t)m * 128 + j]), ref, 0.02f + 0.01f * fabsf(ref)); }
    } else if constexpr (ST == 5) {
        const int n = h2 % 896; float ref = 0.f, s2 = 0.f;
        if (n < 384) { const float* W = args.in[10] + (size_t)l * 256 * 384 + n; for (int k = 0; k < 256; ++k) { const float p = bf1(A2[(size_t)m * 384 + k]) * W[(size_t)k * 384]; ref += p; s2 += p * p; } }
        else { const float* W = args.in[11] + (size_t)l * 128 * 512 + (n - 384); for (int k = 0; k < 128; ++k) { const float p = bf1(A2[(size_t)m * 384 + 256 + k]) * W[(size_t)k * 512]; ref += p; s2 += p * p; } }
        bad = nclose(bf1(P2[(size_t)m * 1024 + n]), ref, 0.02f * sqrtf(s2) + 0.01f * fabsf(ref) + 1e-3f);
    } else if constexpr (ST == 6) {
        if (blockIdx.x < 16) { const int h = h2 & 3, d = (h2 >> 2) & 63; const bf16* qp = P2 + (size_t)m * 1024 + h * 96; float q[96];
#pragma unroll
            for (int i = 0; i < 64; ++i) q[i] = bf1(qp[i]);
#pragma unroll
            for (int i = 0; i < 16; ++i) { const float x1 = bf1(qp[64 + i]), x2 = bf1(qp[80 + i]), c = tabt[t * 32 + i], sn = tabt[t * 32 + 16 + i]; q[64 + i] = x1 * c - x2 * sn; q[80 + i] = x2 * c + x1 * sn; }
            float mx = -1e30f, lsum = 0.f, o = 0.f;
            for (int kk = 0; kk < SEQ; ++kk) { const size_t mk = (size_t)b * SEQ + kk; const bf16* kn = P2 + mk * 1024 + 384 + h * 128; const bf16* kr = KPE + mk * 32; float sc = 0.f;
#pragma unroll
                for (int i = 0; i < 64; ++i) sc += q[i] * bf1(kn[i]);
#pragma unroll
                for (int i = 0; i < 32; ++i) sc += q[64 + i] * bf1(kr[i]);
                sc *= 0.10206207261596577f; const float mn = fmaxf(mx, sc), a = expf(mx - mn), p = expf(sc - mn); mx = mn; lsum = lsum * a + p; o = o * a + p * bf1(kn[64 + d]); }
            const float ref = o / lsum; bad = nclose(bf1(OCAT[(size_t)m * 1024 + 256 + h * 64 + d]), ref, 0.002f + 0.02f * fabsf(ref)); }
    } else if constexpr (ST == 7) {
        if (blockIdx.x < 16) { const int hq = h2 & 7, kvh = hq >> 2, d = (h2 >> 3) & 63; const bf16* qp = QC + (size_t)m * 512 + hq * 64; float q[64];
#pragma unroll
            for (int i = 0; i < 64; ++i) q[i] = bf1(qp[i]);
            float mx = -1e30f, lsum = 0.f, o = 0.f;
            for (int kk = 0; kk < SEQ; ++kk) { const size_t mk = (size_t)b * SEQ + kk; const bf16* kn = KC + mk * 128 + kvh * 64; float sc = 0.f;
#pragma unroll
                for (int i = 0; i < 64; ++i) sc += q[i] * bf1(kn[i]);
                sc *= 0.125f; const float mn = fmaxf(mx, sc), a = expf(mx - mn), p = expf(sc - mn); mx = mn; lsum = lsum * a + p; o = o * a + p * bf1(P1[mk * N1 + C_VC + kvh * 64 + d]); }
            const float ref = o / lsum; bad = nclose(bf1(OCAT[(size_t)m * 1024 + 512 + hq * 64 + d]), ref, 0.002f + 0.02f * fabsf(ref)); }
    } else if constexpr (ST == 8) {
        const int h = h2 & 3, d = (h2 >> 2) & 63, r = t / GRID_W, qc = t % GRID_W; const int rs = min(max(r - 4, 0), NROWS - 8), wst = min(max(qc - 8, 0), GRID_W - 16);
        const bf16* qp = P1 + (size_t)m * N1 + C_QA + h * 64; const float* rpb = args.in[7] + (size_t)l * 4 * 15 * 31; float mx = -1e30f, lsum = 0.f, o = 0.f;
        for (int i = 0; i < 8; ++i)
            for (int j = 0; j < 16; ++j) { const size_t tk = (size_t)b * SEQ + (size_t)(rs + i) * GRID_W + wst + j; const bf16* kp = P1 + tk * N1 + C_KA + h * 64; float s_ = 0.f;
                for (int k = 0; k < 64; ++k) s_ += bf1(qp[k]) * bf1(kp[k]);
                s_ = s_ * 0.125f + rpb[((size_t)h * 15 + (rs + i - r + 7)) * 31 + (wst + j - qc + 15)];
                const float mn = fmaxf(mx, s_), a = expf(mx - mn), p = expf(s_ - mn); mx = mn; lsum = lsum * a + p; o = o * a + p * bf1(P1[tk * N1 + C_VA + h * 64 + d]); }
        const float ref = o / lsum; bad = nclose(bf1(OCAT[(size_t)m * 1024 + h * 64 + d]), ref, 0.003f + 0.02f * fabsf(ref));
    } else if constexpr (ST == 10) {
        const int c = h2 % DM; float ref = 0.f;
        for (int br = 0; br < 3; ++br) { const int kk = br == 2 ? 512 : 256, off = br * 256; const float* W = args.in[14 + br] + (size_t)l * kk * DM + c; float y = 0.f;
            for (int k = 0; k < kk; ++k) y += bf1(OCAT[(size_t)m * 1024 + off + k]) * W[(size_t)k * DM];
            ref += bf1(GATES[(size_t)m * NG + br * 1024 + c]) * y; }
        bad = nclose(bf1(Hb[(size_t)m * DM + c]), ref, 0.002f + 0.03f * fabsf(ref));
        if (bad) atomicAdd(flags + 2, 1u); if (nclose(bf1(Hb[(size_t)m * DM + c]), ref, 0.01f + 0.15f * fabsf(ref))) atomicAdd(flags + 3, 1u);
        if (gtid < 32 * DM) saved[gtid] = xcur[(size_t)save_row(gtid / DM) * DM + (gtid % DM)];
    } else if constexpr (ST == 11 || ST == 14) {
        if (gtid < 32 * DM) { const int s = gtid / DM, c = gtid % DM, mm = save_row(s), bb = mm / SEQ; float acc = 0.f, s2 = 0.f;
            if (ST == 11) { const float* W = args.in[17] + (size_t)l * DM * DM + c; for (int k = 0; k < DM; ++k) { const float p = bf1(Hb[(size_t)mm * DM + k]) * W[(size_t)k * DM]; acc += p; s2 += p * p; } }
            else { const float* W = args.in[19] + (size_t)l * FFN * DM + c; for (int k = 0; k < FFN; ++k) { const float p = bf1(ACT[(size_t)mm * FFN + k]) * W[(size_t)k * DM]; acc += p; s2 += p * p; } }
            const float g = mod[(size_t)bb * NMOD * DM + (ST == 11 ? 2 : 5) * DM + c]; const float ref = saved[gtid] + g * acc;
            bad = nclose(xres[(size_t)mm * DM + c], ref, 1e-3f + fabsf(g) * 0.02f * sqrtf(s2) + 1e-3f * fabsf(ref)); }
    } else if constexpr (ST == 13) {
        const int j = h2 % FFN; const float* W = args.in[18] + (size_t)l * DM * 2 * FFN; float gt = 0.f, up = 0.f, s2 = 0.f;
        for (int k = 0; k < DM; ++k) { const float hv = bf1(Hb[(size_t)m * DM + k]); const float p1 = hv * W[(size_t)k * 2 * FFN + j], p2 = hv * W[(size_t)k * 2 * FFN + FFN + j]; gt += p1; up += p2; s2 += p1 * p1 + p2 * p2; }
        const float ref = gt / (1.0f + expf(-gt)) * up; bad = nclose(bf1(ACT[(size_t)m * FFN + j]), ref, 0.03f * sqrtf(s2) * (1.0f + fabsf(gt) + fabsf(up)) + 0.02f * fabsf(ref) + 2e-3f);
        if (gtid < 32 * DM) saved[gtid] = xres[(size_t)save_row(gtid / DM) * DM + (gtid % DM)];
    }
    if (bad) atomicOr(flags, 1u << (ST + 16 * l));
}
#ifndef CHKMASK
#define CHKMASK 0xffff
#endif
#define CHK(ST) do { if constexpr (((CHKMASK >> (ST)) & 1) != 0) if (ph <= hi && ph > lo) { selfcheck<ST>(args, l_chk, (unsigned*)(ctl + CW_FLAGS)); xcd_barrier(bar); } } while (0)
#else
#define CHK(ST) do { } while (0)
#endif

__global__ void __launch_bounds__(NWAVES * 64, 2) hybrid_fwd(Args args) {
    extern __shared__ __attribute__((aligned(16))) unsigned char lds[];
    LAS unsigned char* ldsl = (LAS unsigned char*)lds;
    volatile LAS unsigned* MISC = (volatile LAS unsigned*)(ldsl + MISC_OFF);
    const int tid = threadIdx.x, lane = tid & 63, wave = __builtin_amdgcn_readfirstlane(tid >> 6);
    const int G = gridDim.x; const int bx = blockIdx.x; const int vcu = (G % 8 == 0) ? (bx % 8) * (G / 8) + bx / 8 : bx;
    if (G != 256) return;
    unsigned char* ws = args.ws;
    gu32* ctl = (gu32*)(ws + WS_CTL);
    for (int u = tid; u < (LDS_BYTES - LDSCTL_OFF) / 4; u += NWAVES * 64) ((LAS unsigned*)(ldsl + LDSCTL_OFF))[u] = 0u;
    __syncthreads();
    XcdBarrier bar = xcd_barrier_post((unsigned*)(ctl + CW_BAR), MISC + 8);
    const int gw0 = vcu * NWAVES + wave;
    const int lo = args.ph_lo, hi = args.ph_hi; int ph = 0;
#ifndef PROBE_MASK
#define PROBE_MASK 0
#endif
#define PHASE_BEGIN(ID) if (lo <= ph && ph < hi) { for (int rep_ = 0; rep_ < 1 + (int)(((PROBE_MASK >> (ID)) & 1) && !((ID) == 8 && ph > 11)); ++rep_) { if (rep_) xcd_barrier(bar);
#define PHASE_END() } if (SELFCHECK || ph + 1 < hi) xcd_barrier(bar); } ++ph;

    float* modp = (float*)(ws + WS_MOD); float* tabt = (float*)(ws + WS_TABT); float* taba = (float*)(ws + WS_TABA);
    bf16* Hb = (bf16*)(ws + WS_H); bf16* P1 = (bf16*)(ws + WS_P1); bf16* KPE = (bf16*)(ws + WS_KPE); bf16* QC = (bf16*)(ws + WS_QC); bf16* KC = (bf16*)(ws + WS_KC);
    bf16* P2 = (bf16*)(ws + WS_P2); bf16* OCAT = (bf16*)(ws + WS_OCAT); bf16* A2 = (bf16*)(ws + WS_A2); bf16* GATES = (bf16*)(ws + WS_GATES); bf16* ACT = (bf16*)(ws + WS_ACT);
    const float* x_in = args.in[0]; float* xres = args.out;
    float* rowss_a = (float*)(ws + WS_ROWSS_A); float* rowss_b = (float*)(ws + WS_ROWSS_B); float* biasp = (float*)(ws + WS_BIAS); bf16* XG2 = (bf16*)(ws + WS_XG2);

    PHASE_BEGIN(0)
    { const int tid = opaque_v(threadIdx.x), lane = tid & 63, bx = opaque_s((int)blockIdx.x), G = opaque_s((int)gridDim.x), gw = opaque_s(gw0), NGW = G * NWAVES; (void)lane; (void)bx; (void)G; (void)gw; (void)NGW;
        LAS float* sc = (LAS float*)(ldsl + RING_OFF);
        const float* cin = args.in[1];
        for (int i = tid; i < BATCH * DM; i += NWAVES * 64) { const int b = i / DM, k = i % DM; const float v = cin[i]; sc[k * 8 + b] = v / (1.0f + __expf(-v)); }
        __syncthreads();
        if (wave == 0 && bx < 192) {
            const int l = bx / 96, cg = bx % 96; const float* W = args.in[2] + (size_t)l * DM * (NMOD * DM) + cg * 64 + lane;
            float acc[8];
#pragma unroll
            for (int b = 0; b < 8; ++b) acc[b] = 0.f;
#pragma unroll 8
            for (int k = 0; k < DM; ++k) { const float w = W[(size_t)k * (NMOD * DM)]; const f32x4 s0 = *(const LAS f32x4*)(sc + k * 8), s1 = *(const LAS f32x4*)(sc + k * 8 + 4);
                acc[0] += s0[0] * w; acc[1] += s0[1] * w; acc[2] += s0[2] * w; acc[3] += s0[3] * w; acc[4] += s1[0] * w; acc[5] += s1[1] * w; acc[6] += s1[2] * w; acc[7] += s1[3] * w; }
            const float bias = args.in[3][(size_t)l * NMOD * DM + cg * 64 + lane];
#pragma unroll
            for (int b = 0; b < 8; ++b) modp[((size_t)l * BATCH + b) * (NMOD * DM) + cg * 64 + lane] = acc[b] + bias;
        }
        for (int i = bx * NWAVES * 64 + tid; i < (SEQ + 64) * 16; i += G * NWAVES * 64) {
            const int p = i >> 4, fi = i & 15; const int pos = p < SEQ ? p : p - SEQ; float* dst = p < SEQ ? tabt + (size_t)p * 32 : taba + (size_t)(p - SEQ) * 32;
            const float ang = (float)pos * inv_freq(fi); double s, c; sincos_d((double)ang, s, c); dst[fi] = (float)c; dst[16 + fi] = (float)s;
        }
        LAS float* scr = (LAS float*)(ldsl + RING_OFF + 32768 + wave * 8704);
        for (int l = 0; l < DEPTH; ++l) {
            const LayerW w = layer_w(ws, l);
            constexpr int I_IN = 16 * 157, I_UQ = 4 * 12, I_UKV = 2 * 16, I_BNA = 4 * 32, I_BMLA = 4 * 32, I_BGQA = 8 * 32, I_OUT = 16 * 32, I_GU = 16 * 176, I_DN = 44 * 32;
            constexpr int NITEMS = I_IN + I_UQ + I_UKV + I_BNA + I_BMLA + I_BGQA + I_OUT + I_GU + I_DN;
            for (int it = gw; it < NITEMS; it += NGW) {
                int r = it;
                if (r < I_IN)  { transpose_item(args.in[6] + (size_t)l * DM * IN_COLS, IN_COLS, 64 * (r / 157), 32 * (r % 157), RpWin{w.w1, w.wg}, scr, lane); continue; } r -= I_IN;
                if (r < I_UQ)  { transpose_item(args.in[10] + (size_t)l * 256 * 384, 384, 64 * (r / 12), 32 * (r % 12), RpPlain{w.w2, 384, 0, 0}, scr, lane); continue; } r -= I_UQ;
                if (r < I_UKV) { transpose_item(args.in[11] + (size_t)l * 128 * 512, 512, 64 * (r / 16), 32 * (r % 16), RpPlain{w.w2, 384, 384, 256}, scr, lane); continue; } r -= I_UKV;
                if (r < I_BNA) { transpose_item(args.in[14] + (size_t)l * 256 * 1024, 1024, 64 * (r / 32), 32 * (r % 32), RpPlain{w.bna, 256, 0, 0}, scr, lane); continue; } r -= I_BNA;
                if (r < I_BMLA){ transpose_item(args.in[15] + (size_t)l * 256 * 1024, 1024, 64 * (r / 32), 32 * (r % 32), RpPlain{w.bmla, 256, 0, 0}, scr, lane); continue; } r -= I_BMLA;
                if (r < I_BGQA){ transpose_item(args.in[16] + (size_t)l * 512 * 1024, 1024, 64 * (r / 32), 32 * (r % 32), RpPlain{w.bgqa, 512, 0, 0}, scr, lane); continue; } r -= I_BGQA;
                if (r < I_OUT) { transpose_item(args.in[17] + (size_t)l * 1024 * 1024, 1024, 64 * (r / 32), 32 * (r % 32), RpPlain{w.wout, 1024, 0, 0}, scr, lane); continue; } r -= I_OUT;
                if (r < I_GU)  { transpose_item(args.in[18] + (size_t)l * DM * 2 * FFN, 2 * FFN, 64 * (r / 176), 32 * (r % 176), RpGU{w.wgu}, scr, lane); continue; } r -= I_GU;
                transpose_item(args.in[19] + (size_t)l * FFN * DM, DM, 64 * (r / 32), 32 * (r % 32), RpPlain{w.wdn, FFN, 0, 0}, scr, lane);
            }
            const v4u z = {0u, 0u, 0u, 0u};
            for (int i = bx * NWAVES * 64 + tid; i < 96 * 128; i += G * NWAVES * 64) *(GAS v4u*)(w.w1 + (size_t)N1_USED * DM + (size_t)i * 8) = z;
            for (int i = bx * NWAVES * 64 + tid; i < 1024 * 48; i += G * NWAVES * 64) { const int row = i / 48, ch = i % 48, col = ch * 8;
                const bool zero = row < 384 ? (col >= 256) : row < 896 ? (col < 256) : true;
                if (zero) *(GAS v4u*)(w.w2 + (size_t)row * 384 + col) = z; }
        }
    }
    PHASE_END()
    { const int l_chk = 0; (void)l_chk; CHK(0); CHK(1); }

    PHASE_BEGIN(1)
    { const int tid = opaque_v(threadIdx.x), lane = tid & 63, bx = opaque_s((int)blockIdx.x), G = opaque_s((int)gridDim.x), gw = opaque_s(gw0), NGW = G * NWAVES; (void)lane; (void)bx; (void)G; (void)gw; (void)NGW;
        constexpr int ROWS_PER_LAYER = NB1 + NBG + NBGU, TASKS_PER_LAYER = ROWS_PER_LAYER / 16;
        for (int tk = gw; tk < DEPTH * TASKS_PER_LAYER; tk += NGW) {
            const int l = tk / TASKS_PER_LAYER, r0 = (tk % TASKS_PER_LAYER) * 16, n = lane & 15, q = lane >> 4; const LayerW w = layer_w(ws, l);
            const bf16* wrow; float* bout; int which, nb;
            if (r0 < NB1) { wrow = w.w1 + (size_t)(r0 + n) * DM; bout = biasp + (size_t)l * BIAS_PER_LAYER + r0 + n; which = 0; nb = NB1; }
            else if (r0 < NB1 + NBG) { wrow = w.wg + (size_t)(r0 - NB1 + n) * DM; bout = biasp + (size_t)l * BIAS_PER_LAYER + 8 * NB1 + (r0 - NB1) + n; which = 0; nb = NBG; }
            else { wrow = w.wgu + (size_t)(r0 - NB1 - NBG + n) * DM; bout = biasp + (size_t)l * BIAS_PER_LAYER + 8 * (NB1 + NBG) + (r0 - NB1 - NBG) + n; which = 3; nb = NBGU; }
            const float* sp = modp + ((size_t)l * BATCH + (n & 7)) * NMOD * DM + which * DM + 8 * q; wrow += 8 * q;
            f32x4 acc = {0.f, 0.f, 0.f, 0.f};
#pragma unroll 8
            for (int k = 0; k < DM; k += 32) { const bf16x8 bfrag = *(const bf16x8*)(wrow + k); const f32x4 s0 = *(const f32x4*)(sp + k), s1 = *(const f32x4*)(sp + k + 4);
                v4u aw; aw.x = pk2(s0[0], s0[1]); aw.y = pk2(s0[2], s0[3]); aw.z = pk2(s1[0], s1[1]); aw.w = pk2(s1[2], s1[3]); if (n >= 8) aw = (v4u){0u, 0u, 0u, 0u};
                acc = __builtin_amdgcn_mfma_f32_16x16x32_bf16(__builtin_bit_cast(bf16x8, aw), bfrag, acc, 0, 0, 0); }
            if (q < 2) {
#pragma unroll
                for (int e = 0; e < 4; ++e) bout[(size_t)(4 * q + e) * nb] = acc[e]; }
        }
        {
            const float* g = args.in[4]; const float* mod0 = modp;
            for (int m = gw; m < M; m += NGW) {
                const int b = m / SEQ; const float* xr = x_in + (size_t)m * DM; const float* scl = mod0 + (size_t)b * NMOD * DM + DM;
                f32x4 v[4]; float sq = 0.f;
#pragma unroll
                for (int j = 0; j < 4; ++j) { v[j] = *(const f32x4*)(xr + 256 * j + 4 * lane); sq += (v[j][0] * v[j][0] + v[j][1] * v[j][1]) + (v[j][2] * v[j][2] + v[j][3] * v[j][3]); }
                sq = wave_sum(sq); if (lane == 0) *(f32x4*)(rowss_a + 4 * (size_t)m) = (f32x4){sq, 0.f, 0.f, 0.f};
#pragma unroll
                for (int j = 0; j < 4; ++j) { const int c = 256 * j + 4 * lane; const f32x4 gg = *(const f32x4*)(g + c), s1 = *(const f32x4*)(scl + c);
                    v2u o; o.x = pk2(v[j][0] * gg[0] * (1.0f + s1[0]), v[j][1] * gg[1] * (1.0f + s1[1])); o.y = pk2(v[j][2] * gg[2] * (1.0f + s1[2]), v[j][3] * gg[3] * (1.0f + s1[3])); *(v2u*)(Hb + (size_t)m * DM + c) = o; }
            }
        }
    }
    PHASE_END()

    for (int l = 0; l < DEPTH; ++l) {
        const LayerW w = layer_w(ws, l);
        const float* mod = modp + (size_t)l * BATCH * NMOD * DM;
        const float* xcur = (l == 0) ? x_in : xres;
        const int l_chk = l; (void)l_chk;

        PHASE_BEGIN(2)
        { const int tid = opaque_v(threadIdx.x), lane = tid & 63, bx = opaque_s((int)blockIdx.x), G = opaque_s((int)gridDim.x), gw = opaque_s(gw0), NGW = G * NWAVES; (void)lane; (void)bx; (void)G; (void)gw; (void)NGW;
            pg8::Gemm g{Hb, w.w1, M, N1, DM, DM, DM}; pg8::StaticOrder S; S.init(M, N1, G, bx);
            pg8::EpiBf16N<0> E{P1, N1, rowss_a, biasp + (size_t)l * BIAS_PER_LAYER, NB1, SEQ};
            pg8::gemm_phase<pg8::EpiBf16N<0>, pg8::StaticOrder, true, true>(ldsl + RING_OFF, g, S, E);
        }
        PHASE_END()
        CHK(3);

        PHASE_BEGIN(3)
        { const int tid = opaque_v(threadIdx.x), lane = tid & 63, bx = opaque_s((int)blockIdx.x), G = opaque_s((int)gridDim.x), gw = opaque_s(gw0), NGW = G * NWAVES; (void)lane; (void)bx; (void)G; (void)gw; (void)NGW;
            const float* gq = args.in[8] + (size_t)l * 256; const float* gkv = args.in[9] + (size_t)l * 128;
            const float* gqc = args.in[12] + (size_t)l * 64; const float* gkc = args.in[13] + (size_t)l * 64;
            for (int m = gw; m < M; m += NGW) {
                const int t = m % SEQ, prow = t / GRID_W, pcol = t % GRID_W; const bf16* pr = P1 + (size_t)m * N1;
                {
                    const v2u raw = *(const v2u*)(pr + C_CQ + 4 * lane); float v[4] = {bflo(raw.x), bfhi(raw.x), bflo(raw.y), bfhi(raw.y)};
                    const float rstd = 1.0f / sqrtf(wave_sum(v[0] * v[0] + v[1] * v[1] + v[2] * v[2] + v[3] * v[3]) * (1.0f / 256) + NORM_EPS);
                    const f32x4 gg = *(const f32x4*)(gq + 4 * lane); v2u o; o.x = pk2(v[0] * rstd * gg[0], v[1] * rstd * gg[1]); o.y = pk2(v[2] * rstd * gg[2], v[3] * rstd * gg[3]);
                    *(v2u*)(A2 + (size_t)m * 384 + 4 * lane) = o; }
                {
                    const unsigned raw = *(const unsigned*)(pr + C_CKV + 2 * lane); const float v0 = bflo(raw), v1 = bfhi(raw);
                    const float rstd = 1.0f / sqrtf(wave_sum(v0 * v0 + v1 * v1) * (1.0f / 128) + NORM_EPS);
                    *(unsigned*)(A2 + (size_t)m * 384 + 256 + 2 * lane) = pk2(v0 * rstd * gkv[2 * lane], v1 * rstd * gkv[2 * lane + 1]); }
                if (lane < 16) {
                    const float x1 = bf1(pr[C_KR + lane]), x2 = bf1(pr[C_KR + 16 + lane]); const float c = tabt[(size_t)t * 32 + lane], s = tabt[(size_t)t * 32 + 16 + lane];
                    KPE[(size_t)m * 32 + lane] = (bf16)f2bf(x1 * c - x2 * s); KPE[(size_t)m * 32 + 16 + lane] = (bf16)f2bf(x2 * c + x1 * s); }
#pragma unroll
                for (int pass = 0; pass < 2; ++pass) {
                    const bool act = pass == 0 || lane < 16;
                    const bf16* src = pr + (pass == 0 ? C_QC : C_KC) + 8 * (act ? lane : 0);
                    const v4u raw = *(const v4u*)src; float v[8] = {bflo(raw.x), bfhi(raw.x), bflo(raw.y), bfhi(raw.y), bflo(raw.z), bfhi(raw.z), bflo(raw.w), bfhi(raw.w)};
                    float ss = 0.f;
#pragma unroll
                    for (int e = 0; e < 8; ++e) ss += v[e] * v[e];
                    ss += __shfl_xor(ss, 1); ss += __shfl_xor(ss, 2); ss += __shfl_xor(ss, 4);
                    const float rstd = 1.0f / sqrtf(ss * (1.0f / 64) + NORM_EPS);
                    const int sidx = lane & 7; const float* gn = (pass == 0 ? gqc : gkc) + 8 * sidx;
                    float y[8], pv[8];
#pragma unroll
                    for (int e = 0; e < 8; ++e) y[e] = v[e] * rstd * gn[e];
#pragma unroll
                    for (int e = 0; e < 8; ++e) pv[e] = __shfl_xor(y[e], 2);
                    const int pos = (sidx < 4) ? prow : pcol; const float* tb = taba + (size_t)pos * 32 + (sidx & 1) * 8; const bool second = (sidx & 2) != 0;
                    float o[8];
#pragma unroll
                    for (int e = 0; e < 8; ++e) { const float c = tb[e], s = tb[16 + e]; o[e] = second ? (y[e] * c + pv[e] * s) : (y[e] * c - pv[e] * s); }
                    v4u ov; ov.x = pk2(o[0], o[1]); ov.y = pk2(o[2], o[3]); ov.z = pk2(o[4], o[5]); ov.w = pk2(o[6], o[7]);
                    if (act) { if (pass == 0) *(v4u*)(QC + (size_t)m * 512 + 8 * lane) = ov; else *(v4u*)(KC + (size_t)m * 128 + 8 * lane) = ov; }
                }
            }
        }
        PHASE_END()
        CHK(4);

        PHASE_BEGIN(4)
        { const int tid = opaque_v(threadIdx.x), lane = tid & 63, bx = opaque_s((int)blockIdx.x), G = opaque_s((int)gridDim.x), gw = opaque_s(gw0), NGW = G * NWAVES; (void)lane; (void)bx; (void)G; (void)gw; (void)NGW;
            pg8::Gemm g{A2, w.w2, M, 1024, 384, 384, 384}; pg8::StaticOrder S; S.init(M, 1024, G, bx);
            pg8::EpiBf16<0> E{P2, 1024};
            pg8::gemm_phase<pg8::EpiBf16<0>, pg8::StaticOrder, true, true>(ldsl + RING_OFF, g, S, E);
        }
        PHASE_END()
        CHK(5);

        PHASE_BEGIN(5)
        { const int tid = opaque_v(threadIdx.x), lane = tid & 63, bx = opaque_s((int)blockIdx.x), G = opaque_s((int)gridDim.x), gw = opaque_s(gw0), NGW = G * NWAVES; (void)lane; (void)bx; (void)G; (void)gw; (void)NGW;
            char* alds = (char*)lds + RING_OFF;
            {
                const int x8 = bx & 7, j32 = bx >> 3;
                {
                    const int grp = x8 * 4 + (j32 >> 3), qb = j32 & 7, b = grp >> 2, h = grp & 3; const size_t row0 = (size_t)b * SEQ;
                    att::attn_unit<32>(P2 + (row0 + qb * 256) * 1024 + h * 96, 1024, P2 + row0 * 1024 + 384 + h * 128, 1024, KPE + row0 * 32, 32,
                                       P2 + row0 * 1024 + 384 + h * 128 + 64, 1024, OCAT + (row0 + qb * 256) * 1024 + 256 + h * 64, 1024, SEQ, tabt + (size_t)(qb * 256) * 32, alds);
                }
                for (int i = 0; i < 2; ++i) {
                    const int grp = i * 8 + x8, b = grp >> 1, kvh = grp & 1, hq = kvh * 4 + (j32 >> 3), qb = j32 & 7; const size_t row0 = (size_t)b * SEQ;
                    att::attn_unit<0>(QC + (row0 + qb * 256) * 512 + hq * 64, 512, KC + row0 * 128 + kvh * 64, 128, nullptr, 0,
                                      P1 + row0 * N1 + C_VC + kvh * 64, N1, OCAT + (row0 + qb * 256) * 1024 + 512 + hq * 64, 1024, SEQ, nullptr, alds);
                }
            }
            {
                const int x8 = bx & 7, j32 = bx >> 3; const int grp = x8 * 4 + (j32 >> 3), i = j32 & 7, b = grp >> 2, h = grp & 3; const size_t row0 = (size_t)b * SEQ;
                const int r0 = 4 * i, kst = min(max(r0 - 4, 0), 24), nt = (i == 0 || i == 7) ? 8 : 12;
                const bf16* base = P1 + (row0 + (size_t)kst * GRID_W) * N1;
                att::attn_unit<0, true>(P1 + (row0 + (size_t)r0 * GRID_W) * N1 + C_QA + h * 64, N1, base + C_KA + h * 64, N1, nullptr, 0, base + C_VA + h * 64, N1,
                                        OCAT + (row0 + (size_t)r0 * GRID_W) * 1024 + h * 64, 1024, nt * 64, nullptr, alds, args.in[7] + ((size_t)l * 4 + h) * 15 * 31, r0, kst);
            }
        }
        PHASE_END()
        CHK(6); CHK(7); CHK(8);

        PHASE_BEGIN(6)
        { const int tid = opaque_v(threadIdx.x), lane = tid & 63, bx = opaque_s((int)blockIdx.x), G = opaque_s((int)gridDim.x), gw = opaque_s(gw0), NGW = G * NWAVES; (void)lane; (void)bx; (void)G; (void)gw; (void)NGW;
            pg8::Gemm g{Hb, w.wg, M, NG, DM, DM, DM}; pg8::StaticOrder S; S.init(M, NG, G, bx);
            pg8::EpiBf16N<1> E{GATES, NG, rowss_a, biasp + (size_t)l * BIAS_PER_LAYER + 8 * NB1, NBG, SEQ};
            pg8::gemm_phase<pg8::EpiBf16N<1>, pg8::StaticOrder, true, true>(ldsl + RING_OFF, g, S, E);
        }
        PHASE_END()
        CHK(9);

        PHASE_BEGIN(7)
        { const int tid = opaque_v(threadIdx.x), lane = tid & 63, bx = opaque_s((int)blockIdx.x), G = opaque_s((int)gridDim.x), gw = opaque_s(gw0), NGW = G * NWAVES; (void)lane; (void)bx; (void)G; (void)gw; (void)NGW;
            pg8::StaticOrder S; S.init(M, DM, G, bx);
            { pg8::Gemm g{OCAT, w.bna, M, DM, 256, 1024, 256}; pg8::EpiGateAcc E{Hb, DM, GATES, NG, 0, 1};
              pg8::gemm_phase<pg8::EpiGateAcc, pg8::StaticOrder, true, true>(ldsl + RING_OFF, g, S, E); }
            { pg8::Gemm g{OCAT + 256, w.bmla, M, DM, 256, 1024, 256}; pg8::EpiGateAcc E{Hb, DM, GATES, NG, 1024, 0};
              pg8::gemm_phase<pg8::EpiGateAcc, pg8::StaticOrder, true, true>(ldsl + RING_OFF, g, S, E); }
            { pg8::Gemm g{OCAT + 512, w.bgqa, M, DM, 512, 1024, 512}; pg8::EpiGateAcc E{Hb, DM, GATES, NG, 2048, 0};
              pg8::gemm_phase<pg8::EpiGateAcc, pg8::StaticOrder, true, true>(ldsl + RING_OFF, g, S, E); }
        }
        PHASE_END()
        CHK(10);

        PHASE_BEGIN(8)
        { const int tid = opaque_v(threadIdx.x), lane = tid & 63, bx = opaque_s((int)blockIdx.x), G = opaque_s((int)gridDim.x), gw = opaque_s(gw0), NGW = G * NWAVES; (void)lane; (void)bx; (void)G; (void)gw; (void)NGW;
            pg8::Gemm g{Hb, w.wout, M, DM, DM, DM, DM}; pg8::StaticOrder S; S.init(M, DM, G, bx);
            pg8::EpiResidualN E{xcur, xres, DM, mod + 2 * DM, NMOD * DM, SEQ, XG2, args.in[5] + (size_t)l * DM, mod + 4 * DM, rowss_b, (LAS float*)(ldsl + EPIX_OFF)};
            pg8::gemm_phase<pg8::EpiResidualN, pg8::StaticOrder, true, true>(ldsl + RING_OFF, g, S, E);
        }
        PHASE_END()
        CHK(11);

        PHASE_BEGIN(10)
        { const int tid = opaque_v(threadIdx.x), lane = tid & 63, bx = opaque_s((int)blockIdx.x), G = opaque_s((int)gridDim.x), gw = opaque_s(gw0), NGW = G * NWAVES; (void)lane; (void)bx; (void)G; (void)gw; (void)NGW;
            pg8::Gemm g{XG2, w.wgu, M, 2 * FFN, DM, DM, DM}; pg8::StaticOrder S; S.init(M, 2 * FFN, G, bx);
            pg8::EpiSwiGLUN E{ACT, FFN, rowss_b, biasp + (size_t)l * BIAS_PER_LAYER + 8 * (NB1 + NBG), NBGU, SEQ};
            pg8::gemm_phase<pg8::EpiSwiGLUN, pg8::StaticOrder, true, true>(ldsl + RING_OFF, g, S, E);
        }
        PHASE_END()
        CHK(13);

        PHASE_BEGIN(11)
        { const int tid = opaque_v(threadIdx.x), lane = tid & 63, bx = opaque_s((int)blockIdx.x), G = opaque_s((int)gridDim.x), gw = opaque_s(gw0), NGW = G * NWAVES; (void)lane; (void)bx; (void)G; (void)gw; (void)NGW;
            pg8::Gemm g{ACT, w.wdn, M, DM, FFN, FFN, FFN}; pg8::StaticOrder S; S.init(M, DM, G, bx);
            const bool more = (l + 1 < DEPTH); const float* modn = modp + (size_t)(more ? l + 1 : l) * BATCH * NMOD * DM;
            pg8::EpiResidualN E{xres, xres, DM, mod + 5 * DM, NMOD * DM, SEQ, more ? Hb : (bf16*)nullptr, args.in[4] + (size_t)(more ? l + 1 : l) * DM, modn + DM, rowss_a, (LAS float*)(ldsl + EPIX_OFF)};
            pg8::gemm_phase<pg8::EpiResidualN, pg8::StaticOrder, true, true>(ldsl + RING_OFF, g, S, E);
        }
        PHASE_END()
        CHK(14);
    }

    PHASE_BEGIN(12)
    { const int tid = opaque_v(threadIdx.x), lane = tid & 63, bx = opaque_s((int)blockIdx.x), G = opaque_s((int)gridDim.x), gw = opaque_s(gw0), NGW = G * NWAVES; (void)lane; (void)bx; (void)G; (void)gw; (void)NGW;
        const float* g = args.in[20];
        for (int m = gw; m < M; m += NGW) {
            float* xr = xres + (size_t)m * DM;
            f32x4 v[4]; float s = 0.f;
#pragma unroll
            for (int j = 0; j < 4; ++j) { v[j] = *(const f32x4*)(xr + 256 * j + 4 * lane); s += (v[j][0] * v[j][0] + v[j][1] * v[j][1]) + (v[j][2] * v[j][2] + v[j][3] * v[j][3]); }
            const float rstd = 1.0f / sqrtf(wave_sum(s) * (1.0f / DM) + NORM_EPS);
#pragma unroll
            for (int j = 0; j < 4; ++j) { const int c = 256 * j + 4 * lane; const f32x4 gg = *(const f32x4*)(g + c); f32x4 y;
#pragma unroll
                for (int e = 0; e < 4; ++e) y[e] = v[j][e] * rstd * gg[e];
                *(f32x4*)(xr + c) = y; }
        }
    }
    PHASE_END()
#if SELFCHECK
        xcd_barrier(bar);
        if (blockIdx.x == 0 && threadIdx.x == 0) { const unsigned fl = __hip_atomic_load((unsigned*)(ctl + CW_FLAGS), RLX_AGENT); unsigned c[12]; for (int i = 0; i < 12; ++i) c[i] = __hip_atomic_load((unsigned*)(ctl + CW_FLAGS + 2 + i), RLX_AGENT);
        unsigned tot = c[0] + c[1] + c[2] + c[3], bad_ = c[6] + c[7] + c[8] + c[9]; int d1 = (c[6] ? 1 : 0) | (c[7] ? 2 : 0) | (c[8] ? 4 : 0) | (c[9] ? 8 : 0); int d2 = tot ? (int)(9.99f * (float)bad_ / (float)tot) : 0;
        { int k1 = 0, k2 = 0; while ((c[0] >> k1) != 0) ++k1; while ((c[1] >> k2) != 0) ++k2; d1 = k1 / 2; d2 = k2 / 2; if (d1 > 9) d1 = 9; if (d2 > 9) d2 = 9; args.out[0] = 100.0f * (float)(10 * d1 + d2 + 1); return; }
        args.out[0] = 100.0f * (float)((((fl >> 15) & 1u) * 2u + ((fl >> 10) & 1u)) + 1u); }
#endif
#undef PHASE_BEGIN
#undef PHASE_END
}

constexpr int N_PHASES = 2 + DEPTH * 9 + 1;
#ifndef MK_PER_PHASE
#define MK_PER_PHASE 0
#endif

extern "C" void kernel_launch(void* const* d_in, const int* in_sizes, int n_in, void* d_out, int out_size, void* d_ws, size_t ws_size, hipStream_t stream) {
    static int grid = 0;
    if (grid == 0) {
        if (n_in != 21 || in_sizes[0] != M * DM || out_size != M * DM || ws_size < WS_END) { fprintf(stderr, "kernel_launch: unexpected shapes (n_in %d in0 %d out %d ws %zu)\n", n_in, n_in > 0 ? in_sizes[0] : -1, out_size, ws_size); grid = -1; return; }
        int dev = 0, cus = 0;
        if (hipGetDevice(&dev) != hipSuccess || hipDeviceGetAttribute(&cus, hipDeviceAttributeMultiprocessorCount, dev) != hipSuccess) { grid = -1; return; }
        if (hipFuncSetAttribute((const void*)hybrid_fwd, hipFuncAttributeMaxDynamicSharedMemorySize, LDS_BYTES) != hipSuccess) { fprintf(stderr, "kernel_launch: hipFuncSetAttribute failed\n"); grid = -1; return; }
        (void)hipGetLastError();
        grid = cus;
    }
    if (grid < 0) return;
    (void)hipMemsetAsync((char*)d_ws + WS_CTL, 0, CTL_ZERO_BYTES, stream);
    Args a{};
    for (int i = 0; i < 21; ++i) a.in[i] = (const float*)d_in[i];
    a.out = (float*)d_out; a.ws = (unsigned char*)d_ws;
#if MK_PER_PHASE
    for (int p = 0; p < N_PHASES; ++p) { a.ph_lo = p; a.ph_hi = p + 1; hipLaunchKernelGGL(hybrid_fwd, dim3(grid), dim3(NWAVES * 64), LDS_BYTES, stream, a); }
#else
#if SELFCHECK
    a.ph_lo = 0; a.ph_hi = 12;
#else
    a.ph_lo = 0; a.ph_hi = N_PHASES;
#endif
    hipLaunchKernelGGL(hybrid_fwd, dim3(grid), dim3(NWAVES * 64), LDS_BYTES, stream, a);
#endif
    const hipError_t le = hipPeekAtLastError();
    if (le != hipSuccess) fprintf(stderr, "kernel_launch: launch failed: %s\n", hipGetErrorName(le));
}
```

```cpp
#define SELFCHECK 0
#include <hip/hip_runtime.h>
#include <hip/hip_bf16.h>
#include <cstdio>
#include <cstdint>

__device__ __forceinline__ int opaque_v(int v) { asm volatile("" : "+v"(v)); return v; }
__device__ __forceinline__ int opaque_s(int v) { asm volatile("" : "+s"(v)); return v; }
namespace pg8 {
#define PG8_LAS __attribute__((address_space(3)))
typedef unsigned short bf16_t;
typedef short bf16x8 __attribute__((ext_vector_type(8)));
typedef float f32x4 __attribute__((ext_vector_type(4)));
typedef unsigned u32x4 __attribute__((ext_vector_type(4)));
constexpr int BM = 256, BK = 64, HALF = 128, HTB = HALF * BK * 2, STAGE_BYTES = 8 * HTB, NXCD = 8, WGM = 8;

__host__ __device__ __forceinline__ int lds_byte(int r, int c) { const int st = (r >> 4) * 2 + (c >> 5), rr = r & 15, cc = c & 31, ob = rr * 64 + cc * 2; return st * 1024 + (ob ^ (((ob >> 9) & 1) << 5)); }
__host__ __device__ __forceinline__ void stage_rc(int b, int& R, int& C) { const int st = b / 1024, sb = b % 1024, swz = sb ^ (((sb >> 9) & 1) << 5); R = (st >> 1) * 16 + swz / 64; C = (st & 1) * 32 + (swz % 64) / 2; }
__host__ __device__ __forceinline__ int perm32(int rho) { const int n = rho >> 4, i = rho & 15; return 8 * (i >> 2) + 4 * n + (i & 3); }

struct Unit { int pm, pn; };
struct Gemm { const bf16_t* A; const bf16_t* Bt; int M, N, K, lda, ldb; };

struct StaticOrder {
    int nM, nN, nwg, G, c;
    __host__ __device__ void init(int M, int N, int G_, int c_) { nM = M / BM; nN = N / BM; nwg = nM * nN; G = G_; c = c_; }
    __host__ __device__ bool next(int i, Unit& u) const {
        const long L = (long)i * G + c; if (L >= nwg) return false;
        int wgid = (int)L; { const int q = nwg / NXCD, r = nwg % NXCD, xcd = wgid % NXCD, off = wgid / NXCD; wgid = (xcd < r ? xcd * (q + 1) : r * (q + 1) + (xcd - r) * q) + off; }
        const int nig = WGM * nN, gid = wgid / nig, fm = gid * WGM, gsz = (nM - fm) < WGM ? (nM - fm) : WGM;
        u.pm = fm + ((wgid % nig) % gsz); u.pn = (wgid % nig) / gsz; return true;
    }
    __device__ __forceinline__ void a_ready(const Unit&) const {}
    __device__ __forceinline__ void done(const Unit&) const {}
};

typedef float f32x2_t __attribute__((ext_vector_type(2))); typedef __bf16 bf16x2_t __attribute__((ext_vector_type(2)));
__device__ __forceinline__ unsigned cvt_pk_bf16(float lo, float hi) { f32x2_t v = {lo, hi}; bf16x2_t b = __builtin_convertvector(v, bf16x2_t); return __builtin_bit_cast(unsigned, b); }
__device__ __forceinline__ float bf_lo(unsigned w) { return __uint_as_float(w << 16); }
__device__ __forceinline__ float bf_hi(unsigned w) { return __uint_as_float(w & 0xffff0000u); }
__device__ __forceinline__ float sigmoidf_(float v) { return __builtin_amdgcn_rcpf(1.0f + __builtin_amdgcn_exp2f(-1.4426950408889634f * v)); }

template <int ACT  > struct EpiBf16 {
    static constexpr bool PERM = true, AFTER_DRAIN = false;
    bf16_t* O; int ldc;
    __device__ __forceinline__ void operator()(const f32x4 (&acc)[2][2][4][2], const Unit& u, int wr, int wc, int fr, int fq) const {
        const int row0 = u.pm * BM + wr * 64 + fr, col0 = u.pn * BM + wc * 32 + 8 * fq;
#pragma unroll
        for (int ai = 0; ai < 2; ++ai)
#pragma unroll
            for (int m = 0; m < 4; ++m) { bf16_t* rowp = O + (size_t)(row0 + ai * HALF + m * 16) * ldc + col0;
#pragma unroll
                for (int bj = 0; bj < 2; ++bj) { f32x4 v0 = acc[ai][bj][m][0], v1 = acc[ai][bj][m][1];
                    if (ACT == 1) {
#pragma unroll
                        for (int e = 0; e < 4; ++e) { v0[e] = sigmoidf_(v0[e]); v1[e] = sigmoidf_(v1[e]); } }
                    u32x4 w; w.x = cvt_pk_bf16(v0[0], v0[1]); w.y = cvt_pk_bf16(v0[2], v0[3]); w.z = cvt_pk_bf16(v1[0], v1[1]); w.w = cvt_pk_bf16(v1[2], v1[3]);
                    *(u32x4*)(rowp + bj * HALF) = w; } }
    }
};
struct EpiGateAcc {
    static constexpr bool PERM = true, AFTER_DRAIN = false;
    bf16_t* O; int ldc; const bf16_t* G; int ldg; int goff; int first;
    __device__ __forceinline__ void operator()(const f32x4 (&acc)[2][2][4][2], const Unit& u, int wr, int wc, int fr, int fq) const {
        const int row0 = u.pm * BM + wr * 64 + fr, col0 = u.pn * BM + wc * 32 + 8 * fq;
#pragma unroll
        for (int ai = 0; ai < 2; ++ai)
#pragma unroll
            for (int m = 0; m < 4; ++m) { const size_t r = (size_t)(row0 + ai * HALF + m * 16); bf16_t* rowp = O + r * ldc + col0; const bf16_t* gp = G + r * ldg + goff + col0;
#pragma unroll
                for (int bj = 0; bj < 2; ++bj) { const f32x4 v0 = acc[ai][bj][m][0], v1 = acc[ai][bj][m][1];
                    const u32x4 g = *(const u32x4*)(gp + bj * HALF);
                    float o[8];
                    o[0] = bf_lo(g.x) * v0[0]; o[1] = bf_hi(g.x) * v0[1]; o[2] = bf_lo(g.y) * v0[2]; o[3] = bf_hi(g.y) * v0[3];
                    o[4] = bf_lo(g.z) * v1[0]; o[5] = bf_hi(g.z) * v1[1]; o[6] = bf_lo(g.w) * v1[2]; o[7] = bf_hi(g.w) * v1[3];
                    if (!first) { const u32x4 p = *(const u32x4*)(rowp + bj * HALF);
                        o[0] += bf_lo(p.x); o[1] += bf_hi(p.x); o[2] += bf_lo(p.y); o[3] += bf_hi(p.y); o[4] += bf_lo(p.z); o[5] += bf_hi(p.z); o[6] += bf_lo(p.w); o[7] += bf_hi(p.w); }
                    u32x4 w; w.x = cvt_pk_bf16(o[0], o[1]); w.y = cvt_pk_bf16(o[2], o[3]); w.z = cvt_pk_bf16(o[4], o[5]); w.w = cvt_pk_bf16(o[6], o[7]);
                    *(u32x4*)(rowp + bj * HALF) = w; } }
    }
};
struct EpiSwiGLU {
    static constexpr bool PERM = true, AFTER_DRAIN = false;
    bf16_t* O; int ldc;
    __device__ __forceinline__ void operator()(const f32x4 (&acc)[2][2][4][2], const Unit& u, int wr, int wc, int fr, int fq) const {
        const int row0 = u.pm * BM + wr * 64 + fr, col0 = u.pn * HALF + wc * 32 + 8 * fq;
#pragma unroll
        for (int ai = 0; ai < 2; ++ai)
#pragma unroll
            for (int m = 0; m < 4; ++m) { bf16_t* rowp = O + (size_t)(row0 + ai * HALF + m * 16) * ldc + col0;
                float o[8];
#pragma unroll
                for (int n = 0; n < 2; ++n)
#pragma unroll
                    for (int e = 0; e < 4; ++e) { const float g = acc[ai][0][m][n][e], up = acc[ai][1][m][n][e]; o[n * 4 + e] = g * sigmoidf_(g) * up; }
                u32x4 w; w.x = cvt_pk_bf16(o[0], o[1]); w.y = cvt_pk_bf16(o[2], o[3]); w.z = cvt_pk_bf16(o[4], o[5]); w.w = cvt_pk_bf16(o[6], o[7]);
                *(u32x4*)rowp = w; }
    }
};
struct EpiResidual {
    static constexpr bool PERM = false, AFTER_DRAIN = false;
    const float* xin; float* xout; int ldc; const float* gvec; int gstride; int rows_per_batch;
    __device__ __forceinline__ void operator()(const f32x4 (&acc)[2][2][4][2], const Unit& u, int wr, int wc, int fr, int fq) const {
        const int row0 = u.pm * BM + wr * 64 + fr, col0 = u.pn * BM + wc * 32 + 4 * fq;
        const int b = (u.pm * BM) / rows_per_batch;
        f32x4 gv[2][2];
#pragma unroll
        for (int bj = 0; bj < 2; ++bj)
#pragma unroll
            for (int n = 0; n < 2; ++n) gv[bj][n] = *(const f32x4*)(gvec + (size_t)b * gstride + col0 + bj * HALF + n * 16);
#pragma unroll
        for (int ai = 0; ai < 2; ++ai)
#pragma unroll
            for (int m = 0; m < 4; ++m) { const size_t off = (size_t)(row0 + ai * HALF + m * 16) * ldc + col0;
#pragma unroll
                for (int bj = 0; bj < 2; ++bj)
#pragma unroll
                    for (int n = 0; n < 2; ++n) { const f32x4 xi = *(const f32x4*)(xin + off + bj * HALF + n * 16);
                        *(f32x4*)(xout + off + bj * HALF + n * 16) = xi + gv[bj][n] * acc[ai][bj][m][n]; } }
    }
};

template <int ACT  > struct EpiBf16N {
    static constexpr bool PERM = true, AFTER_DRAIN = false;
    bf16_t* O; int ldc; const float* rowss; const float* bias; int nb; int rows_per_batch;
    __device__ __forceinline__ void operator()(const f32x4 (&acc)[2][2][4][2], const Unit& u, int wr, int wc, int fr, int fq) const {
        const int row0 = u.pm * BM + wr * 64 + fr, col0 = u.pn * BM + wc * 32 + 8 * fq; const float* bp = bias + (size_t)((u.pm * BM) / rows_per_batch) * nb + col0;
        f32x4 bv[2][2];
#pragma unroll
        for (int bj = 0; bj < 2; ++bj) { bv[bj][0] = *(const f32x4*)(bp + bj * HALF); bv[bj][1] = *(const f32x4*)(bp + bj * HALF + 4); }
#pragma unroll
        for (int ai = 0; ai < 2; ++ai)
#pragma unroll
            for (int m = 0; m < 4; ++m) { const int row = row0 + ai * HALF + m * 16; const f32x4 rp = *(const f32x4*)(rowss + 4 * (size_t)row); const float rs = __builtin_amdgcn_rsqf(((rp[0] + rp[1]) + (rp[2] + rp[3])) * (1.0f / 1024.0f) + 1e-6f); bf16_t* rowp = O + (size_t)row * ldc + col0;
#pragma unroll
                for (int bj = 0; bj < 2; ++bj) { f32x4 v0 = acc[ai][bj][m][0] * rs + bv[bj][0], v1 = acc[ai][bj][m][1] * rs + bv[bj][1];
                    if (ACT == 1) {
#pragma unroll
                        for (int e = 0; e < 4; ++e) { v0[e] = sigmoidf_(v0[e]); v1[e] = sigmoidf_(v1[e]); } }
                    u32x4 w; w.x = cvt_pk_bf16(v0[0], v0[1]); w.y = cvt_pk_bf16(v0[2], v0[3]); w.z = cvt_pk_bf16(v1[0], v1[1]); w.w = cvt_pk_bf16(v1[2], v1[3]);
                    *(u32x4*)(rowp + bj * HALF) = w; } }
    }
};
struct EpiSwiGLUN {
    static constexpr bool PERM = true, AFTER_DRAIN = false;
    bf16_t* O; int ldc; const float* rowss; const float* bias; int nb; int rows_per_batch;
    __device__ __forceinline__ void operator()(const f32x4 (&acc)[2][2][4][2], const Unit& u, int wr, int wc, int fr, int fq) const {
        const int row0 = u.pm * BM + wr * 64 + fr, col0 = u.pn * HALF + wc * 32 + 8 * fq; const float* bp = bias + (size_t)((u.pm * BM) / rows_per_batch) * nb + u.pn * BM + wc * 32 + 8 * fq;
        f32x4 bv[2][2];
#pragma unroll
        for (int bj = 0; bj < 2; ++bj) { bv[bj][0] = *(const f32x4*)(bp + bj * HALF); bv[bj][1] = *(const f32x4*)(bp + bj * HALF + 4); }
#pragma unroll
        for (int ai = 0; ai < 2; ++ai)
#pragma unroll
            for (int m = 0; m < 4; ++m) { const int row = row0 + ai * HALF + m * 16; const f32x4 rp = *(const f32x4*)(rowss + 4 * (size_t)row); const float rs = __builtin_amdgcn_rsqf(((rp[0] + rp[1]) + (rp[2] + rp[3])) * (1.0f / 1024.0f) + 1e-6f); bf16_t* rowp = O + (size_t)row * ldc + col0;
                float o[8];
#pragma unroll
                for (int n = 0; n < 2; ++n)
#pragma unroll
                    for (int e = 0; e < 4; ++e) { const float g = acc[ai][0][m][n][e] * rs + bv[0][n][e], up = acc[ai][1][m][n][e] * rs + bv[1][n][e]; o[n * 4 + e] = g * sigmoidf_(g) * up; }
                u32x4 w; w.x = cvt_pk_bf16(o[0], o[1]); w.y = cvt_pk_bf16(o[2], o[3]); w.z = cvt_pk_bf16(o[4], o[5]); w.w = cvt_pk_bf16(o[6], o[7]);
                *(u32x4*)rowp = w; }
    }
};
struct EpiResidualN {
    static constexpr bool PERM = true, AFTER_DRAIN = false;
    const float* xin; float* xout; int ldc; const float* gvec; int gstride; int rows_per_batch; bf16_t* xg; const float* gn; const float* scn; float* rowss4; PG8_LAS float* lds_x;
    __device__ __forceinline__ void operator()(const f32x4 (&acc)[2][2][4][2], const Unit& u, int wr, int wc, int fr, int fq) const {
        const int row0 = u.pm * BM + wr * 64 + fr, col0 = u.pn * BM + wc * 32 + 8 * fq;
        const int b = (u.pm * BM) / rows_per_batch;
        float ss[2][4];
#pragma unroll
        for (int ai = 0; ai < 2; ++ai)
#pragma unroll
            for (int m = 0; m < 4; ++m) ss[ai][m] = 0.f;
#pragma unroll
        for (int bj = 0; bj < 2; ++bj) { const int c = col0 + bj * HALF;
            const f32x4 gv0 = *(const f32x4*)(gvec + (size_t)b * gstride + c), gv1 = *(const f32x4*)(gvec + (size_t)b * gstride + c + 4);
            f32x4 gs0 = {0.f, 0.f, 0.f, 0.f}, gs1 = {0.f, 0.f, 0.f, 0.f};
            if (xg) { gs0 = *(const f32x4*)(gn + c) * (*(const f32x4*)(scn + (size_t)b * gstride + c) + 1.0f); gs1 = *(const f32x4*)(gn + c + 4) * (*(const f32x4*)(scn + (size_t)b * gstride + c + 4) + 1.0f); }
#pragma unroll
            for (int ai = 0; ai < 2; ++ai)
#pragma unroll
                for (int m = 0; m < 4; ++m) { const size_t off = (size_t)(row0 + ai * HALF + m * 16) * ldc + c; const f32x4 xi0 = *(const f32x4*)(xin + off), xi1 = *(const f32x4*)(xin + off + 4);
                    const f32x4 xo0 = xi0 + gv0 * acc[ai][bj][m][0], xo1 = xi1 + gv1 * acc[ai][bj][m][1]; *(f32x4*)(xout + off) = xo0; *(f32x4*)(xout + off + 4) = xo1;
                    if (xg) { const f32x4 y0 = xo0 * gs0, y1 = xo1 * gs1; u32x4 w; w.x = cvt_pk_bf16(y0[0], y0[1]); w.y = cvt_pk_bf16(y0[2], y0[3]); w.z = cvt_pk_bf16(y1[0], y1[1]); w.w = cvt_pk_bf16(y1[2], y1[3]); *(u32x4*)(xg + off) = w;
                        ss[ai][m] += ((xo0[0] * xo0[0] + xo0[1] * xo0[1]) + (xo0[2] * xo0[2] + xo0[3] * xo0[3])) + ((xo1[0] * xo1[0] + xo1[1] * xo1[1]) + (xo1[2] * xo1[2] + xo1[3] * xo1[3])); } } }
        if (xg) {
#pragma unroll
            for (int ai = 0; ai < 2; ++ai)
#pragma unroll
                for (int m = 0; m < 4; ++m) { float v = ss[ai][m]; v += __shfl_xor(v, 16); v += __shfl_xor(v, 32); if (fq == 0) lds_x[wc * 256 + ai * HALF + wr * 64 + m * 16 + fr] = v; }
            asm volatile("s_waitcnt lgkmcnt(0)" ::: "memory"); __builtin_amdgcn_s_barrier(); asm volatile("" ::: "memory");
            const int t = threadIdx.x;
            if (t < 256) rowss4[4 * (size_t)(u.pm * BM + t) + u.pn] = (lds_x[t] + lds_x[256 + t]) + (lds_x[512 + t] + lds_x[768 + t]);
        }
    }
};

struct EpiProj1 {
    static constexpr bool PERM = true, AFTER_DRAIN = false;
    bf16_t* P1; int ld1; int c_vc; const float* rowss; const float* bias; int nb; int rows_per_batch;
    bf16_t* A2; bf16_t* KPE; bf16_t* QC; bf16_t* KC; const float* g_q; const float* g_kv; const float* g_qc; const float* g_kc; const float* tabt; const float* taba; PG8_LAS float* lds_x;
    __device__ __forceinline__ float rstd_of(int row) const { const f32x4 rp = *(const f32x4*)(rowss + 4 * (size_t)row); return __builtin_amdgcn_rsqf(((rp[0] + rp[1]) + (rp[2] + rp[3])) * (1.0f / 1024.0f) + 1e-6f); }
    __device__ __forceinline__ void operator()(const f32x4 (&acc)[2][2][4][2], const Unit& u, int wr, int wc, int fr, int fq) const {
        const int row0 = u.pm * BM + wr * 64 + fr, pn = u.pn; const float* bp = bias + (size_t)((u.pm * BM) / rows_per_batch) * nb + pn * BM + wc * 32 + 8 * fq;
#define EP1_BV(bj, n) (*(const f32x4*)(bp + (bj) * HALF + 4 * (n)))
#define EP1_PACK(v0, v1) (u32x4){cvt_pk_bf16((v0)[0], (v0)[1]), cvt_pk_bf16((v0)[2], (v0)[3]), cvt_pk_bf16((v1)[0], (v1)[1]), cvt_pk_bf16((v1)[2], (v1)[3])}
#define EP1_FENCE() asm volatile("" ::: "memory")
        if (pn < 3 || (pn == 7 && wc >= 2)) {
            const int dcol = pn < 3 ? pn * BM + wc * 32 + 8 * fq : c_vc + (wc - 2) * 64 + 8 * fq; const int bjs = pn < 3 ? HALF : 32;
#pragma unroll
            for (int ai = 0; ai < 2; ++ai)
#pragma unroll
                for (int m = 0; m < 4; ++m) { const int row = row0 + ai * HALF + m * 16; const float rs = rstd_of(row); bf16_t* rowp = P1 + (size_t)row * ld1 + dcol;
#pragma unroll
                    for (int bj = 0; bj < 2; ++bj) { const f32x4 v0 = acc[ai][bj][m][0] * rs + EP1_BV(bj, 0), v1 = acc[ai][bj][m][1] * rs + EP1_BV(bj, 1); *(u32x4*)(rowp + bj * bjs) = EP1_PACK(v0, v1); }
                    EP1_FENCE(); }
        } else if (pn == 3 || pn == 4) {
#pragma unroll
            for (int ai = 0; ai < 2; ++ai)
#pragma unroll
                for (int m = 0; m < 4; ++m) { const float rs = rstd_of(row0 + ai * HALF + m * 16); float ss = 0.f;
#pragma unroll
                    for (int bj = 0; bj < 2; ++bj) if (pn == 3 || bj == 0) { const f32x4 v0 = acc[ai][bj][m][0] * rs + EP1_BV(bj, 0), v1 = acc[ai][bj][m][1] * rs + EP1_BV(bj, 1);
                        ss += ((v0[0] * v0[0] + v0[1] * v0[1]) + (v0[2] * v0[2] + v0[3] * v0[3])) + ((v1[0] * v1[0] + v1[1] * v1[1]) + (v1[2] * v1[2] + v1[3] * v1[3])); }
                    ss += __shfl_xor(ss, 16); ss += __shfl_xor(ss, 32); if (fq == 0) lds_x[wc * 256 + ai * HALF + wr * 64 + m * 16 + fr] = ss; EP1_FENCE(); }
            asm volatile("s_waitcnt lgkmcnt(0)" ::: "memory"); __builtin_amdgcn_s_barrier(); asm volatile("" ::: "memory");
            const float invn = pn == 3 ? (1.0f / 256.0f) : (1.0f / 128.0f); const float* gp = (pn == 3 ? g_q : g_kv) + wc * 32 + 8 * fq; const int a2c = (pn == 3 ? 0 : 256) + wc * 32 + 8 * fq;
#pragma unroll
            for (int ai = 0; ai < 2; ++ai)
#pragma unroll
                for (int m = 0; m < 4; ++m) { const int rl = ai * HALF + wr * 64 + m * 16 + fr; const int row = u.pm * BM + rl; float rs = rstd_of(row); asm volatile("" : "+v"(rs));
                    const float r2 = __builtin_amdgcn_rsqf(((lds_x[rl] + lds_x[256 + rl]) + (lds_x[512 + rl] + lds_x[768 + rl])) * invn + 1e-6f);
                    { const f32x4 v0 = (acc[ai][0][m][0] * rs + EP1_BV(0, 0)) * r2 * *(const f32x4*)(gp), v1 = (acc[ai][0][m][1] * rs + EP1_BV(0, 1)) * r2 * *(const f32x4*)(gp + 4); *(u32x4*)(A2 + (size_t)row * 384 + a2c) = EP1_PACK(v0, v1); }
                    if (pn == 3) { const f32x4 v0 = (acc[ai][1][m][0] * rs + EP1_BV(1, 0)) * r2 * *(const f32x4*)(gp + HALF), v1 = (acc[ai][1][m][1] * rs + EP1_BV(1, 1)) * r2 * *(const f32x4*)(gp + HALF + 4); *(u32x4*)(A2 + (size_t)row * 384 + a2c + HALF) = EP1_PACK(v0, v1); }
                    else if (wc == 0) {
                        const int t = row % rows_per_batch; const f32x4 c = *(const f32x4*)(tabt + (size_t)t * 32 + 4 * fq), sn = *(const f32x4*)(tabt + (size_t)t * 32 + 16 + 4 * fq);
                        const f32x4 x1 = acc[ai][1][m][0] * rs + EP1_BV(1, 0), x2 = acc[ai][1][m][1] * rs + EP1_BV(1, 1); const f32x4 y1 = x1 * c - x2 * sn, y2 = x2 * c + x1 * sn;
                        typedef unsigned u32x2 __attribute__((ext_vector_type(2)));
                        *(u32x2*)(KPE + (size_t)row * 32 + 4 * fq) = (u32x2){cvt_pk_bf16(y1[0], y1[1]), cvt_pk_bf16(y1[2], y1[3])};
                        *(u32x2*)(KPE + (size_t)row * 32 + 16 + 4 * fq) = (u32x2){cvt_pk_bf16(y2[0], y2[1]), cvt_pk_bf16(y2[2], y2[3])}; }
                    EP1_FENCE(); }
        } else {
            const bool isq = pn != 7; const float* g = (isq ? g_qc : g_kc) + 4 * fq; bf16_t* dst = isq ? QC + ((pn - 5) * 4 + wc) * 64 + 8 * fq : KC + wc * 64 + 8 * fq; const int ldd = isq ? 512 : 128;
#pragma unroll
            for (int ai = 0; ai < 2; ++ai)
#pragma unroll
                for (int m = 0; m < 4; ++m) { const int row = row0 + ai * HALF + m * 16; const int t = row % rows_per_batch; const float rs = rstd_of(row);
                    f32x4 v[2][2]; float ss = 0.f;
#pragma unroll
                    for (int bj = 0; bj < 2; ++bj)
#pragma unroll
                        for (int n = 0; n < 2; ++n) { v[bj][n] = acc[ai][bj][m][n] * rs + EP1_BV(bj, n); ss += (v[bj][n][0] * v[bj][n][0] + v[bj][n][1] * v[bj][n][1]) + (v[bj][n][2] * v[bj][n][2] + v[bj][n][3] * v[bj][n][3]); }
                    ss += __shfl_xor(ss, 16); ss += __shfl_xor(ss, 32);
                    const float r2 = __builtin_amdgcn_rsqf(ss * (1.0f / 64.0f) + 1e-6f);
                    f32x4 o[2][2];
#pragma unroll
                    for (int n = 0; n < 2; ++n) { const int pos = n == 0 ? (t >> 6) : (t & 63); const f32x4 c = *(const f32x4*)(taba + (size_t)pos * 32 + 4 * fq), sn = *(const f32x4*)(taba + (size_t)pos * 32 + 16 + 4 * fq);
                        const f32x4 y1 = v[0][n] * r2 * *(const f32x4*)(g + 32 * n), y2 = v[1][n] * r2 * *(const f32x4*)(g + 32 * n + 16); o[0][n] = y1 * c - y2 * sn; o[1][n] = y2 * c + y1 * sn; }
#pragma unroll
                    for (int bj = 0; bj < 2; ++bj) *(u32x4*)(dst + (size_t)row * ldd + bj * 32) = EP1_PACK(o[bj][0], o[bj][1]);
                    EP1_FENCE(); }
        }
#undef EP1_BV
#undef EP1_PACK
#undef EP1_FENCE
    }
};

template <class Epi, class Sched, bool ALIGN_EPI = false, bool SP2 = false>
__device__ __forceinline__ void gemm_phase(PG8_LAS unsigned char* lds, const Gemm g, const Sched& S, const Epi& E) {
    const int tid = opaque_v(threadIdx.x), wid = __builtin_amdgcn_readfirstlane(tid >> 6), lane = tid & 63, wr = wid >> 2, wc = wid & 3, fr = lane & 15, fq = lane >> 4;
    const int K = g.K, nt = K / BK;
    unsigned voffA[2], voffB[2];
#pragma unroll
    for (int i = 0; i < 2; ++i) { int R, C; stage_rc(tid * 16 + i * 8192, R, C); const int Rb = Epi::PERM ? ((R & ~31) + perm32(R & 31)) : R;
        voffA[i] = (unsigned)(R * g.lda + C) * 2u; voffB[i] = (unsigned)(Rb * g.ldb + C) * 2u; }
    const size_t kstep = (size_t)(BK * 2);
    const size_t hstepA = (size_t)HALF * g.lda * 2, hstepB = (size_t)HALF * g.ldb * 2;
    const size_t tstepA = 2 * hstepA, tstepB = 2 * hstepB;
    const unsigned ldsw = (unsigned)wid * 1024u;
    const int aoff = lds_byte(wr * 64 + fr, fq * 8), boff = lds_byte(wc * 32 + fr, fq * 8);
#define PG8_SA(b, h) (((b) * 2 + (h)) * HTB)
#define PG8_SB(b, h) ((4 + (b) * 2 + (h)) * HTB)
#define PG8_STAGE(bufoff, gbase, voff) do { _Pragma("unroll") for (int _i = 0; _i < 2; ++_i) \
        __builtin_amdgcn_global_load_lds((const unsigned*)((const char*)(gbase) + (voff)[_i]), (PG8_LAS unsigned*)(lds + (bufoff) + ldsw + _i * 8192), 16, 0, 0); } while (0)
#define PG8_LDA(dst, b, h) do { _Pragma("unroll") for (int m = 0; m < 4; ++m) _Pragma("unroll") for (int k = 0; k < 2; ++k) dst[m][k] = *(const PG8_LAS bf16x8*)(lds + PG8_SA(b, h) + aoff + m * 2048 + k * 1024); } while (0)
#define PG8_LDB(dst, b, h) do { _Pragma("unroll") for (int n = 0; n < 2; ++n) _Pragma("unroll") for (int k = 0; k < 2; ++k) dst[n][k] = *(const PG8_LAS bf16x8*)(lds + PG8_SB(b, h) + boff + n * 2048 + k * 1024); } while (0)
#define PG8_MMA(ai, bj, At, Bt) do { __builtin_amdgcn_s_setprio(1); _Pragma("unroll") for (int m = 0; m < 4; ++m) _Pragma("unroll") for (int n = 0; n < 2; ++n) _Pragma("unroll") for (int k = 0; k < 2; ++k) \
        acc[ai][bj][m][n] = __builtin_amdgcn_mfma_f32_16x16x32_bf16(Bt[n][k], At[m][k], acc[ai][bj][m][n], 0, 0, 0); __builtin_amdgcn_s_setprio(0); } while (0)
#define PG8_WAIT_V(n) asm volatile("s_waitcnt vmcnt(" #n ")" ::: "memory")
#define PG8_WAIT_L(n) asm volatile("s_waitcnt lgkmcnt(" #n ")" ::: "memory")
#define PG8_BAR __builtin_amdgcn_s_barrier()
#define PG8_SCHED __builtin_amdgcn_sched_barrier(0)
    Unit cur, nxt; int ui = 0;
    if (!S.next(0, cur)) return;
    f32x4 acc[2][2][4][2];
#pragma unroll
    for (int a = 0; a < 2; ++a)
#pragma unroll
        for (int b = 0; b < 2; ++b)
#pragma unroll
            for (int m = 0; m < 4; ++m)
#pragma unroll
                for (int n = 0; n < 2; ++n) acc[a][b][m][n] = (f32x4){0.f, 0.f, 0.f, 0.f};
    bf16x8 At[4][2], B0[2][2], B1[2][2];
    const char* cA = (const char*)g.A + (size_t)cur.pm * tstepA; const char* cB = (const char*)g.Bt + (size_t)cur.pn * tstepB;
    S.a_ready(cur);
    if constexpr (SP2) {
        PG8_STAGE(PG8_SB(0, 0), cB, voffB); PG8_STAGE(PG8_SB(0, 1), cB + hstepB, voffB); PG8_STAGE(PG8_SA(0, 0), cA, voffA); PG8_STAGE(PG8_SA(0, 1), cA + hstepA, voffA);
        if (wr == 1) PG8_BAR;
        PG8_WAIT_V(2); PG8_BAR;
        PG8_STAGE(PG8_SB(1, 0), cB + kstep, voffB); PG8_STAGE(PG8_SA(1, 0), cA + kstep, voffA); PG8_STAGE(PG8_SB(1, 1), cB + hstepB + kstep, voffB);
        PG8_WAIT_V(6); PG8_BAR;
    } else {
        PG8_STAGE(PG8_SB(0, 0), cB, voffB); PG8_STAGE(PG8_SA(0, 0), cA, voffA); PG8_STAGE(PG8_SB(0, 1), cB + hstepB, voffB); PG8_STAGE(PG8_SA(0, 1), cA + hstepA, voffA);
        if (wr == 1) PG8_BAR;
        PG8_WAIT_V(4); PG8_BAR;
        PG8_STAGE(PG8_SB(1, 0), cB + kstep, voffB); PG8_STAGE(PG8_SA(1, 0), cA + kstep, voffA); PG8_STAGE(PG8_SB(1, 1), cB + hstepB + kstep, voffB);
        PG8_WAIT_V(6); PG8_BAR;
    }
    for (;;) {
        const bool has_next = S.next(ui + 1, nxt);
        const char* nA = has_next ? (const char*)g.A + (size_t)nxt.pm * tstepA : cA; const char* nB = has_next ? (const char*)g.Bt + (size_t)nxt.pn * tstepB : cB;
#pragma unroll 1
        for (int t = 0; t < nt; t += 2) {
            const bool last = (t == nt - 2);
            const char* a1 = cA + (size_t)(t + 1) * kstep;
            const char* a2 = last ? nA : cA + (size_t)(t + 2) * kstep; const char* b2 = last ? nB : cB + (size_t)(t + 2) * kstep;
            const char* a3 = a2 + kstep; const char* b3 = b2 + kstep;
            if (last && has_next) S.a_ready(nxt);
            if constexpr (SP2) {
            PG8_LDB(B0, 0, 0); PG8_LDB(B1, 0, 1); PG8_SCHED; PG8_LDA(At, 0, 0); PG8_STAGE(PG8_SA(1, 1), a1 + hstepA, voffA);
            PG8_WAIT_V(8); PG8_WAIT_L(0); PG8_BAR; PG8_MMA(0, 0, At, B0); PG8_MMA(0, 1, At, B1); PG8_BAR; PG8_SCHED;
            PG8_LDA(At, 0, 1); PG8_STAGE(PG8_SB(0, 0), b2, voffB); PG8_STAGE(PG8_SB(0, 1), b2 + hstepB, voffB); PG8_STAGE(PG8_SA(0, 0), a2, voffA);
            PG8_WAIT_V(8); PG8_WAIT_L(0); PG8_BAR; PG8_MMA(1, 0, At, B0); PG8_MMA(1, 1, At, B1); PG8_BAR; PG8_SCHED;
            PG8_LDB(B0, 1, 0); PG8_LDB(B1, 1, 1); PG8_SCHED; PG8_LDA(At, 1, 0); PG8_STAGE(PG8_SA(0, 1), a2 + hstepA, voffA);
            PG8_WAIT_V(8); PG8_WAIT_L(0); PG8_BAR; PG8_MMA(0, 0, At, B0); PG8_MMA(0, 1, At, B1); PG8_BAR; PG8_SCHED;
            PG8_LDA(At, 1, 1); PG8_STAGE(PG8_SB(1, 0), b3, voffB); PG8_STAGE(PG8_SB(1, 1), b3 + hstepB, voffB); PG8_STAGE(PG8_SA(1, 0), a3, voffA);
            PG8_WAIT_V(8); PG8_WAIT_L(0); PG8_BAR; PG8_MMA(1, 0, At, B0); PG8_MMA(1, 1, At, B1); PG8_BAR; PG8_SCHED;
            } else {
            PG8_LDB(B0, 0, 0); PG8_SCHED; PG8_LDA(At, 0, 0); PG8_STAGE(PG8_SA(1, 1), a1 + hstepA, voffA);
            PG8_WAIT_L(8); PG8_BAR; PG8_WAIT_L(0); PG8_MMA(0, 0, At, B0); PG8_BAR; PG8_SCHED;
            PG8_LDB(B1, 0, 1); PG8_STAGE(PG8_SB(0, 0), b2, voffB);
            PG8_BAR; PG8_WAIT_L(0); PG8_MMA(0, 1, At, B1); PG8_BAR;
            PG8_LDA(At, 0, 1); PG8_STAGE(PG8_SA(0, 0), a2, voffA);
            PG8_BAR; PG8_WAIT_L(0); PG8_MMA(1, 0, At, B0); PG8_BAR; PG8_SCHED;
            PG8_STAGE(PG8_SB(0, 1), b2 + hstepB, voffB);
            PG8_WAIT_V(6); PG8_BAR; PG8_MMA(1, 1, At, B1); PG8_BAR;
            PG8_LDB(B0, 1, 0); PG8_SCHED; PG8_LDA(At, 1, 0); PG8_STAGE(PG8_SA(0, 1), a2 + hstepA, voffA);
            PG8_WAIT_L(8); PG8_BAR; PG8_WAIT_L(0); PG8_MMA(0, 0, At, B0); PG8_BAR; PG8_SCHED;
            PG8_LDB(B1, 1, 1); PG8_STAGE(PG8_SB(1, 0), b3, voffB);
            PG8_BAR; PG8_WAIT_L(0); PG8_MMA(0, 1, At, B1); PG8_BAR;
            PG8_LDA(At, 1, 1); PG8_STAGE(PG8_SA(1, 0), a3, voffA);
            PG8_BAR; PG8_WAIT_L(0); PG8_MMA(1, 0, At, B0); PG8_BAR; PG8_SCHED;
            PG8_STAGE(PG8_SB(1, 1), b3 + hstepB, voffB);
            PG8_WAIT_V(6); PG8_BAR; PG8_MMA(1, 1, At, B1); PG8_BAR;
            }
        }
        if constexpr (ALIGN_EPI) { if (wr == 0) PG8_BAR; }
        if constexpr (!Epi::AFTER_DRAIN) { E(acc, cur, wr, wc, fr, fq); S.done(cur); }
        if (!has_next) break;
#pragma unroll
        for (int a = 0; a < 2; ++a)
#pragma unroll
            for (int b = 0; b < 2; ++b)
#pragma unroll
                for (int m = 0; m < 4; ++m)
#pragma unroll
                    for (int n = 0; n < 2; ++n) acc[a][b][m][n] = (f32x4){0.f, 0.f, 0.f, 0.f};
        cur = nxt; cA = nA; cB = nB; ++ui;
        if constexpr (ALIGN_EPI) { if (wr == 1) PG8_BAR; }
    }
    PG8_WAIT_V(0);
    if constexpr (!ALIGN_EPI) { if (wr == 0) PG8_BAR; }
    PG8_BAR;
#undef PG8_SA
#undef PG8_SB
#undef PG8_STAGE
#undef PG8_LDA
#undef PG8_LDB
#undef PG8_MMA
#undef PG8_WAIT_V
#undef PG8_WAIT_L
#undef PG8_BAR
#undef PG8_SCHED
}
}

namespace att {
using bf16x8 = __attribute__((ext_vector_type(8))) short;
using s16x4  = __attribute__((ext_vector_type(4))) short;
using f32x16 = __attribute__((ext_vector_type(16))) float;
using f32x4  = __attribute__((ext_vector_type(4))) float;
using u32x4  = __attribute__((ext_vector_type(4))) unsigned;
typedef unsigned short bf16_t;
constexpr int NW = 8, QBLK = 32, KVBLK = 64;
constexpr int SHM_V = 8192, SHM_KN = 8192, SHM_KR = 4096;
constexpr int OFF_V = 0, OFF_KN = 2 * SHM_V, OFF_KR = OFF_KN + 2 * SHM_KN, OFF_WS = OFF_KR + 2 * SHM_KR, OFF_BIAS = OFF_WS + NW * 64 * 4 + 1024  , LDS_BYTES = OFF_BIAS + 15 * 32 * 4 + 1024;
#define ATT_SBAR() __builtin_amdgcn_sched_barrier(0)
__device__ __forceinline__ int crow(int r, int hi) { return (r & 3) + 8 * (r >> 2) + 4 * hi; }
__device__ __forceinline__ unsigned cvtpk(float lo, float hi) { return pg8::cvt_pk_bf16(lo, hi); }
__device__ __forceinline__ float bf2f(short s) { return __uint_as_float(((unsigned)(unsigned short)s) << 16); }
__device__ __forceinline__ int kn_off(int row, int chunk) { return row * 128 + ((chunk ^ ((row >> 1) & 7)) << 4); }
__device__ __forceinline__ int kr_off(int row, int chunk) { return row * 64 + ((chunk ^ ((row >> 2) & 3)) << 4); }
__device__ __forceinline__ int v_st(int k, int c) { const int kk = (k & ~0xC) | ((k & 4) << 1) | ((k & 8) >> 1); return ((kk >> 3) * 2 + (c >> 5)) * 512 + ((kk & 7) * 32 + (c & 31)) * 2; }
__device__ __forceinline__ int v_rd_base(int lane) { return ((lane & 3) << 3) | (((lane >> 2) & 3) << 6) | (((lane >> 4) & 1) << 5) | (((lane >> 5) & 1) << 8); }
constexpr int v_rd_off(int d0, int ks, int half) { return d0 * 512 + ks * 2048 + half * 1024; }
template <int OFF> __device__ __forceinline__ s16x4 tr_read(int vb) { s16x4 r; asm volatile("ds_read_b64_tr_b16 %0, %1 offset:%2" : "=&v"(r) : "v"(vb), "i"(OFF) : "memory"); return r; }

template <int D0> __device__ __forceinline__ void pv_one(f32x16& od, int vb, bf16x8 pa0, bf16x8 pa1, bf16x8 pa2, bf16x8 pa3) {
  const s16x4 l0 = tr_read<v_rd_off(D0, 0, 0)>(vb), h0 = tr_read<v_rd_off(D0, 0, 1)>(vb), l1 = tr_read<v_rd_off(D0, 1, 0)>(vb), h1 = tr_read<v_rd_off(D0, 1, 1)>(vb);
  const s16x4 l2 = tr_read<v_rd_off(D0, 2, 0)>(vb), h2 = tr_read<v_rd_off(D0, 2, 1)>(vb), l3 = tr_read<v_rd_off(D0, 3, 0)>(vb), h3 = tr_read<v_rd_off(D0, 3, 1)>(vb);
  asm volatile("s_waitcnt lgkmcnt(0)" ::: "memory"); ATT_SBAR();
#define ATT_PK(L, H) (bf16x8){L[0], L[1], L[2], L[3], H[0], H[1], H[2], H[3]}
  od = __builtin_amdgcn_mfma_f32_32x32x16_bf16(pa0, ATT_PK(l0, h0), od, 0, 0, 0);
  od = __builtin_amdgcn_mfma_f32_32x32x16_bf16(pa1, ATT_PK(l1, h1), od, 0, 0, 0);
  od = __builtin_amdgcn_mfma_f32_32x32x16_bf16(pa2, ATT_PK(l2, h2), od, 0, 0, 0);
  od = __builtin_amdgcn_mfma_f32_32x32x16_bf16(pa3, ATT_PK(l3, h3), od, 0, 0, 0);
#undef ATT_PK
}

template <int DKR> struct Cst { static constexpr float SCALE = DKR ? 0.10206207261596577f : 0.125f; static constexpr float C = SCALE * 1.4426950408889634f; };

template <int DKR> __device__ __forceinline__ void partialSM(f32x16& p0, f32x16& p1, float& m_reg, float& alpha) {
  constexpr float C = Cst<DKR>::C;
  float pmax = p0[0];
#pragma unroll
  for (int r = 1; r < 16; ++r) pmax = fmaxf(pmax, p0[r]);
#pragma unroll
  for (int r = 0; r < 16; ++r) pmax = fmaxf(pmax, p1[r]);
  { auto rr = __builtin_amdgcn_permlane32_swap(__float_as_uint(pmax), __float_as_uint(pmax), false, false);
    pmax = fmaxf(__uint_as_float(rr[0]), __uint_as_float(rr[1])); }
  float mn;
  if (__builtin_expect(__all(pmax <= m_reg), 1)) { mn = m_reg; alpha = 1.f; }
  else { mn = fmaxf(m_reg, pmax); alpha = __builtin_amdgcn_exp2f((m_reg - mn) * C); m_reg = mn; }
  const float mnC = -mn * C;
#pragma unroll
  for (int r = 0; r < 16; ++r) p0[r] = fmaf(p0[r], C, mnC);
#pragma unroll
  for (int r = 0; r < 16; ++r) p1[r] = fmaf(p1[r], C, mnC);
#pragma unroll
  for (int r = 0; r < 16; ++r) p0[r] = __builtin_amdgcn_exp2f(p0[r]);
}
__device__ __forceinline__ void finishSM(f32x16& p0, f32x16& p1, float alpha, float& l_reg, bf16x8& pa0, bf16x8& pa1, bf16x8& pa2, bf16x8& pa3) {
#pragma unroll
  for (int r = 0; r < 16; ++r) p1[r] = __builtin_amdgcn_exp2f(p1[r]);
  float ps = 0;
#pragma unroll
  for (int r = 0; r < 16; ++r) ps += p0[r];
#pragma unroll
  for (int r = 0; r < 16; ++r) ps += p1[r];
  { auto rr = __builtin_amdgcn_permlane32_swap(__float_as_uint(ps), __float_as_uint(ps), false, false);
    ps = __uint_as_float(rr[0]) + __uint_as_float(rr[1]); }
  l_reg = l_reg * alpha + ps;
#define ATT_PK4(P, BASE, OUT) do { unsigned a0 = cvtpk(P[BASE + 0], P[BASE + 1]), a1 = cvtpk(P[BASE + 2], P[BASE + 3]);   \
    unsigned b0 = cvtpk(P[BASE + 4], P[BASE + 5]), b1 = cvtpk(P[BASE + 6], P[BASE + 7]);                              \
    auto r0 = __builtin_amdgcn_permlane32_swap(a0, b0, false, false); auto r1 = __builtin_amdgcn_permlane32_swap(a1, b1, false, false); \
    u32x4 w = {r0[0], r1[0], r0[1], r1[1]}; OUT = *reinterpret_cast<bf16x8*>(&w); } while (0)
  ATT_PK4(p0, 0, pa0); ATT_PK4(p0, 8, pa1); ATT_PK4(p1, 0, pa2); ATT_PK4(p1, 8, pa3);
#undef ATT_PK4
}
template <int DKR> __device__ __forceinline__ void qkt(f32x16& p0, f32x16& p1, const char* Kn, const char* Kr, const bf16x8* qr, int r32, int hi) {
  p0 = f32x16{}; p1 = f32x16{};
#pragma unroll
  for (int d0 = 0; d0 < 4; ++d0) {
    const bf16x8 b0 = *reinterpret_cast<const bf16x8*>(Kn + kn_off(r32, d0 * 2 + hi));
    const bf16x8 b1 = *reinterpret_cast<const bf16x8*>(Kn + kn_off(32 + r32, d0 * 2 + hi));
    p0 = __builtin_amdgcn_mfma_f32_32x32x16_bf16(b0, qr[d0], p0, 0, 0, 0);
    p1 = __builtin_amdgcn_mfma_f32_32x32x16_bf16(b1, qr[d0], p1, 0, 0, 0); }
  if constexpr (DKR != 0) {
#pragma unroll
    for (int d0 = 0; d0 < 2; ++d0) {
      const bf16x8 b0 = *reinterpret_cast<const bf16x8*>(Kr + kr_off(r32, d0 * 2 + hi));
      const bf16x8 b1 = *reinterpret_cast<const bf16x8*>(Kr + kr_off(32 + r32, d0 * 2 + hi));
      p0 = __builtin_amdgcn_mfma_f32_32x32x16_bf16(b0, qr[4 + d0], p0, 0, 0, 0);
      p1 = __builtin_amdgcn_mfma_f32_32x32x16_bf16(b1, qr[4 + d0], p1, 0, 0, 0); }
  }
}

__device__ __forceinline__ void na_mask(f32x16& p0, f32x16& p1, const char* brow_b, int a, bool tile_ok) {
  const float NEG = -INFINITY;
#pragma unroll
  for (int r = 0; r < 16; ++r) { const int cr = (r & 3) + 8 * (r >> 2);
    const float b0 = *reinterpret_cast<const float*>(brow_b + cr * 4), b1 = *reinterpret_cast<const float*>(brow_b + (cr + 32) * 4);
    const bool v0 = tile_ok && ((unsigned)(cr + a) < 16u), v1 = tile_ok && ((unsigned)(cr + 32 + a) < 16u);
    p0[r] = v0 ? fmaf(8.0f, b0, p0[r]) : NEG; p1[r] = v1 ? fmaf(8.0f, b1, p1[r]) : NEG; }
}
template <int DKR, bool NA = false>
__device__ __forceinline__ void attn_unit(const bf16_t* __restrict__ Qb, int ldq, const bf16_t* __restrict__ Kn, int ldk, const bf16_t* __restrict__ Kr, int ldkr,
                                          const bf16_t* __restrict__ Vh, int ldv, bf16_t* __restrict__ Ob, int ldo, int seq, const float* __restrict__ qtab, char* lds,
                                          const float* __restrict__ rpb_h = nullptr, int r0 = 0, int kstart = 0) {
  const int tid = opaque_v(threadIdx.x), wid = tid >> 6, lane = tid & 63, r32 = lane & 31, hi = lane >> 5;
  char* V_lds = lds + OFF_V; char* KN_lds = lds + OFF_KN; char* KR_lds = lds + OFF_KR;
  float* ws = (float*)(lds + OFF_WS) + wid * 64; float* li_l = ws; float* al_l = ws + 32;
  float m_reg = -1e30f, l_reg = 0; f32x16 o[2] = {}; bf16x8 qr[DKR ? 6 : 4];
  const bf16_t* Qw = Qb + (long)(wid * QBLK + r32) * ldq + hi * 8;
#pragma unroll
  for (int d0 = 0; d0 < 4; ++d0) qr[d0] = *reinterpret_cast<const bf16x8*>(Qw + d0 * 16);
  if constexpr (DKR != 0) {
    const bf16x8 x1 = *reinterpret_cast<const bf16x8*>(Qw + 64), x2 = *reinterpret_cast<const bf16x8*>(Qw + 80);
    const float* tb = qtab + (long)(wid * QBLK + r32) * 32 + hi * 8;
    const f32x4 c0 = *(const f32x4*)(tb), c1 = *(const f32x4*)(tb + 4), s0 = *(const f32x4*)(tb + 16), s1 = *(const f32x4*)(tb + 20);
    float y1[8], y2[8];
#pragma unroll
    for (int j = 0; j < 8; ++j) { const float a = bf2f(x1[j]), b = bf2f(x2[j]); const float cc = j < 4 ? c0[j & 3] : c1[j & 3], ss = j < 4 ? s0[j & 3] : s1[j & 3];
      y1[j] = a * cc - b * ss; y2[j] = b * cc + a * ss; }
    u32x4 w1 = {cvtpk(y1[0], y1[1]), cvtpk(y1[2], y1[3]), cvtpk(y1[4], y1[5]), cvtpk(y1[6], y1[7])};
    u32x4 w2 = {cvtpk(y2[0], y2[1]), cvtpk(y2[2], y2[3]), cvtpk(y2[4], y2[5]), cvtpk(y2[6], y2[7])};
    qr[4] = *reinterpret_cast<bf16x8*>(&w1); qr[5] = *reinterpret_cast<bf16x8*>(&w2);
  }
  const int sr = tid >> 3, sc8 = tid & 7, knst = kn_off(sr, sc8), vst = v_st(sr, sc8 * 8);
  const int rr_ = (tid >> 2) & 63, rc_ = tid & 3, krst = kr_off(rr_, rc_);
  const bool do_kr = (DKR != 0) && (tid < 256);
  const int vb0 = (int)(uintptr_t)V_lds + v_rd_base(lane);
  bf16x8 sK0, sV0, sR0, sK1, sV1, sR1;
  sR0 = bf16x8{}; sR1 = bf16x8{};
#define ATT_SLOAD(SK, SV, SR, k0) do { SK = *reinterpret_cast<const bf16x8*>(Kn + (long)((k0) + sr) * ldk + sc8 * 8); SV = *reinterpret_cast<const bf16x8*>(Vh + (long)((k0) + sr) * ldv + sc8 * 8); \
    if (do_kr) SR = *reinterpret_cast<const bf16x8*>(Kr + (long)((k0) + rr_) * ldkr + rc_ * 8); } while (0)
#define ATT_SWRITE(b, SK, SV, SR) do { *(bf16x8*)(V_lds + (b) * SHM_V + vst) = SV; *(bf16x8*)(KN_lds + (b) * SHM_KN + knst) = SK; \
    if (do_kr) *(bf16x8*)(KR_lds + (b) * SHM_KR + krst) = SR; } while (0)
#define ATT_RESC(a) do { if (__any((a) < 1.f)) { if (hi == 0) al_l[r32] = (a); asm volatile("s_waitcnt lgkmcnt(0)" ::: "memory"); \
    _Pragma("unroll") for (int d = 0; d < 2; ++d) _Pragma("unroll") for (int r = 0; r < 16; ++r) o[d][r] *= al_l[crow(r, hi)]; } } while (0)
  f32x16 pA0, pA1, pB0, pB1; float alA, alB; bf16x8 pa0, pa1, pa2, pa3; const int NT = seq / KVBLK;
  const int na_r = r0 + (wid >> 1), na_rs = min(max(na_r - 4, 0), 24), na_qc = (wid & 1) * 32 + r32, na_ws = min(max(na_qc - 8, 0), 48);
  const int na_a = 4 * hi - na_ws; const char* na_b0 = lds + OFF_BIAS + (4 * hi - na_qc + 15) * 4;
  if constexpr (NA) { float* bt = (float*)(lds + OFF_BIAS); if (tid < 15 * 32) bt[tid] = ((tid & 31) < 31) ? rpb_h[(tid >> 5) * 31 + (tid & 31)] : 0.f; }
#define ATT_NAMASK(P0, P1, t) do { if constexpr (NA) { const int kr_ = kstart + (t); const bool ok_ = (unsigned)(kr_ - na_rs) < 8u; const int ro_ = min(max(kr_ - na_r + 7, 0), 14); \
    na_mask(P0, P1, na_b0 + ro_ * 128, na_a, ok_); } } while (0)
  ATT_SLOAD(sK0, sV0, sR0, 0); ATT_SWRITE(0, sK0, sV0, sR0); __syncthreads();
  qkt<DKR>(pA0, pA1, KN_lds, KR_lds, qr, r32, hi); ATT_NAMASK(pA0, pA1, 0); partialSM<DKR>(pA0, pA1, m_reg, alA);
  ATT_SLOAD(sK1, sV1, sR1, KVBLK); if (2 < NT) ATT_SLOAD(sK0, sV0, sR0, 2 * KVBLK);
  ATT_SWRITE(1, sK1, sV1, sR1); __syncthreads();
  for (int j = 1; j + 1 < NT; j += 2) {
    ATT_SBAR(); qkt<DKR>(pB0, pB1, KN_lds + SHM_KN, KR_lds + SHM_KR, qr, r32, hi); ATT_NAMASK(pB0, pB1, j);
    finishSM(pA0, pA1, alA, l_reg, pa0, pa1, pa2, pa3); ATT_SBAR();
    ATT_SLOAD(sK1, sV1, sR1, (j + 2) * KVBLK); ATT_SBAR();
    pv_one<0>(o[0], vb0, pa0, pa1, pa2, pa3); pv_one<1>(o[1], vb0, pa0, pa1, pa2, pa3); partialSM<DKR>(pB0, pB1, m_reg, alB);
    __syncthreads(); ATT_SWRITE(0, sK0, sV0, sR0);
    ATT_RESC(alB); __syncthreads();
    ATT_SBAR(); qkt<DKR>(pA0, pA1, KN_lds, KR_lds, qr, r32, hi); ATT_NAMASK(pA0, pA1, j + 1);
    finishSM(pB0, pB1, alB, l_reg, pa0, pa1, pa2, pa3); ATT_SBAR();
    if (j + 3 < NT) ATT_SLOAD(sK0, sV0, sR0, (j + 3) * KVBLK); ATT_SBAR();
    pv_one<0>(o[0], vb0 + SHM_V, pa0, pa1, pa2, pa3); pv_one<1>(o[1], vb0 + SHM_V, pa0, pa1, pa2, pa3); partialSM<DKR>(pA0, pA1, m_reg, alA);
    __syncthreads(); ATT_SWRITE(1, sK1, sV1, sR1);
    ATT_RESC(alA); __syncthreads();
  }
  ATT_SBAR(); qkt<DKR>(pB0, pB1, KN_lds + SHM_KN, KR_lds + SHM_KR, qr, r32, hi); ATT_NAMASK(pB0, pB1, NT - 1);
  finishSM(pA0, pA1, alA, l_reg, pa0, pa1, pa2, pa3); ATT_SBAR();
  pv_one<0>(o[0], vb0, pa0, pa1, pa2, pa3); pv_one<1>(o[1], vb0, pa0, pa1, pa2, pa3); partialSM<DKR>(pB0, pB1, m_reg, alB);
  __syncthreads(); ATT_RESC(alB);
  finishSM(pB0, pB1, alB, l_reg, pa0, pa1, pa2, pa3); ATT_SBAR();
  pv_one<0>(o[0], vb0 + SHM_V, pa0, pa1, pa2, pa3); pv_one<1>(o[1], vb0 + SHM_V, pa0, pa1, pa2, pa3);
  if (hi == 0) li_l[r32] = l_reg; asm volatile("s_waitcnt lgkmcnt(0)" ::: "memory");
  float rli[16];
#pragma unroll
  for (int r = 0; r < 16; ++r) rli[r] = __builtin_amdgcn_rcpf(li_l[crow(r, hi)]);
  bf16_t* Ow = Ob + (long)(wid * QBLK) * ldo;
#pragma unroll
  for (int r = 0; r < 16; ++r) { const int orow = crow(r, hi);
#pragma unroll
    for (int d0 = 0; d0 < 2; ++d0) { const float v = o[d0][r] * rli[r]; Ow[(long)orow * ldo + d0 * 32 + r32] = (bf16_t)(cvtpk(v, v) & 0xffffu); } }
  __syncthreads();
#undef ATT_SLOAD
#undef ATT_SWRITE
#undef ATT_RESC
#undef ATT_NAMASK
}
#undef ATT_SBAR
}

constexpr int NWAVES = 8;
constexpr int BATCH = 8, SEQ = 2048, DM = 1024, DEPTH = 2, M = BATCH * SEQ;
constexpr int GRID_W = 64, NROWS = SEQ / GRID_W;
constexpr int IN_COLS = 5024, N1 = 2048  , NG = 3072, N1_USED = 1952;
constexpr int FFN = 2816, NMOD = 6;
constexpr float NORM_EPS = 1e-6f;
constexpr int C_QA = 0, C_KA = 256, C_VA = 512, C_VC = 768;
constexpr int C_CQ = 768, C_CKV = 1024, C_KR = 1152, C_QC = 1184, C_KC = 1696;

constexpr size_t MiB = 1u << 20;
constexpr size_t WS_CTL = 0, CTL_ZERO_BYTES = 64 * 1024;
constexpr size_t WS_MOD = 1 * MiB;
constexpr size_t WS_TABT = WS_MOD + 512 * 1024;
constexpr size_t WS_TABA = WS_TABT + 256 * 1024;
constexpr size_t WS_W = 2 * MiB;
constexpr size_t W_1 = 0, W_G = W_1 + (size_t)N1 * DM * 2, W_2 = W_G + (size_t)NG * DM * 2, W_BNA = W_2 + (size_t)1024 * 384 * 2, W_BMLA = W_BNA + (size_t)1024 * 256 * 2,
                 W_BGQA = W_BMLA + (size_t)1024 * 256 * 2, W_OUT = W_BGQA + (size_t)1024 * 512 * 2, W_GU = W_OUT + (size_t)1024 * 1024 * 2, W_DN = W_GU + (size_t)2 * FFN * DM * 2,
                 LAYER_W_BYTES = W_DN + (size_t)DM * FFN * 2;
static_assert(LAYER_W_BYTES == 32768000, "weights per layer");
constexpr size_t WS_ROWSS_A = 64 * MiB + 512 * 1024, WS_ROWSS_B = WS_ROWSS_A + 256 * 1024;
constexpr size_t WS_BIAS = WS_ROWSS_B + 256 * 1024;
constexpr int NB1 = N1, NBG = NG, NBGU = 2 * FFN, BIAS_PER_LAYER = 8 * (NB1 + NBG + NBGU);
constexpr size_t WS_XG2 = 194 * MiB;
constexpr size_t WS_H = 66 * MiB;
constexpr size_t WS_P1 = 98 * MiB;
constexpr size_t WS_KPE = 162 * MiB;
constexpr size_t WS_QC = 163 * MiB;
constexpr size_t WS_KC = 179 * MiB;
constexpr size_t WS_P2 = 183 * MiB;
constexpr size_t WS_OCAT = 215 * MiB;
constexpr size_t WS_A2 = 215 * MiB;
constexpr size_t WS_GATES = 98 * MiB;
constexpr size_t WS_ACT = 98 * MiB;
constexpr size_t WS_END = 247 * MiB;
static_assert(WS_W + 2 * LAYER_W_BYTES <= WS_ROWSS_A && WS_BIAS + (size_t)2 * BIAS_PER_LAYER * 4 <= WS_H && WS_XG2 + (size_t)M * DM * 2 <= WS_END && WS_GATES + (size_t)M * NG * 2 <= WS_OCAT && WS_ACT + (size_t)M * FFN * 2 <= WS_OCAT, "ws map");
constexpr int CW_BAR = 4096;

constexpr int RING_OFF = 0, RING_BYTES = 131072;
constexpr int LDSCTL_OFF = RING_BYTES, MISC_OFF = LDSCTL_OFF + 320;
constexpr int EPIX_OFF = 132096;
constexpr int LDS_BYTES = 147456;

#define GAS __attribute__((address_space(1)))
#define LAS __attribute__((address_space(3)))
typedef unsigned short bf16;
typedef unsigned v4u __attribute__((ext_vector_type(4)));
typedef unsigned v2u __attribute__((ext_vector_type(2)));
typedef float f32x4 __attribute__((ext_vector_type(4)));
typedef short bf16x8 __attribute__((ext_vector_type(8)));
typedef GAS unsigned gu32;
#define RLX_AGENT __ATOMIC_RELAXED, __HIP_MEMORY_SCOPE_AGENT
#define LDS_WAIT() asm volatile("s_waitcnt lgkmcnt(0)" ::: "memory")
__device__ __forceinline__ unsigned f2bf(float f) { unsigned u = __builtin_bit_cast(unsigned, f); return (u + 0x7fffu + ((u >> 16) & 1u)) >> 16; }
__device__ __forceinline__ unsigned pk2(float lo, float hi) { return f2bf(lo) | (f2bf(hi) << 16); }
__device__ __forceinline__ float bflo(unsigned w) { return __uint_as_float(w << 16); }
__device__ __forceinline__ float bfhi(unsigned w) { return __uint_as_float(w & 0xffff0000u); }
__device__ __forceinline__ float bf1(bf16 s) { return __uint_as_float(((unsigned)s) << 16); }

#define XB_TMO      128
#define XB_XCNT(j)  (256  + 64 * (j))
#define XB_XSUB(j)  (1280 + 64 * (j))
#define XB_XGEN(j)  (2304 + 64 * (j))
#define XB_TOP      3328
#define XB_TOPGEN   3392
#define XCD_BAR_WORDS 3456
#define XB_SPIN_CAP (1u << 18)
__device__ __forceinline__ unsigned xb_ld(unsigned* p)              { return __hip_atomic_load(p, __ATOMIC_RELAXED, __HIP_MEMORY_SCOPE_AGENT); }
__device__ __forceinline__ unsigned xb_add(unsigned* p, unsigned v) { return __hip_atomic_fetch_add(p, v, __ATOMIC_RELAXED, __HIP_MEMORY_SCOPE_AGENT); }
__device__ __forceinline__ unsigned xb_xcc_id() { return (unsigned)__builtin_amdgcn_s_getreg((3 << 11) | 20) & 0xFu; }
#define XB_SPIN(cond, bar) do { unsigned _sp = 0; while (cond) { __builtin_amdgcn_s_sleep(1); \
    if ((++_sp & 255u) == 0u) { if (xb_ld(&(bar)[XB_TMO])) break; if (_sp > XB_SPIN_CAP) { atomicAdd(&(bar)[XB_TMO], 1u); break; } } } } while (0)
struct XcdBarrier { unsigned* bar; unsigned x; volatile LAS unsigned* st; };
__device__ __forceinline__ XcdBarrier xcd_barrier_post(unsigned* bar, volatile LAS unsigned* st) {
    XcdBarrier b; b.bar = bar; b.x = xb_xcc_id(); b.st = st;
    if (threadIdx.x == 0) (void)xb_add(&bar[XB_XCNT(b.x)], 1u);
    return b;
}
__device__ __forceinline__ void xcd_barrier_complete(unsigned* bar, unsigned x, unsigned& nloc, unsigned& nx) {
    const unsigned G = gridDim.x * gridDim.y * gridDim.z;
    unsigned sum, cnt, mine, sp = 0u;
    for (;;) {
        sum = 0u; cnt = 0u; mine = 0u;
#pragma unroll
        for (unsigned j = 0; j < 16; ++j) { const unsigned c = xb_ld(&bar[XB_XCNT(j)]); sum += c; cnt += (c > 0u) ? 1u : 0u; mine = (j == x) ? c : mine; }
        if (sum == G) break;
        __builtin_amdgcn_s_sleep(1);
        if ((++sp & 255u) == 0u) { if (xb_ld(&bar[XB_TMO])) break; if (sp > XB_SPIN_CAP) { atomicAdd(&bar[XB_TMO], 1u); break; } }
    }
    nloc = mine > 0u ? mine : 1u; nx = cnt > 0u ? cnt : 1u;
}
__device__ __forceinline__ void xcd_barrier(const XcdBarrier& b) {
    asm volatile("s_waitcnt vmcnt(0)" ::: "memory");
    __syncthreads();
    if (threadIdx.x == 0) {
        unsigned* bar = b.bar;
        __builtin_amdgcn_s_waitcnt(0);
        unsigned nloc = b.st[0], nx = b.st[1];
        if (nloc == 0u) { xcd_barrier_complete(bar, b.x, nloc, nx); b.st[0] = nloc; b.st[1] = nx; }
        const unsigned old = xb_add(&bar[XB_XSUB(b.x)], 1u);
        const unsigned gen = old / nloc;
        if (old + 1u == (gen + 1u) * nloc) {
            __builtin_amdgcn_fence(__ATOMIC_RELEASE, "agent");
            asm volatile("s_waitcnt vmcnt(0)" ::: "memory");
            const unsigned og = xb_add(&bar[XB_TOP], 1u);
            const unsigned tg = og / nx;
            if (og + 1u == (tg + 1u) * nx) xb_add(&bar[XB_TOPGEN], 1u);
            else XB_SPIN(xb_ld(&bar[XB_TOPGEN]) == tg, bar);
            __builtin_amdgcn_fence(__ATOMIC_ACQUIRE, "agent");
            xb_add(&bar[XB_XGEN(b.x)], 1u);
            asm volatile("s_waitcnt vmcnt(0)" ::: "memory");
        } else {
            XB_SPIN(xb_ld(&bar[XB_XGEN(b.x)]) == gen, bar);
            __builtin_amdgcn_fence(__ATOMIC_ACQUIRE, "agent");
            asm volatile("s_waitcnt vmcnt(0)" ::: "memory");
        }
    }
    __syncthreads();
}

struct Args { const float* in[21]; float* out; unsigned char* ws; int ph_lo, ph_hi; };
struct LayerW { bf16 *w1, *wg, *w2, *bna, *bmla, *bgqa, *wout, *wgu, *wdn; };
__device__ __forceinline__ LayerW layer_w(unsigned char* ws, int l) {
    unsigned char* b = ws + WS_W + (size_t)l * LAYER_W_BYTES; LayerW w;
    w.w1 = (bf16*)(b + W_1); w.wg = (bf16*)(b + W_G); w.w2 = (bf16*)(b + W_2); w.bna = (bf16*)(b + W_BNA); w.bmla = (bf16*)(b + W_BMLA); w.bgqa = (bf16*)(b + W_BGQA);
    w.wout = (bf16*)(b + W_OUT); w.wgu = (bf16*)(b + W_GU); w.wdn = (bf16*)(b + W_DN); return w;
}
__device__ __forceinline__ float wave_sum(float v) {
#pragma unroll
    for (int o = 1; o < 64; o <<= 1) v += __shfl_xor(v, o);
    return v;
}
__device__ __forceinline__ void sincos_d(double x, double& s, double& c) {
    const double k = __builtin_rint(x * 0.15915494309189535);
    double r = __builtin_fma(-k, 6.283185307179586, x); r = __builtin_fma(-k, 2.4492935982947064e-16, r);
    const double r2 = r * r; double tc = 1.0, ts = 1.0, cs = 1.0, ss = 1.0;
#pragma unroll 1
    for (int n = 1; n <= 15; ++n) { tc *= -r2 / (double)((2 * n - 1) * (2 * n)); cs += tc; ts *= -r2 / (double)((2 * n) * (2 * n + 1)); ss += ts; }
    s = r * ss; c = cs;
}
__device__ __forceinline__ float inv_freq(int i) {
    const float q[4] = {1.0f, 0.5623413251903491f, 0.31622776601683794f, 0.17782794100389228f};
    const float p[4] = {1.0f, 0.1f, 0.01f, 0.001f};
    float a = (i & 3) == 0 ? q[0] : (i & 3) == 1 ? q[1] : (i & 3) == 2 ? q[2] : q[3];
    float b = (i >> 2) == 0 ? p[0] : (i >> 2) == 1 ? p[1] : (i >> 2) == 2 ? p[2] : p[3];
    return (float)((double)a * (double)b);
}

template <class RowPtr>
__device__ __forceinline__ void transpose_item(const float* W, int N, int k0, int n0, const RowPtr& rp, LAS float* scr, int lane) {
#pragma unroll 8
    for (int i = 0; i < 32; ++i) { const int kk = 2 * i + (lane >> 5); scr[kk * 33 + (lane & 31)] = W[(size_t)(k0 + kk) * N + n0 + (lane & 31)]; }
    LDS_WAIT(); asm volatile("" ::: "memory");
    const int c = lane & 7;
#pragma unroll
    for (int j = 0; j < 4; ++j) { const int n = (lane >> 3) + 8 * j; const LAS float* s = scr + (8 * c) * 33 + n;
        v4u o; o.x = pk2(s[0 * 33], s[1 * 33]); o.y = pk2(s[2 * 33], s[3 * 33]); o.z = pk2(s[4 * 33], s[5 * 33]); o.w = pk2(s[6 * 33], s[7 * 33]);
        *(GAS v4u*)(rp(n0 + n) + k0 + 8 * c) = o; }
    LDS_WAIT(); asm volatile("" ::: "memory");
}
struct RpPlain { bf16* base; int ld; int roff; int koff; __device__ __forceinline__ bf16* operator()(int n) const { return base + (size_t)(n + roff) * ld + koff; } };
struct RpWin { bf16* w1; bf16* wg; __device__ __forceinline__ bf16* operator()(int n) const {
    if (n >= N1_USED) return wg + (size_t)(n - N1_USED) * DM;
    int row;
    if (n < 1152) row = n;
    else if (n < 1184) { const int j = n - 1152, nn = j >> 4, i = j & 15; row = 1024 + 128 + 8 * (i >> 2) + 4 * nn + (i & 3); }
    else if (n < 1824) { const bool kc = n >= 1696; const int j = kc ? n - 1696 : n - 1184, head = j >> 6, d = j & 63, nn = d >> 5, bj = (d >> 4) & 1, i = d & 15, r = 8 * (i >> 2) + 4 * nn + (i & 3);
        const int tile = kc ? 7 : 5 + (head >> 2), wc = kc ? head : (head & 3); row = tile * 256 + bj * 128 + wc * 32 + r; }
    else { const int j = n - 1824, head = j >> 6, d = j & 63; row = 7 * 256 + (d >> 5) * 128 + (2 + head) * 32 + (d & 31); }
    return w1 + (size_t)row * DM; } };
struct RpGU { bf16* base; __device__ __forceinline__ bf16* operator()(int n) const { const int j = n < FFN ? n : n - FFN; return base + (size_t)(256 * (j >> 7) + (n < FFN ? 0 : 128) + (j & 127)) * DM; } };


#ifndef SELFCHECK
#define SELFCHECK 0
#endif
#if SELFCHECK
constexpr size_t WS_SAVE = WS_TABA + 16 * 1024;
constexpr int CW_FLAGS = 64;
__device__ __forceinline__ unsigned hash_u(unsigned x) { x ^= x >> 16; x *= 0x7feb352dU; x ^= x >> 15; x *= 0x846ca68bU; x ^= x >> 16; return x; }
__device__ __forceinline__ bool nclose(float a, float ref, float tol) { return !(fabsf(a - ref) <= tol); }
__device__ __forceinline__ int save_row(int s) { return (s * 509 + 13) % M; }
template <int ST> __device__ __forceinline__ void selfcheck(const Args& args, int l, unsigned* flags) {
    unsigned char* ws = args.ws;
    const int gtid = opaque_v(blockIdx.x * (NWAVES * 64) + threadIdx.x);
    const unsigned hsh = hash_u((unsigned)gtid * 2654435761u + ST * 977u + l * 7919u);
    const float* modp = (const float*)(ws + WS_MOD); const float* tabt = (const float*)(ws + WS_TABT); const float* taba = (const float*)(ws + WS_TABA);
    const bf16* Hb = (const bf16*)(ws + WS_H); const bf16* P1 = (const bf16*)(ws + WS_P1); const bf16* KPE = (const bf16*)(ws + WS_KPE); const bf16* QC = (const bf16*)(ws + WS_QC); const bf16* KC = (const bf16*)(ws + WS_KC);
    const bf16* P2 = (const bf16*)(ws + WS_P2); const bf16* OCAT = (const bf16*)(ws + WS_OCAT); const bf16* A2 = (const bf16*)(ws + WS_A2); const bf16* GATES = (const bf16*)(ws + WS_GATES); const bf16* ACT = (const bf16*)(ws + WS_ACT);
    float* saved = (float*)(ws + WS_SAVE);
    const float* mod = modp + (size_t)l * BATCH * NMOD * DM;
    const float* xcur = (l == 0) ? args.in[0] : args.out; const float* xres = args.out;
    bool bad = false;
    const int m = hsh % M, b = m / SEQ, t = m % SEQ; const unsigned h2 = hsh >> 14;
    if constexpr (ST == 0) {
        const int ll = hsh & 1, bb = (hsh >> 1) & 7, j = (hsh >> 4) % (NMOD * DM); float ref = args.in[3][(size_t)ll * NMOD * DM + j];
        for (int k = 0; k < DM; ++k) { const float v = args.in[1][bb * DM + k]; ref += (v / (1.0f + expf(-v))) * args.in[2][((size_t)ll * DM + k) * (NMOD * DM) + j]; }
        bad = nclose(modp[((size_t)ll * BATCH + bb) * (NMOD * DM) + j], ref, 1e-3f + 1e-3f * fabsf(ref));
    } else if constexpr (ST == 1) {
        const int tt = hsh % SEQ, i = (hsh >> 11) & 15, p = (hsh >> 15) & 63;
        const float a1 = (float)tt * inv_freq(i), a2 = (float)p * inv_freq(i);
        bad = nclose(tabt[tt * 32 + i], cosf(a1), 2e-4f) || nclose(tabt[tt * 32 + 16 + i], sinf(a1), 2e-4f) || nclose(taba[p * 32 + i], cosf(a2), 2e-4f) || nclose(taba[p * 32 + 16 + i], sinf(a2), 2e-4f);
    } else if constexpr (ST == 2 || ST == 12) {
        const float* x = (ST == 2 ? xcur : xres) + (size_t)m * DM; const int c = h2 % DM; float ss = 0.f;
        for (int k = 0; k < DM; ++k) ss += x[k] * x[k];
        const float rstd = 1.0f / sqrtf(ss / DM + NORM_EPS); const float* g = args.in[ST == 2 ? 4 : 5] + (size_t)l * DM; const float* sh = mod + (size_t)b * NMOD * DM + (ST == 2 ? 0 : 3 * DM);
        const float ref = (x[c] * rstd * g[c]) * (1.0f + sh[DM + c]) + sh[c];
        bad = nclose(bf1(Hb[(size_t)m * DM + c]), ref, 0.01f + 0.01f * fabsf(ref));
    } else if constexpr (ST == 3 || ST == 9) {
        const int n = h2 % (ST == 3 ? N1_USED : NG); const int ncol = ST == 3 ? n : N1_USED + n; const float* W = args.in[6] + (size_t)l * DM * IN_COLS + ncol; float ref = 0.f, s2 = 0.f;
        for (int k = 0; k < DM; ++k) { const float p = bf1(Hb[(size_t)m * DM + k]) * W[(size_t)k * IN_COLS]; ref += p; s2 += p * p; }
        if (ST == 3) bad = nclose(bf1(P1[(size_t)m * N1 + n]), ref, 0.02f * sqrtf(s2) + 0.01f * fabsf(ref) + 1e-3f);
        else { const size_t gi = (size_t)m * NG + n; const unsigned wsys = __hip_atomic_load((unsigned*)(GATES + (gi & ~(size_t)1)), __ATOMIC_RELAXED, __HIP_MEMORY_SCOPE_SYSTEM);
            const bf16 vsys = (bf16)((gi & 1) ? (wsys >> 16) : (wsys & 0xffffu)); const bf16 vpl = GATES[gi];
            bad = nclose(bf1(vsys), 1.0f / (1.0f + expf(-ref)), 0.03f); if (vpl != vsys) atomicOr(flags, 1u << 15);
            { pg8::StaticOrder So; So.init(M, NG, 256, 0); int ui = 3; for (int L = 0; L < 768; ++L) { pg8::StaticOrder S1 = So; S1.c = L & 255; pg8::Unit u; S1.next(L >> 8, u); if (u.pm == m / 256 && u.pn == n / 256) ui = L >> 8; }
              atomicAdd(flags + 2 + ui, 1u); if (bad) atomicAdd(flags + 8 + ui, 1u); } }
    } else if constexpr (ST == 4) {
        const bf16* pr = P1 + (size_t)m * N1; const int which = h2 & 3; const unsigned h3 = hsh >> 16; const int prow = t / GRID_W, pcol = t % GRID_W;
        if (which == 0) { const int j = h3 % 384; const int base = j < 256 ? C_CQ : C_CKV, n = j < 256 ? 256 : 128, jj = j < 256 ? j : j - 256; float ss = 0.f;
            for (int k = 0; k < n; ++k) { const float v = bf1(pr[base + k]); ss += v * v; }
            const float g = j < 256 ? args.in[8][(size_t)l * 256 + jj] : args.in[9][(size_t)l * 128 + jj];
            const float ref = bf1(pr[base + jj]) / sqrtf(ss / n + NORM_EPS) * g; bad = nclose(bf1(A2[(size_t)m * 384 + j]), ref, 0.02f + 0.01f * fabsf(ref));
        } else if (which == 1) { const int j = h3 % 32, i = j & 15; const float x1 = bf1(pr[C_KR + i]), x2 = bf1(pr[C_KR + 16 + i]), c = tabt[t * 32 + i], sn = tabt[t * 32 + 16 + i];
            const float ref = j < 16 ? x1 * c - x2 * sn : x2 * c + x1 * sn; bad = nclose(bf1(KPE[(size_t)m * 32 + j]), ref, 0.02f + 0.01f * fabsf(ref));
        } else { const bool isq = which == 2; const int j = h3 % (isq ? 512 : 128), hd = j / 64, d = j % 64; const bf16* src = pr + (isq ? C_QC : C_KC) + hd * 64; float ss = 0.f;
            for (int k = 0; k < 64; ++k) { const float v = bf1(src[k]); ss += v * v; }
            const float rstd = 1.0f / sqrtf(ss / 64 + NORM_EPS); const float* g = args.in[isq ? 12 : 13] + (size_t)l * 64;
            const int part = d / 32, i = (d % 32) % 16; const bool second = (d % 32) >= 16; const int dp = second ? d - 16 : d + 16; const int pos = part == 0 ? prow : pcol;
            const float y = bf1(src[d]) * rstd * g[d], yp = bf1(src[dp]) * rstd * g[dp], c = taba[pos * 32 + i], sn = taba[pos * 32 + 16 + i];
            const float ref = second ? y * c + yp * sn : y * c - yp * sn;
            bad = nclose(bf1(isq ? QC[(size_t)m * 512 + j] : KC[(size_t)m * 128 + j]), ref, 0.02f + 0.01f * fabsf(ref)); }
    } else if constexpr (ST == 5) {
        const int n = h2 % 896; float ref = 0.f, s2 = 0.f;
        if (n < 384) { const float* W = args.in[10] + (size_t)l * 256 * 384 + n; for (int k = 0; k < 256; ++k) { const float p = bf1(A2[(size_t)m * 384 + k]) * W[(size_t)k * 384]; ref += p; s2 += p * p; } }
        else { const float* W = args.in[11] + (size_t)l * 128 * 512 + (n - 384); for (int k = 0; k < 128; ++k) { const float p = bf1(A2[(size_t)m * 384 + 256 + k]) * W[(size_t)k * 512]; ref += p; s2 += p * p; } }
        bad = nclose(bf1(P2[(size_t)m * 1024 + n]), ref, 0.02f * sqrtf(s2) + 0.01f * fabsf(ref) + 1e-3f);
    } else if constexpr (ST == 6) {
        if (blockIdx.x < 16) { const int h = h2 & 3, d = (h2 >> 2) & 63; const bf16* qp = P2 + (size_t)m * 1024 + h * 96; float q[96];
#pragma unroll
            for (int i = 0; i < 64; ++i) q[i] = bf1(qp[i]);
#pragma unroll
            for (int i = 0; i < 16; ++i) { const float x1 = bf1(qp[64 + i]), x2 = bf1(qp[80 + i]), c = tabt[t * 32 + i], sn = tabt[t * 32 + 16 + i]; q[64 + i] = x1 * c - x2 * sn; q[80 + i] = x2 * c + x1 * sn; }
            float mx = -1e30f, lsum = 0.f, o = 0.f;
            for (int kk = 0; kk < SEQ; ++kk) { const size_t mk = (size_t)b * SEQ + kk; const bf16* kn = P2 + mk * 1024 + 384 + h * 128; const bf16* kr = KPE + mk * 32; float sc = 0.f;
#pragma unroll
                for (int i = 0; i < 64; ++i) sc += q[i] * bf1(kn[i]);
#pragma unroll
                for (int i = 0; i < 32; ++i) sc += q[64 + i] * bf1(kr[i]);
                sc *= 0.10206207261596577f; const float mn = fmaxf(mx, sc), a = expf(mx - mn), p = expf(sc - mn); mx = mn; lsum = lsum * a + p; o = o * a + p * bf1(kn[64 + d]); }
            const float ref = o / lsum; bad = nclose(bf1(OCAT[(size_t)m * 1024 + 256 + h * 64 + d]), ref, 0.002f + 0.02f * fabsf(ref)); }
    } else if constexpr (ST == 7) {
        if (blockIdx.x < 16) { const int hq = h2 & 7, kvh = hq >> 2, d = (h2 >> 3) & 63; const bf16* qp = QC + (size_t)m * 512 + hq * 64; float q[64];
#pragma unroll
            for (int i = 0; i < 64; ++i) q[i] = bf1(qp[i]);
            float mx = -1e30f, lsum = 0.f, o = 0.f;
            for (int kk = 0; kk < SEQ; ++kk) { const size_t mk = (size_t)b * SEQ + kk; const bf16* kn = KC + mk * 128 + kvh * 64; float sc = 0.f;
#pragma unroll
                for (int i = 0; i < 64; ++i) sc += q[i] * bf1(kn[i]);
                sc *= 0.125f; const float mn = fmaxf(mx, sc), a = expf(mx - mn), p = expf(sc - mn); mx = mn; lsum = lsum * a + p; o = o * a + p * bf1(P1[mk * N1 + C_VC + kvh * 64 + d]); }
            const float ref = o / lsum; bad = nclose(bf1(OCAT[(size_t)m * 1024 + 512 + hq * 64 + d]), ref, 0.002f + 0.02f * fabsf(ref)); }
    } else if constexpr (ST == 8) {
        const int h = h2 & 3, d = (h2 >> 2) & 63, r = t / GRID_W, qc = t % GRID_W; const int rs = min(max(r - 4, 0), NROWS - 8), wst = min(max(qc - 8, 0), GRID_W - 16);
        const bf16* qp = P1 + (size_t)m * N1 + C_QA + h * 64; const float* rpb = args.in[7] + (size_t)l * 4 * 15 * 31; float mx = -1e30f, lsum = 0.f, o = 0.f;
        for (int i = 0; i < 8; ++i)
            for (int j = 0; j < 16; ++j) { const size_t tk = (size_t)b * SEQ + (size_t)(rs + i) * GRID_W + wst + j; const bf16* kp = P1 + tk * N1 + C_KA + h * 64; float s_ = 0.f;
                for (int k = 0; k < 64; ++k) s_ += bf1(qp[k]) * bf1(kp[k]);
                s_ = s_ * 0.125f + rpb[((size_t)h * 15 + (rs + i - r + 7)) * 31 + (wst + j - qc + 15)];
                const float mn = fmaxf(mx, s_), a = expf(mx - mn), p = expf(s_ - mn); mx = mn; lsum = lsum * a + p; o = o * a + p * bf1(P1[tk * N1 + C_VA + h * 64 + d]); }
        const float ref = o / lsum; bad = nclose(bf1(OCAT[(size_t)m * 1024 + h * 64 + d]), ref, 0.003f + 0.02f * fabsf(ref));
    } else if constexpr (ST == 10) {
        const int c = h2 % DM; float ref = 0.f;
        for (int br = 0; br < 3; ++br) { const int kk = br == 2 ? 512 : 256, off = br * 256; const float* W = args.in[14 + br] + (size_t)l * kk * DM + c; float y = 0.f;
            for (int k = 0; k < kk; ++k) y += bf1(OCAT[(size_t)m * 1024 + off + k]) * W[(size_t)k * DM];
            ref += bf1(GATES[(size_t)m * NG + br * 1024 + c]) * y; }
        bad = nclose(bf1(Hb[(size_t)m * DM + c]), ref, 0.002f + 0.03f * fabsf(ref));
        if (bad) atomicAdd(flags + 2, 1u); if (nclose(bf1(Hb[(size_t)m * DM + c]), ref, 0.01f + 0.15f * fabsf(ref))) atomicAdd(flags + 3, 1u);
        if (gtid < 32 * DM) saved[gtid] = xcur[(size_t)save_row(gtid / DM) * DM + (gtid % DM)];
    } else if constexpr (ST == 11 || ST == 14) {
        if (gtid < 32 * DM) { const int s = gtid / DM, c = gtid % DM, mm = save_row(s), bb = mm / SEQ; float acc = 0.f, s2 = 0.f;
            if (ST == 11) { const float* W = args.in[17] + (size_t)l * DM * DM + c; for (int k = 0; k < DM; ++k) { const float p = bf1(Hb[(size_t)mm * DM + k]) * W[(size_t)k * DM]; acc += p; s2 += p * p; } }
            else { const float* W = args.in[19] + (size_t)l * FFN * DM + c; for (int k = 0; k < FFN; ++k) { const float p = bf1(ACT[(size_t)mm * FFN + k]) * W[(size_t)k * DM]; acc += p; s2 += p * p; } }
            const float g = mod[(size_t)bb * NMOD * DM + (ST == 11 ? 2 : 5) * DM + c]; const float ref = saved[gtid] + g * acc;
            bad = nclose(xres[(size_t)mm * DM + c], ref, 1e-3f + fabsf(g) * 0.02f * sqrtf(s2) + 1e-3f * fabsf(ref)); }
    } else if constexpr (ST == 13) {
        const int j = h2 % FFN; const float* W = args.in[18] + (size_t)l * DM * 2 * FFN; float gt = 0.f, up = 0.f, s2 = 0.f;
        for (int k = 0; k < DM; ++k) { const float hv = bf1(Hb[(size_t)m * DM + k]); const float p1 = hv * W[(size_t)k * 2 * FFN + j], p2 = hv * W[(size_t)k * 2 * FFN + FFN + j]; gt += p1; up += p2; s2 += p1 * p1 + p2 * p2; }
        const float ref = gt / (1.0f + expf(-gt)) * up; bad = nclose(bf1(ACT[(size_t)m * FFN + j]), ref, 0.03f * sqrtf(s2) * (1.0f + fabsf(gt) + fabsf(up)) + 0.02f * fabsf(ref) + 2e-3f);
        if (gtid < 32 * DM) saved[gtid] = xres[(size_t)save_row(gtid / DM) * DM + (gtid % DM)];
    }
    if (bad) atomicOr(flags, 1u << (ST + 16 * l));
}
#ifndef CHKMASK
#define CHKMASK 0xffff
#endif
#define CHK(ST) do { if constexpr (((CHKMASK >> (ST)) & 1) != 0) if (ph <= hi && ph > lo) { selfcheck<ST>(args, l_chk, (unsigned*)(ctl + CW_FLAGS)); xcd_barrier(bar); } } while (0)
#else
#define CHK(ST) do { } while (0)
#endif

__global__ void __launch_bounds__(NWAVES * 64, 2) hybrid_fwd(Args args) {
    extern __shared__ __attribute__((aligned(16))) unsigned char lds[];
    LAS unsigned char* ldsl = (LAS unsigned char*)lds;
    volatile LAS unsigned* MISC = (volatile LAS unsigned*)(ldsl + MISC_OFF);
    const int tid = threadIdx.x, lane = tid & 63, wave = __builtin_amdgcn_readfirstlane(tid >> 6);
    const int G = gridDim.x; const int bx = blockIdx.x; const int vcu = (G % 8 == 0) ? (bx % 8) * (G / 8) + bx / 8 : bx;
    if (G != 256) return;
    unsigned char* ws = args.ws;
    gu32* ctl = (gu32*)(ws + WS_CTL);
    for (int u = tid; u < (LDS_BYTES - LDSCTL_OFF) / 4; u += NWAVES * 64) ((LAS unsigned*)(ldsl + LDSCTL_OFF))[u] = 0u;
    __syncthreads();
    XcdBarrier bar = xcd_barrier_post((unsigned*)(ctl + CW_BAR), MISC + 8);
    const int gw0 = vcu * NWAVES + wave;
    const int lo = args.ph_lo, hi = args.ph_hi; int ph = 0;
#ifndef PROBE_MASK
#define PROBE_MASK 0
#endif
#define PHASE_BEGIN(ID) if (lo <= ph && ph < hi) { for (int rep_ = 0; rep_ < 1 + (int)(((PROBE_MASK >> (ID)) & 1) && !((ID) == 8 && ph > 11)); ++rep_) { if (rep_) xcd_barrier(bar);
#define PHASE_END() } if (SELFCHECK || ph + 1 < hi) xcd_barrier(bar); } ++ph;

    float* modp = (float*)(ws + WS_MOD); float* tabt = (float*)(ws + WS_TABT); float* taba = (float*)(ws + WS_TABA);
    bf16* Hb = (bf16*)(ws + WS_H); bf16* P1 = (bf16*)(ws + WS_P1); bf16* KPE = (bf16*)(ws + WS_KPE); bf16* QC = (bf16*)(ws + WS_QC); bf16* KC = (bf16*)(ws + WS_KC);
    bf16* P2 = (bf16*)(ws + WS_P2); bf16* OCAT = (bf16*)(ws + WS_OCAT); bf16* A2 = (bf16*)(ws + WS_A2); bf16* GATES = (bf16*)(ws + WS_GATES); bf16* ACT = (bf16*)(ws + WS_ACT);
    const float* x_in = args.in[0]; float* xres = args.out;
    float* rowss_a = (float*)(ws + WS_ROWSS_A); float* rowss_b = (float*)(ws + WS_ROWSS_B); float* biasp = (float*)(ws + WS_BIAS); bf16* XG2 = (bf16*)(ws + WS_XG2);

    PHASE_BEGIN(0)
    { const int tid = opaque_v(threadIdx.x), lane = tid & 63, bx = opaque_s((int)blockIdx.x), G = opaque_s((int)gridDim.x), gw = opaque_s(gw0), NGW = G * NWAVES; (void)lane; (void)bx; (void)G; (void)gw; (void)NGW;
        LAS float* sc = (LAS float*)(ldsl + RING_OFF);
        const float* cin = args.in[1];
        for (int i = tid; i < BATCH * DM; i += NWAVES * 64) { const int b = i / DM, k = i % DM; const float v = cin[i]; sc[k * 8 + b] = v / (1.0f + __expf(-v)); }
        __syncthreads();
        if (bx < 192) {
            const int l = bx / 96, cg = bx % 96; const float* W = args.in[2] + (size_t)l * DM * (NMOD * DM) + cg * 64 + lane + (size_t)(wave * 128) * (NMOD * DM);
            LAS float* part = (LAS float*)(ldsl + RING_OFF + 102400);
            float acc[8];
#pragma unroll
            for (int b = 0; b < 8; ++b) acc[b] = 0.f;
#pragma unroll 16
            for (int k = 0; k < 128; ++k) { const float w = W[(size_t)k * (NMOD * DM)]; const int kk = wave * 128 + k; const f32x4 s0 = *(const LAS f32x4*)(sc + kk * 8), s1 = *(const LAS f32x4*)(sc + kk * 8 + 4);
                acc[0] += s0[0] * w; acc[1] += s0[1] * w; acc[2] += s0[2] * w; acc[3] += s0[3] * w; acc[4] += s1[0] * w; acc[5] += s1[1] * w; acc[6] += s1[2] * w; acc[7] += s1[3] * w; }
#pragma unroll
            for (int b = 0; b < 8; ++b) part[(wave * 8 + b) * 64 + lane] = acc[b];
            __syncthreads();
            {
                const int b = tid >> 6; float v = args.in[3][(size_t)l * NMOD * DM + cg * 64 + lane];
#pragma unroll
                for (int w8 = 0; w8 < 8; ++w8) v += part[(w8 * 8 + b) * 64 + lane];
                modp[((size_t)l * BATCH + b) * (NMOD * DM) + cg * 64 + lane] = v;
            }
        }
        for (int i = bx * NWAVES * 64 + tid; i < (SEQ + 64) * 16; i += G * NWAVES * 64) {
            const int p = i >> 4, fi = i & 15; const int pos = p < SEQ ? p : p - SEQ; float* dst = p < SEQ ? tabt + (size_t)p * 32 : taba + (size_t)(p - SEQ) * 32;
            const float ang = (float)pos * inv_freq(fi); double s, c; sincos_d((double)ang, s, c); dst[fi] = (float)c; dst[16 + fi] = (float)s;
        }
        LAS float* scr = (LAS float*)(ldsl + RING_OFF + 32768 + wave * 8704);
        for (int l = 0; l < DEPTH; ++l) {
            const LayerW w = layer_w(ws, l);
            constexpr int I_IN = 16 * 157, I_UQ = 4 * 12, I_UKV = 2 * 16, I_BNA = 4 * 32, I_BMLA = 4 * 32, I_BGQA = 8 * 32, I_OUT = 16 * 32, I_GU = 16 * 176, I_DN = 44 * 32;
            constexpr int NITEMS = I_IN + I_UQ + I_UKV + I_BNA + I_BMLA + I_BGQA + I_OUT + I_GU + I_DN;
            for (int it = gw; it < NITEMS; it += NGW) {
                int r = it;
                if (r < I_IN)  { transpose_item(args.in[6] + (size_t)l * DM * IN_COLS, IN_COLS, 64 * (r / 157), 32 * (r % 157), RpWin{w.w1, w.wg}, scr, lane); continue; } r -= I_IN;
                if (r < I_UQ)  { transpose_item(args.in[10] + (size_t)l * 256 * 384, 384, 64 * (r / 12), 32 * (r % 12), RpPlain{w.w2, 384, 0, 0}, scr, lane); continue; } r -= I_UQ;
                if (r < I_UKV) { transpose_item(args.in[11] + (size_t)l * 128 * 512, 512, 64 * (r / 16), 32 * (r % 16), RpPlain{w.w2, 384, 384, 256}, scr, lane); continue; } r -= I_UKV;
                if (r < I_BNA) { transpose_item(args.in[14] + (size_t)l * 256 * 1024, 1024, 64 * (r / 32), 32 * (r % 32), RpPlain{w.bna, 256, 0, 0}, scr, lane); continue; } r -= I_BNA;
                if (r < I_BMLA){ transpose_item(args.in[15] + (size_t)l * 256 * 1024, 1024, 64 * (r / 32), 32 * (r % 32), RpPlain{w.bmla, 256, 0, 0}, scr, lane); continue; } r -= I_BMLA;
                if (r < I_BGQA){ transpose_item(args.in[16] + (size_t)l * 512 * 1024, 1024, 64 * (r / 32), 32 * (r % 32), RpPlain{w.bgqa, 512, 0, 0}, scr, lane); continue; } r -= I_BGQA;
                if (r < I_OUT) { transpose_item(args.in[17] + (size_t)l * 1024 * 1024, 1024, 64 * (r / 32), 32 * (r % 32), RpPlain{w.wout, 1024, 0, 0}, scr, lane); continue; } r -= I_OUT;
                if (r < I_GU)  { transpose_item(args.in[18] + (size_t)l * DM * 2 * FFN, 2 * FFN, 64 * (r / 176), 32 * (r % 176), RpGU{w.wgu}, scr, lane); continue; } r -= I_GU;
                transpose_item(args.in[19] + (size_t)l * FFN * DM, DM, 64 * (r / 32), 32 * (r % 32), RpPlain{w.wdn, FFN, 0, 0}, scr, lane);
            }
            const v4u z = {0u, 0u, 0u, 0u};
            for (int i = bx * NWAVES * 64 + tid; i < 96 * 128; i += G * NWAVES * 64) *(GAS v4u*)(w.w1 + (size_t)(1024 + 160) * DM + (size_t)i * 8) = z;
            for (int i = bx * NWAVES * 64 + tid; i < 1024 * 48; i += G * NWAVES * 64) { const int row = i / 48, ch = i % 48, col = ch * 8;
                const bool zero = row < 384 ? (col >= 256) : row < 896 ? (col < 256) : true;
                if (zero) *(GAS v4u*)(w.w2 + (size_t)row * 384 + col) = z; }
        }
    }
    PHASE_END()
    { const int l_chk = 0; (void)l_chk; CHK(0); CHK(1); }

    PHASE_BEGIN(1)
    { const int tid = opaque_v(threadIdx.x), lane = tid & 63, bx = opaque_s((int)blockIdx.x), G = opaque_s((int)gridDim.x), gw = opaque_s(gw0), NGW = G * NWAVES; (void)lane; (void)bx; (void)G; (void)gw; (void)NGW;
        constexpr int ROWS_PER_LAYER = NB1 + NBG + NBGU, TASKS_PER_LAYER = ROWS_PER_LAYER / 16;
        for (int tk = gw; tk < DEPTH * TASKS_PER_LAYER; tk += NGW) {
            const int l = tk / TASKS_PER_LAYER, r0 = (tk % TASKS_PER_LAYER) * 16, n = lane & 15, q = lane >> 4; const LayerW w = layer_w(ws, l);
            const bf16* wrow; float* bout; int which, nb;
            if (r0 < NB1) { wrow = w.w1 + (size_t)(r0 + n) * DM; bout = biasp + (size_t)l * BIAS_PER_LAYER + r0 + n; which = 0; nb = NB1; }
            else if (r0 < NB1 + NBG) { wrow = w.wg + (size_t)(r0 - NB1 + n) * DM; bout = biasp + (size_t)l * BIAS_PER_LAYER + 8 * NB1 + (r0 - NB1) + n; which = 0; nb = NBG; }
            else { wrow = w.wgu + (size_t)(r0 - NB1 - NBG + n) * DM; bout = biasp + (size_t)l * BIAS_PER_LAYER + 8 * (NB1 + NBG) + (r0 - NB1 - NBG) + n; which = 3; nb = NBGU; }
            const float* sp = modp + ((size_t)l * BATCH + (n & 7)) * NMOD * DM + which * DM + 8 * q; wrow += 8 * q;
            f32x4 acc = {0.f, 0.f, 0.f, 0.f};
#pragma unroll 8
            for (int k = 0; k < DM; k += 32) { const bf16x8 bfrag = *(const bf16x8*)(wrow + k); const f32x4 s0 = *(const f32x4*)(sp + k), s1 = *(const f32x4*)(sp + k + 4);
                v4u aw; aw.x = pk2(s0[0], s0[1]); aw.y = pk2(s0[2], s0[3]); aw.z = pk2(s1[0], s1[1]); aw.w = pk2(s1[2], s1[3]); if (n >= 8) aw = (v4u){0u, 0u, 0u, 0u};
                acc = __builtin_amdgcn_mfma_f32_16x16x32_bf16(__builtin_bit_cast(bf16x8, aw), bfrag, acc, 0, 0, 0); }
            if (q < 2) {
#pragma unroll
                for (int e = 0; e < 4; ++e) bout[(size_t)(4 * q + e) * nb] = acc[e]; }
        }
        {
            const float* g = args.in[4]; const float* mod0 = modp;
            for (int m = gw; m < M; m += NGW) {
                const int b = m / SEQ; const float* xr = x_in + (size_t)m * DM; const float* scl = mod0 + (size_t)b * NMOD * DM + DM;
                f32x4 v[4]; float sq = 0.f;
#pragma unroll
                for (int j = 0; j < 4; ++j) { v[j] = *(const f32x4*)(xr + 256 * j + 4 * lane); sq += (v[j][0] * v[j][0] + v[j][1] * v[j][1]) + (v[j][2] * v[j][2] + v[j][3] * v[j][3]); }
                sq = wave_sum(sq); if (lane == 0) *(f32x4*)(rowss_a + 4 * (size_t)m) = (f32x4){sq, 0.f, 0.f, 0.f};
#pragma unroll
                for (int j = 0; j < 4; ++j) { const int c = 256 * j + 4 * lane; const f32x4 gg = *(const f32x4*)(g + c), s1 = *(const f32x4*)(scl + c);
                    v2u o; o.x = pk2(v[j][0] * gg[0] * (1.0f + s1[0]), v[j][1] * gg[1] * (1.0f + s1[1])); o.y = pk2(v[j][2] * gg[2] * (1.0f + s1[2]), v[j][3] * gg[3] * (1.0f + s1[3])); *(v2u*)(Hb + (size_t)m * DM + c) = o; }
            }
        }
    }
    PHASE_END()

    for (int l = 0; l < DEPTH; ++l) {
        const LayerW w = layer_w(ws, l);
        const float* mod = modp + (size_t)l * BATCH * NMOD * DM;
        const float* xcur = (l == 0) ? x_in : xres;
        const int l_chk = l; (void)l_chk;

        PHASE_BEGIN(2)
        { const int tid = opaque_v(threadIdx.x), lane = tid & 63, bx = opaque_s((int)blockIdx.x), G = opaque_s((int)gridDim.x), gw = opaque_s(gw0), NGW = G * NWAVES; (void)lane; (void)bx; (void)G; (void)gw; (void)NGW;
            pg8::Gemm g{Hb, w.w1, M, N1, DM, DM, DM}; pg8::StaticOrder S; S.init(M, N1, G, bx);
            pg8::EpiProj1 E{P1, N1, C_VC, rowss_a, biasp + (size_t)l * BIAS_PER_LAYER, NB1, SEQ, A2, KPE, QC, KC, args.in[8] + (size_t)l * 256, args.in[9] + (size_t)l * 128,
                            args.in[12] + (size_t)l * 64, args.in[13] + (size_t)l * 64, tabt, taba, (LAS float*)(ldsl + EPIX_OFF)};
            pg8::gemm_phase<pg8::EpiProj1, pg8::StaticOrder, true, true>(ldsl + RING_OFF, g, S, E);
        }
        PHASE_END()
        CHK(3);

        PHASE_BEGIN(4)
        { const int tid = opaque_v(threadIdx.x), lane = tid & 63, bx = opaque_s((int)blockIdx.x), G = opaque_s((int)gridDim.x), gw = opaque_s(gw0), NGW = G * NWAVES; (void)lane; (void)bx; (void)G; (void)gw; (void)NGW;
            pg8::Gemm g{A2, w.w2, M, 1024, 384, 384, 384}; pg8::StaticOrder S; S.init(M, 1024, G, bx);
            pg8::EpiBf16<0> E{P2, 1024};
            pg8::gemm_phase<pg8::EpiBf16<0>, pg8::StaticOrder, true, true>(ldsl + RING_OFF, g, S, E);
        }
        PHASE_END()
        CHK(5);

        PHASE_BEGIN(5)
        { const int tid = opaque_v(threadIdx.x), lane = tid & 63, bx = opaque_s((int)blockIdx.x), G = opaque_s((int)gridDim.x), gw = opaque_s(gw0), NGW = G * NWAVES; (void)lane; (void)bx; (void)G; (void)gw; (void)NGW;
            char* alds = (char*)lds + RING_OFF;
            {
                const int x8 = bx & 7, j32 = bx >> 3;
                {
                    const int grp = x8 * 4 + (j32 >> 3), qb = j32 & 7, b = grp >> 2, h = grp & 3; const size_t row0 = (size_t)b * SEQ;
                    att::attn_unit<32>(P2 + (row0 + qb * 256) * 1024 + h * 96, 1024, P2 + row0 * 1024 + 384 + h * 128, 1024, KPE + row0 * 32, 32,
                                       P2 + row0 * 1024 + 384 + h * 128 + 64, 1024, OCAT + (row0 + qb * 256) * 1024 + 256 + h * 64, 1024, SEQ, tabt + (size_t)(qb * 256) * 32, alds);
                }
                for (int i = 0; i < 2; ++i) {
                    const int grp = i * 8 + x8, b = grp >> 1, kvh = grp & 1, hq = kvh * 4 + (j32 >> 3), qb = j32 & 7; const size_t row0 = (size_t)b * SEQ;
                    att::attn_unit<0>(QC + (row0 + qb * 256) * 512 + hq * 64, 512, KC + row0 * 128 + kvh * 64, 128, nullptr, 0,
                                      P1 + row0 * N1 + C_VC + kvh * 64, N1, OCAT + (row0 + qb * 256) * 1024 + 512 + hq * 64, 1024, SEQ, nullptr, alds);
                }
            }
            {
                const int x8 = bx & 7, j32 = bx >> 3; const int grp = x8 * 4 + (j32 >> 3), i = j32 & 7, b = grp >> 2, h = grp & 3; const size_t row0 = (size_t)b * SEQ;
                const int r0 = 4 * i, kst = min(max(r0 - 4, 0), 24), nt = (i == 0 || i == 7) ? 8 : 12;
                const bf16* base = P1 + (row0 + (size_t)kst * GRID_W) * N1;
                att::attn_unit<0, true>(P1 + (row0 + (size_t)r0 * GRID_W) * N1 + C_QA + h * 64, N1, base + C_KA + h * 64, N1, nullptr, 0, base + C_VA + h * 64, N1,
                                        OCAT + (row0 + (size_t)r0 * GRID_W) * 1024 + h * 64, 1024, nt * 64, nullptr, alds, args.in[7] + ((size_t)l * 4 + h) * 15 * 31, r0, kst);
            }
        }
        PHASE_END()
        CHK(6); CHK(7); CHK(8);

        PHASE_BEGIN(6)
        { const int tid = opaque_v(threadIdx.x), lane = tid & 63, bx = opaque_s((int)blockIdx.x), G = opaque_s((int)gridDim.x), gw = opaque_s(gw0), NGW = G * NWAVES; (void)lane; (void)bx; (void)G; (void)gw; (void)NGW;
            pg8::Gemm g{Hb, w.wg, M, NG, DM, DM, DM}; pg8::StaticOrder S; S.init(M, NG, G, bx);
            pg8::EpiBf16N<1> E{GATES, NG, rowss_a, biasp + (size_t)l * BIAS_PER_LAYER + 8 * NB1, NBG, SEQ};
            pg8::gemm_phase<pg8::EpiBf16N<1>, pg8::StaticOrder, true, true>(ldsl + RING_OFF, g, S, E);
        }
        PHASE_END()
        CHK(9);

        PHASE_BEGIN(7)
        { const int tid = opaque_v(threadIdx.x), lane = tid & 63, bx = opaque_s((int)blockIdx.x), G = opaque_s((int)gridDim.x), gw = opaque_s(gw0), NGW = G * NWAVES; (void)lane; (void)bx; (void)G; (void)gw; (void)NGW;
            pg8::StaticOrder S; S.init(M, DM, G, bx);
            { pg8::Gemm g{OCAT, w.bna, M, DM, 256, 1024, 256}; pg8::EpiGateAcc E{Hb, DM, GATES, NG, 0, 1};
              pg8::gemm_phase<pg8::EpiGateAcc, pg8::StaticOrder, true, true>(ldsl + RING_OFF, g, S, E); }
            { pg8::Gemm g{OCAT + 256, w.bmla, M, DM, 256, 1024, 256}; pg8::EpiGateAcc E{Hb, DM, GATES, NG, 1024, 0};
              pg8::gemm_phase<pg8::EpiGateAcc, pg8::StaticOrder, true, true>(ldsl + RING_OFF, g, S, E); }
            { pg8::Gemm g{OCAT + 512, w.bgqa, M, DM, 512, 1024, 512}; pg8::EpiGateAcc E{Hb, DM, GATES, NG, 2048, 0};
              pg8::gemm_phase<pg8::EpiGateAcc, pg8::StaticOrder, true, true>(ldsl + RING_OFF, g, S, E); }
        }
        PHASE_END()
        CHK(10);

        PHASE_BEGIN(8)
        { const int tid = opaque_v(threadIdx.x), lane = tid & 63, bx = opaque_s((int)blockIdx.x), G = opaque_s((int)gridDim.x), gw = opaque_s(gw0), NGW = G * NWAVES; (void)lane; (void)bx; (void)G; (void)gw; (void)NGW;
            pg8::Gemm g{Hb, w.wout, M, DM, DM, DM, DM}; pg8::StaticOrder S; S.init(M, DM, G, bx);
            pg8::EpiResidualN E{xcur, xres, DM, mod + 2 * DM, NMOD * DM, SEQ, XG2, args.in[5] + (size_t)l * DM, mod + 4 * DM, rowss_b, (LAS float*)(ldsl + EPIX_OFF)};
            pg8::gemm_phase<pg8::EpiResidualN, pg8::StaticOrder, true, true>(ldsl + RING_OFF, g, S, E);
        }
        PHASE_END()
        CHK(11);

        PHASE_BEGIN(10)
        { const int tid = opaque_v(threadIdx.x), lane = tid & 63, bx = opaque_s((int)blockIdx.x), G = opaque_s((int)gridDim.x), gw = opaque_s(gw0), NGW = G * NWAVES; (void)lane; (void)bx; (void)G; (void)gw; (void)NGW;
            pg8::Gemm g{XG2, w.wgu, M, 2 * FFN, DM, DM, DM}; pg8::StaticOrder S; S.init(M, 2 * FFN, G, bx);
            pg8::EpiSwiGLUN E{ACT, FFN, rowss_b, biasp + (size_t)l * BIAS_PER_LAYER + 8 * (NB1 + NBG), NBGU, SEQ};
            pg8::gemm_phase<pg8::EpiSwiGLUN, pg8::StaticOrder, true, true>(ldsl + RING_OFF, g, S, E);
        }
        PHASE_END()
        CHK(13);

        PHASE_BEGIN(11)
        { const int tid = opaque_v(threadIdx.x), lane = tid & 63, bx = opaque_s((int)blockIdx.x), G = opaque_s((int)gridDim.x), gw = opaque_s(gw0), NGW = G * NWAVES; (void)lane; (void)bx; (void)G; (void)gw; (void)NGW;
            pg8::Gemm g{ACT, w.wdn, M, DM, FFN, FFN, FFN}; pg8::StaticOrder S; S.init(M, DM, G, bx);
            const bool more = (l + 1 < DEPTH); const float* modn = modp + (size_t)(more ? l + 1 : l) * BATCH * NMOD * DM;
            pg8::EpiResidualN E{xres, xres, DM, mod + 5 * DM, NMOD * DM, SEQ, more ? Hb : (bf16*)nullptr, args.in[4] + (size_t)(more ? l + 1 : l) * DM, modn + DM, rowss_a, (LAS float*)(ldsl + EPIX_OFF)};
            pg8::gemm_phase<pg8::EpiResidualN, pg8::StaticOrder, true, true>(ldsl + RING_OFF, g, S, E);
        }
        PHASE_END()
        CHK(14);
    }

    PHASE_BEGIN(12)
    { const int tid = opaque_v(threadIdx.x), lane = tid & 63, bx = opaque_s((int)blockIdx.x), G = opaque_s((int)gridDim.x), gw = opaque_s(gw0), NGW = G * NWAVES; (void)lane; (void)bx; (void)G; (void)gw; (void)NGW;
        const float* g = args.in[20];
        for (int m = gw; m < M; m += NGW) {
            float* xr = xres + (size_t)m * DM;
            f32x4 v[4]; float s = 0.f;
#pragma unroll
            for (int j = 0; j < 4; ++j) { v[j] = *(const f32x4*)(xr + 256 * j + 4 * lane); s += (v[j][0] * v[j][0] + v[j][1] * v[j][1]) + (v[j][2] * v[j][2] + v[j][3] * v[j][3]); }
            const float rstd = 1.0f / sqrtf(wave_sum(s) * (1.0f / DM) + NORM_EPS);
#pragma unroll
            for (int j = 0; j < 4; ++j) { const int c = 256 * j + 4 * lane; const f32x4 gg = *(const f32x4*)(g + c); f32x4 y;
#pragma unroll
                for (int e = 0; e < 4; ++e) y[e] = v[j][e] * rstd * gg[e];
                *(f32x4*)(xr + c) = y; }
        }
    }
    PHASE_END()
#if SELFCHECK
        xcd_barrier(bar);
        if (blockIdx.x == 0 && threadIdx.x == 0) { const unsigned fl = __hip_atomic_load((unsigned*)(ctl + CW_FLAGS), RLX_AGENT); unsigned c[12]; for (int i = 0; i < 12; ++i) c[i] = __hip_atomic_load((unsigned*)(ctl + CW_FLAGS + 2 + i), RLX_AGENT);
        unsigned tot = c[0] + c[1] + c[2] + c[3], bad_ = c[6] + c[7] + c[8] + c[9]; int d1 = (c[6] ? 1 : 0) | (c[7] ? 2 : 0) | (c[8] ? 4 : 0) | (c[9] ? 8 : 0); int d2 = tot ? (int)(9.99f * (float)bad_ / (float)tot) : 0;
        { int k1 = 0, k2 = 0; while ((c[0] >> k1) != 0) ++k1; while ((c[1] >> k2) != 0) ++k2; d1 = k1 / 2; d2 = k2 / 2; if (d1 > 9) d1 = 9; if (d2 > 9) d2 = 9; args.out[0] = 100.0f * (float)(10 * d1 + d2 + 1); return; }
        args.out[0] = 100.0f * (float)((((fl >> 15) & 1u) * 2u + ((fl >> 10) & 1u)) + 1u); }
#endif
#undef PHASE_BEGIN
#undef PHASE_END
}

constexpr int N_PHASES = 2 + DEPTH * 8 + 1;
#ifndef MK_PER_PHASE
#define MK_PER_PHASE 0
#endif

extern "C" void kernel_launch(void* const* d_in, const int* in_sizes, int n_in, void* d_out, int out_size, void* d_ws, size_t ws_size, hipStream_t stream) {
    static int grid = 0;
    if (grid == 0) {
        if (n_in != 21 || in_sizes[0] != M * DM || out_size != M * DM || ws_size < WS_END) { fprintf(stderr, "kernel_launch: unexpected shapes (n_in %d in0 %d out %d ws %zu)\n", n_in, n_in > 0 ? in_sizes[0] : -1, out_size, ws_size); grid = -1; return; }
        int dev = 0, cus = 0;
        if (hipGetDevice(&dev) != hipSuccess || hipDeviceGetAttribute(&cus, hipDeviceAttributeMultiprocessorCount, dev) != hipSuccess) { grid = -1; return; }
        if (hipFuncSetAttribute((const void*)hybrid_fwd, hipFuncAttributeMaxDynamicSharedMemorySize, LDS_BYTES) != hipSuccess) { fprintf(stderr, "kernel_launch: hipFuncSetAttribute failed\n"); grid = -1; return; }
        (void)hipGetLastError();
        grid = cus;
    }
    if (grid < 0) return;
    (void)hipMemsetAsync((char*)d_ws + WS_CTL, 0, CTL_ZERO_BYTES, stream);
    Args a{};
    for (int i = 0; i < 21; ++i) a.in[i] = (const float*)d_in[i];
    a.out = (float*)d_out; a.ws = (unsigned char*)d_ws;
#if MK_PER_PHASE
    for (int p = 0; p < N_PHASES; ++p) { a.ph_lo = p; a.ph_hi = p + 1; hipLaunchKernelGGL(hybrid_fwd, dim3(grid), dim3(NWAVES * 64), LDS_BYTES, stream, a); }
#else
#if SELFCHECK
    a.ph_lo = 0; a.ph_hi = 12;
#else
    a.ph_lo = 0; a.ph_hi = N_PHASES;
#endif
    hipLaunchKernelGGL(hybrid_fwd, dim3(grid), dim3(NWAVES * 64), LDS_BYTES, stream, a);
#endif
    const hipError_t le = hipPeekAtLastError();
    if (le != hipSuccess) fprintf(stderr, "kernel_launch: launch failed: %s\n", hipGetErrorName(le));
}
```

```cpp
#include <hip/hip_runtime.h>
#include <hip/hip_bf16.h>
#include <cstdio>
#include <cstdint>

__device__ __forceinline__ int opaque_v(int v) { asm volatile("" : "+v"(v)); return v; }
__device__ __forceinline__ int opaque_s(int v) { asm volatile("" : "+s"(v)); return v; }
namespace pg8 {
#define PG8_LAS __attribute__((address_space(3)))
typedef unsigned short bf16_t;
typedef short bf16x8 __attribute__((ext_vector_type(8)));
typedef float f32x4 __attribute__((ext_vector_type(4)));
typedef unsigned u32x4 __attribute__((ext_vector_type(4)));
constexpr int BM = 256, BK = 64, HALF = 128, HTB = HALF * BK * 2, STAGE_BYTES = 8 * HTB, NXCD = 8, WGM = 8;

__host__ __device__ __forceinline__ int lds_byte(int r, int c) { const int st = (r >> 4) * 2 + (c >> 5), rr = r & 15, cc = c & 31, ob = rr * 64 + cc * 2; return st * 1024 + (ob ^ (((ob >> 9) & 1) << 5)); }
__host__ __device__ __forceinline__ void stage_rc(int b, int& R, int& C) { const int st = b / 1024, sb = b % 1024, swz = sb ^ (((sb >> 9) & 1) << 5); R = (st >> 1) * 16 + swz / 64; C = (st & 1) * 32 + (swz % 64) / 2; }
__host__ __device__ __forceinline__ int perm32(int rho) { const int n = rho >> 4, i = rho & 15; return 8 * (i >> 2) + 4 * n + (i & 3); }

struct Unit { int pm, pn; };
struct Gemm { const bf16_t* A; const bf16_t* Bt; int M, N, K, lda, ldb; };

struct StaticOrder {
    int nM, nN, nwg, G, c;
    __host__ __device__ void init(int M, int N, int G_, int c_) { nM = M / BM; nN = N / BM; nwg = nM * nN; G = G_; c = c_; }
    __host__ __device__ bool next(int i, Unit& u) const {
        const long L = (long)i * G + c; if (L >= nwg) return false;
        int wgid = (int)L; { const int q = nwg / NXCD, r = nwg % NXCD, xcd = wgid % NXCD, off = wgid / NXCD; wgid = (xcd < r ? xcd * (q + 1) : r * (q + 1) + (xcd - r) * q) + off; }
        const int nig = WGM * nN, gid = wgid / nig, fm = gid * WGM, gsz = (nM - fm) < WGM ? (nM - fm) : WGM;
        u.pm = fm + ((wgid % nig) % gsz); u.pn = (wgid % nig) / gsz; return true;
    }
    __device__ __forceinline__ void a_ready(const Unit&) const {}
    __device__ __forceinline__ void done(const Unit&) const {}
};

typedef float f32x2_t __attribute__((ext_vector_type(2))); typedef __bf16 bf16x2_t __attribute__((ext_vector_type(2)));
__device__ __forceinline__ unsigned cvt_pk_bf16(float lo, float hi) { f32x2_t v = {lo, hi}; bf16x2_t b = __builtin_convertvector(v, bf16x2_t); return __builtin_bit_cast(unsigned, b); }
__device__ __forceinline__ float bf_lo(unsigned w) { return __uint_as_float(w << 16); }
__device__ __forceinline__ float bf_hi(unsigned w) { return __uint_as_float(w & 0xffff0000u); }
__device__ __forceinline__ float sum_x16_x32(float v) {
    auto a = __builtin_amdgcn_permlane16_swap(__float_as_uint(v), __float_as_uint(v), false, false); v = __uint_as_float(a[0]) + __uint_as_float(a[1]);
    auto b = __builtin_amdgcn_permlane32_swap(__float_as_uint(v), __float_as_uint(v), false, false); return __uint_as_float(b[0]) + __uint_as_float(b[1]);
}
__device__ __forceinline__ float sigmoidf_(float v) { return __builtin_amdgcn_rcpf(1.0f + __builtin_amdgcn_exp2f(-1.4426950408889634f * v)); }

template <int ACT  > struct EpiBf16 {
    static constexpr bool PERM = true, AFTER_DRAIN = false, HAS_MID = false; static constexpr int MID0 = 0, MID1 = 0;
    bf16_t* O; int ldc;
    __device__ __forceinline__ void operator()(const f32x4 (&acc)[2][2][4][2], const Unit& u, int wr, int wc, int fr, int fq) const {
        const int row0 = u.pm * BM + wr * 64 + fr, col0 = u.pn * BM + wc * 32 + 8 * fq;
#pragma unroll
        for (int ai = 0; ai < 2; ++ai)
#pragma unroll
            for (int m = 0; m < 4; ++m) { bf16_t* rowp = O + (size_t)(row0 + ai * HALF + m * 16) * ldc + col0;
#pragma unroll
                for (int bj = 0; bj < 2; ++bj) { f32x4 v0 = acc[ai][bj][m][0], v1 = acc[ai][bj][m][1];
                    if (ACT == 1) {
#pragma unroll
                        for (int e = 0; e < 4; ++e) { v0[e] = sigmoidf_(v0[e]); v1[e] = sigmoidf_(v1[e]); } }
                    u32x4 w; w.x = cvt_pk_bf16(v0[0], v0[1]); w.y = cvt_pk_bf16(v0[2], v0[3]); w.z = cvt_pk_bf16(v1[0], v1[1]); w.w = cvt_pk_bf16(v1[2], v1[3]);
                    *(u32x4*)(rowp + bj * HALF) = w; } }
    }
};
struct EpiGateAcc {
    static constexpr bool PERM = true, AFTER_DRAIN = false, HAS_MID = false; static constexpr int MID0 = 0, MID1 = 0;
    bf16_t* O; int ldc; const bf16_t* G; int ldg; int goff; int first;
    __device__ __forceinline__ void operator()(const f32x4 (&acc)[2][2][4][2], const Unit& u, int wr, int wc, int fr, int fq) const {
        const int row0 = u.pm * BM + wr * 64 + fr, col0 = u.pn * BM + wc * 32 + 8 * fq;
#pragma unroll
        for (int ai = 0; ai < 2; ++ai)
#pragma unroll
            for (int m = 0; m < 4; ++m) { const size_t r = (size_t)(row0 + ai * HALF + m * 16); bf16_t* rowp = O + r * ldc + col0; const bf16_t* gp = G + r * ldg + goff + col0;
#pragma unroll
                for (int bj = 0; bj < 2; ++bj) { const f32x4 v0 = acc[ai][bj][m][0], v1 = acc[ai][bj][m][1];
                    const u32x4 g = *(const u32x4*)(gp + bj * HALF);
                    float o[8];
                    o[0] = bf_lo(g.x) * v0[0]; o[1] = bf_hi(g.x) * v0[1]; o[2] = bf_lo(g.y) * v0[2]; o[3] = bf_hi(g.y) * v0[3];
                    o[4] = bf_lo(g.z) * v1[0]; o[5] = bf_hi(g.z) * v1[1]; o[6] = bf_lo(g.w) * v1[2]; o[7] = bf_hi(g.w) * v1[3];
                    if (!first) { const u32x4 p = *(const u32x4*)(rowp + bj * HALF);
                        o[0] += bf_lo(p.x); o[1] += bf_hi(p.x); o[2] += bf_lo(p.y); o[3] += bf_hi(p.y); o[4] += bf_lo(p.z); o[5] += bf_hi(p.z); o[6] += bf_lo(p.w); o[7] += bf_hi(p.w); }
                    u32x4 w; w.x = cvt_pk_bf16(o[0], o[1]); w.y = cvt_pk_bf16(o[2], o[3]); w.z = cvt_pk_bf16(o[4], o[5]); w.w = cvt_pk_bf16(o[6], o[7]);
                    *(u32x4*)(rowp + bj * HALF) = w; } }
    }
};
struct EpiSwiGLU {
    static constexpr bool PERM = true, AFTER_DRAIN = false, HAS_MID = false; static constexpr int MID0 = 0, MID1 = 0;
    bf16_t* O; int ldc;
    __device__ __forceinline__ void operator()(const f32x4 (&acc)[2][2][4][2], const Unit& u, int wr, int wc, int fr, int fq) const {
        const int row0 = u.pm * BM + wr * 64 + fr, col0 = u.pn * HALF + wc * 32 + 8 * fq;
#pragma unroll
        for (int ai = 0; ai < 2; ++ai)
#pragma unroll
            for (int m = 0; m < 4; ++m) { bf16_t* rowp = O + (size_t)(row0 + ai * HALF + m * 16) * ldc + col0;
                float o[8];
#pragma unroll
                for (int n = 0; n < 2; ++n)
#pragma unroll
                    for (int e = 0; e < 4; ++e) { const float g = acc[ai][0][m][n][e], up = acc[ai][1][m][n][e]; o[n * 4 + e] = g * sigmoidf_(g) * up; }
                u32x4 w; w.x = cvt_pk_bf16(o[0], o[1]); w.y = cvt_pk_bf16(o[2], o[3]); w.z = cvt_pk_bf16(o[4], o[5]); w.w = cvt_pk_bf16(o[6], o[7]);
                *(u32x4*)rowp = w; }
    }
};
struct EpiResidual {
    static constexpr bool PERM = false, AFTER_DRAIN = false, HAS_MID = false; static constexpr int MID0 = 0, MID1 = 0;
    const float* xin; float* xout; int ldc; const float* gvec; int gstride; int rows_per_batch;
    __device__ __forceinline__ void operator()(const f32x4 (&acc)[2][2][4][2], const Unit& u, int wr, int wc, int fr, int fq) const {
        const int row0 = u.pm * BM + wr * 64 + fr, col0 = u.pn * BM + wc * 32 + 4 * fq;
        const int b = (u.pm * BM) / rows_per_batch;
        f32x4 gv[2][2];
#pragma unroll
        for (int bj = 0; bj < 2; ++bj)
#pragma unroll
            for (int n = 0; n < 2; ++n) gv[bj][n] = *(const f32x4*)(gvec + (size_t)b * gstride + col0 + bj * HALF + n * 16);
#pragma unroll
        for (int ai = 0; ai < 2; ++ai)
#pragma unroll
            for (int m = 0; m < 4; ++m) { const size_t off = (size_t)(row0 + ai * HALF + m * 16) * ldc + col0;
#pragma unroll
                for (int bj = 0; bj < 2; ++bj)
#pragma unroll
                    for (int n = 0; n < 2; ++n) { const f32x4 xi = *(const f32x4*)(xin + off + bj * HALF + n * 16);
                        *(f32x4*)(xout + off + bj * HALF + n * 16) = xi + gv[bj][n] * acc[ai][bj][m][n]; } }
    }
};

template <int ACT  > struct EpiBf16N {
    static constexpr bool PERM = true, AFTER_DRAIN = false, HAS_MID = false; static constexpr int MID0 = 0, MID1 = 0;
    bf16_t* O; int ldc; const float* rowss; const float* bias; int nb; int rows_per_batch;
    __device__ __forceinline__ void operator()(const f32x4 (&acc)[2][2][4][2], const Unit& u, int wr, int wc, int fr, int fq) const {
        const int row0 = u.pm * BM + wr * 64 + fr, col0 = u.pn * BM + wc * 32 + 8 * fq; const float* bp = bias + (size_t)((u.pm * BM) / rows_per_batch) * nb + col0;
        f32x4 bv[2][2];
#pragma unroll
        for (int bj = 0; bj < 2; ++bj) { bv[bj][0] = *(const f32x4*)(bp + bj * HALF); bv[bj][1] = *(const f32x4*)(bp + bj * HALF + 4); }
#pragma unroll
        for (int ai = 0; ai < 2; ++ai)
#pragma unroll
            for (int m = 0; m < 4; ++m) { const int row = row0 + ai * HALF + m * 16; const f32x4 rp = *(const f32x4*)(rowss + 4 * (size_t)row); const float rs = __builtin_amdgcn_rsqf(((rp[0] + rp[1]) + (rp[2] + rp[3])) * (1.0f / 1024.0f) + 1e-6f); bf16_t* rowp = O + (size_t)row * ldc + col0;
#pragma unroll
                for (int bj = 0; bj < 2; ++bj) { f32x4 v0 = acc[ai][bj][m][0] * rs + bv[bj][0], v1 = acc[ai][bj][m][1] * rs + bv[bj][1];
                    if (ACT == 1) {
#pragma unroll
                        for (int e = 0; e < 4; ++e) { v0[e] = sigmoidf_(v0[e]); v1[e] = sigmoidf_(v1[e]); } }
                    u32x4 w; w.x = cvt_pk_bf16(v0[0], v0[1]); w.y = cvt_pk_bf16(v0[2], v0[3]); w.z = cvt_pk_bf16(v1[0], v1[1]); w.w = cvt_pk_bf16(v1[2], v1[3]);
                    *(u32x4*)(rowp + bj * HALF) = w; } }
    }
};
struct EpiSwiGLUN {
    static constexpr bool PERM = true, AFTER_DRAIN = false, HAS_MID = false; static constexpr int MID0 = 0, MID1 = 0;
    bf16_t* O; int ldc; const float* rowss; const float* bias; int nb; int rows_per_batch;
    __device__ __forceinline__ void operator()(const f32x4 (&acc)[2][2][4][2], const Unit& u, int wr, int wc, int fr, int fq) const {
        const int row0 = u.pm * BM + wr * 64 + fr, col0 = u.pn * HALF + wc * 32 + 8 * fq; const float* bp = bias + (size_t)((u.pm * BM) / rows_per_batch) * nb + u.pn * BM + wc * 32 + 8 * fq;
        f32x4 bv[2][2];
#pragma unroll
        for (int bj = 0; bj < 2; ++bj) { bv[bj][0] = *(const f32x4*)(bp + bj * HALF); bv[bj][1] = *(const f32x4*)(bp + bj * HALF + 4); }
#pragma unroll
        for (int ai = 0; ai < 2; ++ai)
#pragma unroll
            for (int m = 0; m < 4; ++m) { const int row = row0 + ai * HALF + m * 16; const f32x4 rp = *(const f32x4*)(rowss + 4 * (size_t)row); const float rs = __builtin_amdgcn_rsqf(((rp[0] + rp[1]) + (rp[2] + rp[3])) * (1.0f / 1024.0f) + 1e-6f); bf16_t* rowp = O + (size_t)row * ldc + col0;
                float o[8];
#pragma unroll
                for (int n = 0; n < 2; ++n)
#pragma unroll
                    for (int e = 0; e < 4; ++e) { const float g = acc[ai][0][m][n][e] * rs + bv[0][n][e], up = acc[ai][1][m][n][e] * rs + bv[1][n][e]; o[n * 4 + e] = g * sigmoidf_(g) * up; }
                u32x4 w; w.x = cvt_pk_bf16(o[0], o[1]); w.y = cvt_pk_bf16(o[2], o[3]); w.z = cvt_pk_bf16(o[4], o[5]); w.w = cvt_pk_bf16(o[6], o[7]);
                *(u32x4*)rowp = w; }
    }
};
template <bool XIN_F32> struct EpiResidualN {
    static constexpr bool PERM = true, AFTER_DRAIN = false, HAS_MID = false; static constexpr int MID0 = 0, MID1 = 0;
    const void* xin; bf16_t* xout; int ldc; const float* gvec; int gstride; int rows_per_batch; bf16_t* xg; const float* gn; const float* scn; float* rowss4; PG8_LAS float* lds_x;
    __device__ __forceinline__ void operator()(const f32x4 (&acc)[2][2][4][2], const Unit& u, int wr, int wc, int fr, int fq) const {
        const int row0 = u.pm * BM + wr * 64 + fr, col0 = u.pn * BM + wc * 32 + 8 * fq;
        const int b = (u.pm * BM) / rows_per_batch;
        float ss[2][4];
#pragma unroll
        for (int ai = 0; ai < 2; ++ai)
#pragma unroll
            for (int m = 0; m < 4; ++m) ss[ai][m] = 0.f;
#pragma unroll
        for (int bj = 0; bj < 2; ++bj) { const int c = col0 + bj * HALF;
            const f32x4 gv0 = *(const f32x4*)(gvec + (size_t)b * gstride + c), gv1 = *(const f32x4*)(gvec + (size_t)b * gstride + c + 4);
            f32x4 gs0 = {0.f, 0.f, 0.f, 0.f}, gs1 = {0.f, 0.f, 0.f, 0.f};
            if (xg) { gs0 = *(const f32x4*)(gn + c) * (*(const f32x4*)(scn + (size_t)b * gstride + c) + 1.0f); gs1 = *(const f32x4*)(gn + c + 4) * (*(const f32x4*)(scn + (size_t)b * gstride + c + 4) + 1.0f); }
#pragma unroll
            for (int ai = 0; ai < 2; ++ai)
#pragma unroll
                for (int m = 0; m < 4; ++m) { const size_t off = (size_t)(row0 + ai * HALF + m * 16) * ldc + c; f32x4 xi0, xi1;
                    if constexpr (XIN_F32) { xi0 = *(const f32x4*)((const float*)xin + off); xi1 = *(const f32x4*)((const float*)xin + off + 4); }
                    else { const u32x4 xw = *(const u32x4*)((const bf16_t*)xin + off); xi0 = (f32x4){bf_lo(xw.x), bf_hi(xw.x), bf_lo(xw.y), bf_hi(xw.y)}; xi1 = (f32x4){bf_lo(xw.z), bf_hi(xw.z), bf_lo(xw.w), bf_hi(xw.w)}; }
                    const f32x4 xo0 = xi0 + gv0 * acc[ai][bj][m][0], xo1 = xi1 + gv1 * acc[ai][bj][m][1];
                    { u32x4 w; w.x = cvt_pk_bf16(xo0[0], xo0[1]); w.y = cvt_pk_bf16(xo0[2], xo0[3]); w.z = cvt_pk_bf16(xo1[0], xo1[1]); w.w = cvt_pk_bf16(xo1[2], xo1[3]); *(u32x4*)(xout + off) = w; }
                    if (xg) { const f32x4 y0 = xo0 * gs0, y1 = xo1 * gs1; u32x4 w; w.x = cvt_pk_bf16(y0[0], y0[1]); w.y = cvt_pk_bf16(y0[2], y0[3]); w.z = cvt_pk_bf16(y1[0], y1[1]); w.w = cvt_pk_bf16(y1[2], y1[3]); *(u32x4*)(xg + off) = w;
                        ss[ai][m] += ((xo0[0] * xo0[0] + xo0[1] * xo0[1]) + (xo0[2] * xo0[2] + xo0[3] * xo0[3])) + ((xo1[0] * xo1[0] + xo1[1] * xo1[1]) + (xo1[2] * xo1[2] + xo1[3] * xo1[3])); } } }
        if (xg) {
#pragma unroll
            for (int ai = 0; ai < 2; ++ai)
#pragma unroll
                for (int m = 0; m < 4; ++m) { float v = sum_x16_x32(ss[ai][m]); if (fq == 0) lds_x[wc * 256 + ai * HALF + wr * 64 + m * 16 + fr] = v; }
            asm volatile("s_waitcnt lgkmcnt(0)" ::: "memory"); __builtin_amdgcn_s_barrier(); asm volatile("" ::: "memory");
            const int t = ((wr * 4 + wc) << 6) | (fq << 4) | fr;
            if (t < 256) rowss4[4 * (size_t)(u.pm * BM + t) + u.pn] = (lds_x[t] + lds_x[256 + t]) + (lds_x[512 + t] + lds_x[768 + t]);
        }
    }
};

struct EpiProj1 {
    static constexpr bool PERM = true, AFTER_DRAIN = false, HAS_MID = false; static constexpr int MID0 = 0, MID1 = 0;
    bf16_t* P1; int ld1; int c_vc; const float* rowss; const float* bias; int nb; int rows_per_batch;
    bf16_t* A2; bf16_t* KPE; bf16_t* QC; bf16_t* KC; const float* g_q; const float* g_kv; const float* g_qc; const float* g_kc; const float* tabt; const float* taba; PG8_LAS float* lds_x;
    __device__ __forceinline__ float rstd_of(int row) const { const f32x4 rp = *(const f32x4*)(rowss + 4 * (size_t)row); return __builtin_amdgcn_rsqf(((rp[0] + rp[1]) + (rp[2] + rp[3])) * (1.0f / 1024.0f) + 1e-6f); }
    __device__ __forceinline__ void operator()(const f32x4 (&acc)[2][2][4][2], const Unit& u, int wr, int wc, int fr, int fq) const {
        const int row0 = u.pm * BM + wr * 64 + fr, pn = u.pn; const float* bp = bias + (size_t)((u.pm * BM) / rows_per_batch) * nb + pn * BM + wc * 32 + 8 * fq;
#define EP1_BV(bj, n) (*(const f32x4*)(bp + (bj) * HALF + 4 * (n)))
#define EP1_PACK(v0, v1) (u32x4){cvt_pk_bf16((v0)[0], (v0)[1]), cvt_pk_bf16((v0)[2], (v0)[3]), cvt_pk_bf16((v1)[0], (v1)[1]), cvt_pk_bf16((v1)[2], (v1)[3])}
#define EP1_FENCE() asm volatile("" ::: "memory")
        if (pn < 3 || (pn == 7 && wc >= 2)) {
            const int dcol = pn < 3 ? pn * BM + wc * 32 + 8 * fq : c_vc + (wc - 2) * 64 + 8 * fq; const int bjs = pn < 3 ? HALF : 32;
#pragma unroll
            for (int ai = 0; ai < 2; ++ai)
#pragma unroll
                for (int m = 0; m < 4; ++m) { const int row = row0 + ai * HALF + m * 16; const float rs = rstd_of(row); bf16_t* rowp = P1 + (size_t)row * ld1 + dcol;
#pragma unroll
                    for (int bj = 0; bj < 2; ++bj) { const f32x4 v0 = acc[ai][bj][m][0] * rs + EP1_BV(bj, 0), v1 = acc[ai][bj][m][1] * rs + EP1_BV(bj, 1); *(u32x4*)(rowp + bj * bjs) = EP1_PACK(v0, v1); }
                    EP1_FENCE(); }
        } else if (pn == 3 || pn == 4) {
#pragma unroll
            for (int ai = 0; ai < 2; ++ai)
#pragma unroll
                for (int m = 0; m < 4; ++m) { const float rs = rstd_of(row0 + ai * HALF + m * 16); float ss = 0.f;
#pragma unroll
                    for (int bj = 0; bj < 2; ++bj) if (pn == 3 || bj == 0) { const f32x4 v0 = acc[ai][bj][m][0] * rs + EP1_BV(bj, 0), v1 = acc[ai][bj][m][1] * rs + EP1_BV(bj, 1);
                        ss += ((v0[0] * v0[0] + v0[1] * v0[1]) + (v0[2] * v0[2] + v0[3] * v0[3])) + ((v1[0] * v1[0] + v1[1] * v1[1]) + (v1[2] * v1[2] + v1[3] * v1[3])); }
                    ss = sum_x16_x32(ss); if (fq == 0) lds_x[wc * 256 + ai * HALF + wr * 64 + m * 16 + fr] = ss; EP1_FENCE(); }
            asm volatile("s_waitcnt lgkmcnt(0)" ::: "memory"); __builtin_amdgcn_s_barrier(); asm volatile("" ::: "memory");
            const float invn = pn == 3 ? (1.0f / 256.0f) : (1.0f / 128.0f); const float* gp = (pn == 3 ? g_q : g_kv) + wc * 32 + 8 * fq; const int a2c = (pn == 3 ? 0 : 256) + wc * 32 + 8 * fq;
#pragma unroll
            for (int ai = 0; ai < 2; ++ai)
#pragma unroll
                for (int m = 0; m < 4; ++m) { const int rl = ai * HALF + wr * 64 + m * 16 + fr; const int row = u.pm * BM + rl; float rs = rstd_of(row); asm volatile("" : "+v"(rs));
                    const float r2 = __builtin_amdgcn_rsqf(((lds_x[rl] + lds_x[256 + rl]) + (lds_x[512 + rl] + lds_x[768 + rl])) * invn + 1e-6f);
                    { const f32x4 v0 = (acc[ai][0][m][0] * rs + EP1_BV(0, 0)) * r2 * *(const f32x4*)(gp), v1 = (acc[ai][0][m][1] * rs + EP1_BV(0, 1)) * r2 * *(const f32x4*)(gp + 4); *(u32x4*)(A2 + (size_t)row * 384 + a2c) = EP1_PACK(v0, v1); }
                    if (pn == 3) { const f32x4 v0 = (acc[ai][1][m][0] * rs + EP1_BV(1, 0)) * r2 * *(const f32x4*)(gp + HALF), v1 = (acc[ai][1][m][1] * rs + EP1_BV(1, 1)) * r2 * *(const f32x4*)(gp + HALF + 4); *(u32x4*)(A2 + (size_t)row * 384 + a2c + HALF) = EP1_PACK(v0, v1); }
                    else if (wc == 0) {
                        const int t = row % rows_per_batch; const f32x4 c = *(const f32x4*)(tabt + (size_t)t * 32 + 4 * fq), sn = *(const f32x4*)(tabt + (size_t)t * 32 + 16 + 4 * fq);
                        const f32x4 x1 = acc[ai][1][m][0] * rs + EP1_BV(1, 0), x2 = acc[ai][1][m][1] * rs + EP1_BV(1, 1); const f32x4 y1 = x1 * c - x2 * sn, y2 = x2 * c + x1 * sn;
                        typedef unsigned u32x2 __attribute__((ext_vector_type(2)));
                        *(u32x2*)(KPE + (size_t)row * 32 + 4 * fq) = (u32x2){cvt_pk_bf16(y1[0], y1[1]), cvt_pk_bf16(y1[2], y1[3])};
                        *(u32x2*)(KPE + (size_t)row * 32 + 16 + 4 * fq) = (u32x2){cvt_pk_bf16(y2[0], y2[1]), cvt_pk_bf16(y2[2], y2[3])}; }
                    EP1_FENCE(); }
        } else {
            const bool isq = pn != 7; const float* g = (isq ? g_qc : g_kc) + 4 * fq; bf16_t* dst = isq ? QC + ((pn - 5) * 4 + wc) * 64 + 8 * fq : KC + wc * 64 + 8 * fq; const int ldd = isq ? 512 : 128;
#pragma unroll
            for (int ai = 0; ai < 2; ++ai)
#pragma unroll
                for (int m = 0; m < 4; ++m) { const int row = row0 + ai * HALF + m * 16; const int t = row % rows_per_batch; const float rs = rstd_of(row);
                    f32x4 v[2][2]; float ss = 0.f;
#pragma unroll
                    for (int bj = 0; bj < 2; ++bj)
#pragma unroll
                        for (int n = 0; n < 2; ++n) { v[bj][n] = acc[ai][bj][m][n] * rs + EP1_BV(bj, n); ss += (v[bj][n][0] * v[bj][n][0] + v[bj][n][1] * v[bj][n][1]) + (v[bj][n][2] * v[bj][n][2] + v[bj][n][3] * v[bj][n][3]); }
                    ss = sum_x16_x32(ss);
                    const float r2 = __builtin_amdgcn_rsqf(ss * (1.0f / 64.0f) + 1e-6f);
                    f32x4 o[2][2];
#pragma unroll
                    for (int n = 0; n < 2; ++n) { const int pos = n == 0 ? (t >> 6) : (t & 63); const f32x4 c = *(const f32x4*)(taba + (size_t)pos * 32 + 4 * fq), sn = *(const f32x4*)(taba + (size_t)pos * 32 + 16 + 4 * fq);
                        const f32x4 y1 = v[0][n] * r2 * *(const f32x4*)(g + 32 * n), y2 = v[1][n] * r2 * *(const f32x4*)(g + 32 * n + 16); o[0][n] = y1 * c - y2 * sn; o[1][n] = y2 * c + y1 * sn; }
#pragma unroll
                    for (int bj = 0; bj < 2; ++bj) *(u32x4*)(dst + (size_t)row * ldd + bj * 32) = EP1_PACK(o[bj][0], o[bj][1]);
                    EP1_FENCE(); }
        }
#undef EP1_BV
#undef EP1_PACK
#undef EP1_FENCE
    }
};

struct EpiMerge {
    static constexpr bool PERM = true, AFTER_DRAIN = false, HAS_MID = true; static constexpr int MID0 = 4, MID1 = 8;
    bf16_t* O; int ldc; const bf16_t* G; int ldg;
    __device__ __forceinline__ void mid(f32x4 (&acc)[2][2][4][2], const Unit& u, int which, int wr, int wc, int fr, int fq) const {
        const int row0 = u.pm * BM + wr * 64 + fr, col0 = u.pn * BM + wc * 32 + 8 * fq;
#pragma unroll
        for (int ai = 0; ai < 2; ++ai)
#pragma unroll
            for (int m = 0; m < 4; ++m) { const bf16_t* gp = G + (size_t)(row0 + ai * HALF + m * 16) * ldg + which * 1024 + col0;
#pragma unroll
                for (int bj = 0; bj < 2; ++bj) { const u32x4 gn = *(const u32x4*)(gp + bj * HALF), gd = *(const u32x4*)(gp + 1024 + bj * HALF);
                    f32x4 r0, r1;
                    r0[0] = bf_lo(gn.x) * __builtin_amdgcn_rcpf(fmaxf(bf_lo(gd.x), 1e-30f)); r0[1] = bf_hi(gn.x) * __builtin_amdgcn_rcpf(fmaxf(bf_hi(gd.x), 1e-30f));
                    r0[2] = bf_lo(gn.y) * __builtin_amdgcn_rcpf(fmaxf(bf_lo(gd.y), 1e-30f)); r0[3] = bf_hi(gn.y) * __builtin_amdgcn_rcpf(fmaxf(bf_hi(gd.y), 1e-30f));
                    r1[0] = bf_lo(gn.z) * __builtin_amdgcn_rcpf(fmaxf(bf_lo(gd.z), 1e-30f)); r1[1] = bf_hi(gn.z) * __builtin_amdgcn_rcpf(fmaxf(bf_hi(gd.z), 1e-30f));
                    r1[2] = bf_lo(gn.w) * __builtin_amdgcn_rcpf(fmaxf(bf_lo(gd.w), 1e-30f)); r1[3] = bf_hi(gn.w) * __builtin_amdgcn_rcpf(fmaxf(bf_hi(gd.w), 1e-30f));
                    acc[ai][bj][m][0] *= r0; acc[ai][bj][m][1] *= r1; }
                asm volatile("" ::: "memory"); }
    }
    __device__ __forceinline__ void operator()(const f32x4 (&acc)[2][2][4][2], const Unit& u, int wr, int wc, int fr, int fq) const {
        const int row0 = u.pm * BM + wr * 64 + fr, col0 = u.pn * BM + wc * 32 + 8 * fq;
#pragma unroll
        for (int ai = 0; ai < 2; ++ai)
#pragma unroll
            for (int m = 0; m < 4; ++m) { const size_t r = (size_t)(row0 + ai * HALF + m * 16); bf16_t* rowp = O + r * ldc + col0; const bf16_t* gp = G + r * ldg + 2048 + col0;
#pragma unroll
                for (int bj = 0; bj < 2; ++bj) { const f32x4 v0 = acc[ai][bj][m][0], v1 = acc[ai][bj][m][1]; const u32x4 g = *(const u32x4*)(gp + bj * HALF);
                    u32x4 w; w.x = cvt_pk_bf16(bf_lo(g.x) * v0[0], bf_hi(g.x) * v0[1]); w.y = cvt_pk_bf16(bf_lo(g.y) * v0[2], bf_hi(g.y) * v0[3]);
                    w.z = cvt_pk_bf16(bf_lo(g.z) * v1[0], bf_hi(g.z) * v1[1]); w.w = cvt_pk_bf16(bf_lo(g.w) * v1[2], bf_hi(g.w) * v1[3]);
                    *(u32x4*)(rowp + bj * HALF) = w; }
                asm volatile("" ::: "memory"); }
    }
};

template <class Epi, class Sched, bool ALIGN_EPI = false, bool SP2 = false>
__device__ __forceinline__ void gemm_phase(PG8_LAS unsigned char* lds, const Gemm g, const Sched& S, const Epi& E) {
    const int tid = opaque_v(threadIdx.x), wid = __builtin_amdgcn_readfirstlane(tid >> 6), lane = tid & 63, wr = wid >> 2, wc = wid & 3, fr = lane & 15, fq = lane >> 4;
    const int K = g.K, nt = K / BK;
    unsigned voffA[2], voffB[2];
#pragma unroll
    for (int i = 0; i < 2; ++i) { int R, C; stage_rc(tid * 16 + i * 8192, R, C); const int Rb = Epi::PERM ? ((R & ~31) + perm32(R & 31)) : R;
        voffA[i] = (unsigned)(R * g.lda + C) * 2u; voffB[i] = (unsigned)(Rb * g.ldb + C) * 2u; }
    const size_t kstep = (size_t)(BK * 2);
    const size_t hstepA = (size_t)HALF * g.lda * 2, hstepB = (size_t)HALF * g.ldb * 2;
    const size_t tstepA = 2 * hstepA, tstepB = 2 * hstepB;
    const unsigned ldsw = (unsigned)wid * 1024u;
    const int aoff = lds_byte(wr * 64 + fr, fq * 8), boff = lds_byte(wc * 32 + fr, fq * 8);
#define PG8_SA(b, h) (((b) * 2 + (h)) * HTB)
#define PG8_SB(b, h) ((4 + (b) * 2 + (h)) * HTB)
#define PG8_STAGE(bufoff, gbase, voff) do { _Pragma("unroll") for (int _i = 0; _i < 2; ++_i) \
        __builtin_amdgcn_global_load_lds((const unsigned*)((const char*)(gbase) + (voff)[_i]), (PG8_LAS unsigned*)(lds + (bufoff) + ldsw + _i * 8192), 16, 0, 0); } while (0)
#define PG8_LDA(dst, b, h) do { _Pragma("unroll") for (int m = 0; m < 4; ++m) _Pragma("unroll") for (int k = 0; k < 2; ++k) dst[m][k] = *(const PG8_LAS bf16x8*)(lds + PG8_SA(b, h) + aoff + m * 2048 + k * 1024); } while (0)
#define PG8_LDB(dst, b, h) do { _Pragma("unroll") for (int n = 0; n < 2; ++n) _Pragma("unroll") for (int k = 0; k < 2; ++k) dst[n][k] = *(const PG8_LAS bf16x8*)(lds + PG8_SB(b, h) + boff + n * 2048 + k * 1024); } while (0)
#define PG8_MMA(ai, bj, At, Bt) do { __builtin_amdgcn_s_setprio(1); _Pragma("unroll") for (int m = 0; m < 4; ++m) _Pragma("unroll") for (int n = 0; n < 2; ++n) _Pragma("unroll") for (int k = 0; k < 2; ++k) \
        acc[ai][bj][m][n] = __builtin_amdgcn_mfma_f32_16x16x32_bf16(Bt[n][k], At[m][k], acc[ai][bj][m][n], 0, 0, 0); __builtin_amdgcn_s_setprio(0); } while (0)
#define PG8_WAIT_V(n) asm volatile("s_waitcnt vmcnt(" #n ")" ::: "memory")
#define PG8_WAIT_L(n) asm volatile("s_waitcnt lgkmcnt(" #n ")" ::: "memory")
#define PG8_BAR __builtin_amdgcn_s_barrier()
#define PG8_SCHED __builtin_amdgcn_sched_barrier(0)
    Unit cur, nxt; int ui = 0;
    if (!S.next(0, cur)) return;
    f32x4 acc[2][2][4][2];
#pragma unroll
    for (int a = 0; a < 2; ++a)
#pragma unroll
        for (int b = 0; b < 2; ++b)
#pragma unroll
            for (int m = 0; m < 4; ++m)
#pragma unroll
                for (int n = 0; n < 2; ++n) acc[a][b][m][n] = (f32x4){0.f, 0.f, 0.f, 0.f};
    bf16x8 At[4][2], B0[2][2], B1[2][2];
    const char* cA = (const char*)g.A + (size_t)cur.pm * tstepA; const char* cB = (const char*)g.Bt + (size_t)cur.pn * tstepB;
    S.a_ready(cur);
    if constexpr (SP2) {
        PG8_STAGE(PG8_SB(0, 0), cB, voffB); PG8_STAGE(PG8_SB(0, 1), cB + hstepB, voffB); PG8_STAGE(PG8_SA(0, 0), cA, voffA); PG8_STAGE(PG8_SA(0, 1), cA + hstepA, voffA);
        if (wr == 1) PG8_BAR;
        PG8_WAIT_V(2); PG8_BAR;
        PG8_STAGE(PG8_SB(1, 0), cB + kstep, voffB); PG8_STAGE(PG8_SA(1, 0), cA + kstep, voffA); PG8_STAGE(PG8_SB(1, 1), cB + hstepB + kstep, voffB);
        PG8_WAIT_V(6); PG8_BAR;
    } else {
        PG8_STAGE(PG8_SB(0, 0), cB, voffB); PG8_STAGE(PG8_SA(0, 0), cA, voffA); PG8_STAGE(PG8_SB(0, 1), cB + hstepB, voffB); PG8_STAGE(PG8_SA(0, 1), cA + hstepA, voffA);
        if (wr == 1) PG8_BAR;
        PG8_WAIT_V(4); PG8_BAR;
        PG8_STAGE(PG8_SB(1, 0), cB + kstep, voffB); PG8_STAGE(PG8_SA(1, 0), cA + kstep, voffA); PG8_STAGE(PG8_SB(1, 1), cB + hstepB + kstep, voffB);
        PG8_WAIT_V(6); PG8_BAR;
    }
    for (;;) {
        const bool has_next = S.next(ui + 1, nxt);
        const char* nA = has_next ? (const char*)g.A + (size_t)nxt.pm * tstepA : cA; const char* nB = has_next ? (const char*)g.Bt + (size_t)nxt.pn * tstepB : cB;
        int t = 0;
#pragma unroll 1
        for (int seg = 0; seg < (Epi::HAS_MID ? 3 : 1); ++seg) {
        const int tend = Epi::HAS_MID ? (seg == 0 ? Epi::MID0 : seg == 1 ? Epi::MID1 : nt) : nt;
        if constexpr (Epi::HAS_MID) { if (seg > 0) E.mid(acc, cur, seg - 1, wr, wc, fr, fq); }
#pragma unroll 1
        for (; t < tend; t += 2) {
            const bool last = (t == nt - 2);
            const char* a1 = cA + (size_t)(t + 1) * kstep;
            const char* a2 = last ? nA : cA + (size_t)(t + 2) * kstep; const char* b2 = last ? nB : cB + (size_t)(t + 2) * kstep;
            const char* a3 = a2 + kstep; const char* b3 = b2 + kstep;
            if (last && has_next) S.a_ready(nxt);
            if constexpr (SP2) {
            PG8_LDB(B0, 0, 0); PG8_LDB(B1, 0, 1); PG8_SCHED; PG8_LDA(At, 0, 0); PG8_STAGE(PG8_SA(1, 1), a1 + hstepA, voffA);
            PG8_WAIT_V(8); PG8_WAIT_L(0); PG8_BAR; PG8_MMA(0, 0, At, B0); PG8_MMA(0, 1, At, B1); PG8_BAR; PG8_SCHED;
            PG8_LDA(At, 0, 1); PG8_STAGE(PG8_SB(0, 0), b2, voffB); PG8_STAGE(PG8_SB(0, 1), b2 + hstepB, voffB); PG8_STAGE(PG8_SA(0, 0), a2, voffA);
            PG8_WAIT_V(8); PG8_WAIT_L(0); PG8_BAR; PG8_MMA(1, 0, At, B0); PG8_MMA(1, 1, At, B1); PG8_BAR; PG8_SCHED;
            PG8_LDB(B0, 1, 0); PG8_LDB(B1, 1, 1); PG8_SCHED; PG8_LDA(At, 1, 0); PG8_STAGE(PG8_SA(0, 1), a2 + hstepA, voffA);
            PG8_WAIT_V(8); PG8_WAIT_L(0); PG8_BAR; PG8_MMA(0, 0, At, B0); PG8_MMA(0, 1, At, B1); PG8_BAR; PG8_SCHED;
            PG8_LDA(At, 1, 1); PG8_STAGE(PG8_SB(1, 0), b3, voffB); PG8_STAGE(PG8_SB(1, 1), b3 + hstepB, voffB); PG8_STAGE(PG8_SA(1, 0), a3, voffA);
            PG8_WAIT_V(8); PG8_WAIT_L(0); PG8_BAR; PG8_MMA(1, 0, At, B0); PG8_MMA(1, 1, At, B1); PG8_BAR; PG8_SCHED;
            } else {
            PG8_LDB(B0, 0, 0); PG8_SCHED; PG8_LDA(At, 0, 0); PG8_STAGE(PG8_SA(1, 1), a1 + hstepA, voffA);
            PG8_WAIT_L(8); PG8_BAR; PG8_WAIT_L(0); PG8_MMA(0, 0, At, B0); PG8_BAR; PG8_SCHED;
            PG8_LDB(B1, 0, 1); PG8_STAGE(PG8_SB(0, 0), b2, voffB);
            PG8_BAR; PG8_WAIT_L(0); PG8_MMA(0, 1, At, B1); PG8_BAR;
            PG8_LDA(At, 0, 1); PG8_STAGE(PG8_SA(0, 0), a2, voffA);
            PG8_BAR; PG8_WAIT_L(0); PG8_MMA(1, 0, At, B0); PG8_BAR; PG8_SCHED;
            PG8_STAGE(PG8_SB(0, 1), b2 + hstepB, voffB);
            PG8_WAIT_V(6); PG8_BAR; PG8_MMA(1, 1, At, B1); PG8_BAR;
            PG8_LDB(B0, 1, 0); PG8_SCHED; PG8_LDA(At, 1, 0); PG8_STAGE(PG8_SA(0, 1), a2 + hstepA, voffA);
            PG8_WAIT_L(8); PG8_BAR; PG8_WAIT_L(0); PG8_MMA(0, 0, At, B0); PG8_BAR; PG8_SCHED;
            PG8_LDB(B1, 1, 1); PG8_STAGE(PG8_SB(1, 0), b3, voffB);
            PG8_BAR; PG8_WAIT_L(0); PG8_MMA(0, 1, At, B1); PG8_BAR;
            PG8_LDA(At, 1, 1); PG8_STAGE(PG8_SA(1, 0), a3, voffA);
            PG8_BAR; PG8_WAIT_L(0); PG8_MMA(1, 0, At, B0); PG8_BAR; PG8_SCHED;
            PG8_STAGE(PG8_SB(1, 1), b3 + hstepB, voffB);
            PG8_WAIT_V(6); PG8_BAR; PG8_MMA(1, 1, At, B1); PG8_BAR;
            }
        }
        }
        if constexpr (ALIGN_EPI) { if (wr == 0) PG8_BAR; }
        if constexpr (!Epi::AFTER_DRAIN) { E(acc, cur, wr, wc, fr, fq); S.done(cur); }
        if (!has_next) break;
#pragma unroll
        for (int a = 0; a < 2; ++a)
#pragma unroll
            for (int b = 0; b < 2; ++b)
#pragma unroll
                for (int m = 0; m < 4; ++m)
#pragma unroll
                    for (int n = 0; n < 2; ++n) acc[a][b][m][n] = (f32x4){0.f, 0.f, 0.f, 0.f};
        cur = nxt; cA = nA; cB = nB; ++ui;
        if constexpr (ALIGN_EPI) { if (wr == 1) PG8_BAR; }
    }
    PG8_WAIT_V(0);
    if constexpr (!ALIGN_EPI) { if (wr == 0) PG8_BAR; }
    PG8_BAR;
#undef PG8_SA
#undef PG8_SB
#undef PG8_STAGE
#undef PG8_LDA
#undef PG8_LDB
#undef PG8_MMA
#undef PG8_WAIT_V
#undef PG8_WAIT_L
#undef PG8_BAR
#undef PG8_SCHED
}
}

namespace att {
using bf16x8 = __attribute__((ext_vector_type(8))) short;
using s16x4  = __attribute__((ext_vector_type(4))) short;
using f32x16 = __attribute__((ext_vector_type(16))) float;
using f32x4  = __attribute__((ext_vector_type(4))) float;
using u32x4  = __attribute__((ext_vector_type(4))) unsigned;
typedef unsigned short bf16_t;
constexpr int NW = 8, QBLK = 32, KVBLK = 64;
constexpr int SHM_V = 8192, SHM_KN = 8192, SHM_KR = 4096;
constexpr int OFF_V = 0, OFF_KN = 2 * SHM_V, OFF_KR = OFF_KN + 2 * SHM_KN, OFF_WS = OFF_KR + 2 * SHM_KR, OFF_BIAS = OFF_WS + NW * 64 * 4 + 1024  , LDS_BYTES = OFF_BIAS + 15 * 32 * 4 + 1024;
#define ATT_SBAR() __builtin_amdgcn_sched_barrier(0)
__device__ __forceinline__ int crow(int r, int hi) { return (r & 3) + 8 * (r >> 2) + 4 * hi; }
__device__ __forceinline__ unsigned cvtpk(float lo, float hi) { return pg8::cvt_pk_bf16(lo, hi); }
__device__ __forceinline__ float bf2f(short s) { return __uint_as_float(((unsigned)(unsigned short)s) << 16); }
__device__ __forceinline__ int kn_off(int row, int chunk) { return row * 128 + ((chunk ^ ((row >> 1) & 7)) << 4); }
__device__ __forceinline__ int kr_off(int row, int chunk) { return row * 64 + ((chunk ^ ((row >> 2) & 3)) << 4); }
__device__ __forceinline__ int v_st(int k, int c) { const int kk = (k & ~0xC) | ((k & 4) << 1) | ((k & 8) >> 1); return ((kk >> 3) * 2 + (c >> 5)) * 512 + ((kk & 7) * 32 + (c & 31)) * 2; }
__device__ __forceinline__ int v_rd_base(int lane) { return ((lane & 3) << 3) | (((lane >> 2) & 3) << 6) | (((lane >> 4) & 1) << 5) | (((lane >> 5) & 1) << 8); }
constexpr int v_rd_off(int d0, int ks, int half) { return d0 * 512 + ks * 2048 + half * 1024; }
template <int OFF> __device__ __forceinline__ s16x4 tr_read(int vb) { s16x4 r; asm volatile("ds_read_b64_tr_b16 %0, %1 offset:%2" : "=&v"(r) : "v"(vb), "i"(OFF) : "memory"); return r; }

template <int D0> __device__ __forceinline__ void pv_one(f32x16& od, int vb, bf16x8 pa0, bf16x8 pa1, bf16x8 pa2, bf16x8 pa3) {
  const s16x4 l0 = tr_read<v_rd_off(D0, 0, 0)>(vb), h0 = tr_read<v_rd_off(D0, 0, 1)>(vb), l1 = tr_read<v_rd_off(D0, 1, 0)>(vb), h1 = tr_read<v_rd_off(D0, 1, 1)>(vb);
  const s16x4 l2 = tr_read<v_rd_off(D0, 2, 0)>(vb), h2 = tr_read<v_rd_off(D0, 2, 1)>(vb), l3 = tr_read<v_rd_off(D0, 3, 0)>(vb), h3 = tr_read<v_rd_off(D0, 3, 1)>(vb);
  asm volatile("s_waitcnt lgkmcnt(0)" ::: "memory"); ATT_SBAR();
#define ATT_PK(L, H) (bf16x8){L[0], L[1], L[2], L[3], H[0], H[1], H[2], H[3]}
  od = __builtin_amdgcn_mfma_f32_32x32x16_bf16(pa0, ATT_PK(l0, h0), od, 0, 0, 0);
  od = __builtin_amdgcn_mfma_f32_32x32x16_bf16(pa1, ATT_PK(l1, h1), od, 0, 0, 0);
  od = __builtin_amdgcn_mfma_f32_32x32x16_bf16(pa2, ATT_PK(l2, h2), od, 0, 0, 0);
  od = __builtin_amdgcn_mfma_f32_32x32x16_bf16(pa3, ATT_PK(l3, h3), od, 0, 0, 0);
#undef ATT_PK
}

template <int DKR> struct Cst { static constexpr float SCALE = DKR ? 0.10206207261596577f : 0.125f; static constexpr float C = SCALE * 1.4426950408889634f; };

template <int DKR> __device__ __forceinline__ void partialSM(f32x16& p0, f32x16& p1, float& m_reg, float& alpha) {
  constexpr float C = Cst<DKR>::C;
  float pmax = p0[0];
#pragma unroll
  for (int r = 1; r < 16; ++r) pmax = fmaxf(pmax, p0[r]);
#pragma unroll
  for (int r = 0; r < 16; ++r) pmax = fmaxf(pmax, p1[r]);
  { auto rr = __builtin_amdgcn_permlane32_swap(__float_as_uint(pmax), __float_as_uint(pmax), false, false);
    pmax = fmaxf(__uint_as_float(rr[0]), __uint_as_float(rr[1])); }
  float mn;
  if (__builtin_expect(__all(pmax <= m_reg), 1)) { mn = m_reg; alpha = 1.f; }
  else { mn = fmaxf(m_reg, pmax); alpha = __builtin_amdgcn_exp2f((m_reg - mn) * C); m_reg = mn; }
  const float mnC = -mn * C;
#pragma unroll
  for (int r = 0; r < 16; ++r) p0[r] = fmaf(p0[r], C, mnC);
#pragma unroll
  for (int r = 0; r < 16; ++r) p1[r] = fmaf(p1[r], C, mnC);
#pragma unroll
  for (int r = 0; r < 16; ++r) p0[r] = __builtin_amdgcn_exp2f(p0[r]);
}
__device__ __forceinline__ void finishSM(f32x16& p0, f32x16& p1, float alpha, float& l_reg, bf16x8& pa0, bf16x8& pa1, bf16x8& pa2, bf16x8& pa3) {
#pragma unroll
  for (int r = 0; r < 16; ++r) p1[r] = __builtin_amdgcn_exp2f(p1[r]);
  float ps = 0;
#pragma unroll
  for (int r = 0; r < 16; ++r) ps += p0[r];
#pragma unroll
  for (int r = 0; r < 16; ++r) ps += p1[r];
  { auto rr = __builtin_amdgcn_permlane32_swap(__float_as_uint(ps), __float_as_uint(ps), false, false);
    ps = __uint_as_float(rr[0]) + __uint_as_float(rr[1]); }
  l_reg = l_reg * alpha + ps;
#define ATT_PK4(P, BASE, OUT) do { unsigned a0 = cvtpk(P[BASE + 0], P[BASE + 1]), a1 = cvtpk(P[BASE + 2], P[BASE + 3]);   \
    unsigned b0 = cvtpk(P[BASE + 4], P[BASE + 5]), b1 = cvtpk(P[BASE + 6], P[BASE + 7]);                              \
    auto r0 = __builtin_amdgcn_permlane32_swap(a0, b0, false, false); auto r1 = __builtin_amdgcn_permlane32_swap(a1, b1, false, false); \
    u32x4 w = {r0[0], r1[0], r0[1], r1[1]}; OUT = *reinterpret_cast<bf16x8*>(&w); } while (0)
  ATT_PK4(p0, 0, pa0); ATT_PK4(p0, 8, pa1); ATT_PK4(p1, 0, pa2); ATT_PK4(p1, 8, pa3);
#undef ATT_PK4
}
template <int DKR> __device__ __forceinline__ void qkt(f32x16& p0, f32x16& p1, const char* Kn, const char* Kr, const bf16x8* qr, int r32, int hi) {
  p0 = f32x16{}; p1 = f32x16{};
#pragma unroll
  for (int d0 = 0; d0 < 4; ++d0) {
    const bf16x8 b0 = *reinterpret_cast<const bf16x8*>(Kn + kn_off(r32, d0 * 2 + hi));
    const bf16x8 b1 = *reinterpret_cast<const bf16x8*>(Kn + kn_off(32 + r32, d0 * 2 + hi));
    p0 = __builtin_amdgcn_mfma_f32_32x32x16_bf16(b0, qr[d0], p0, 0, 0, 0);
    p1 = __builtin_amdgcn_mfma_f32_32x32x16_bf16(b1, qr[d0], p1, 0, 0, 0); }
  if constexpr (DKR != 0) {
#pragma unroll
    for (int d0 = 0; d0 < 2; ++d0) {
      const bf16x8 b0 = *reinterpret_cast<const bf16x8*>(Kr + kr_off(r32, d0 * 2 + hi));
      const bf16x8 b1 = *reinterpret_cast<const bf16x8*>(Kr + kr_off(32 + r32, d0 * 2 + hi));
      p0 = __builtin_amdgcn_mfma_f32_32x32x16_bf16(b0, qr[4 + d0], p0, 0, 0, 0);
      p1 = __builtin_amdgcn_mfma_f32_32x32x16_bf16(b1, qr[4 + d0], p1, 0, 0, 0); }
  }
}

__device__ __forceinline__ void na_mask(f32x16& p0, f32x16& p1, const char* brow_b, int a, bool tile_ok) {
  const float NEG = -INFINITY;
#pragma unroll
  for (int r = 0; r < 16; ++r) { const int cr = (r & 3) + 8 * (r >> 2);
    const float b0 = *reinterpret_cast<const float*>(brow_b + cr * 4), b1 = *reinterpret_cast<const float*>(brow_b + (cr + 32) * 4);
    const bool v0 = tile_ok && ((unsigned)(cr + a) < 16u), v1 = tile_ok && ((unsigned)(cr + 32 + a) < 16u);
    p0[r] = v0 ? fmaf(8.0f, b0, p0[r]) : NEG; p1[r] = v1 ? fmaf(8.0f, b1, p1[r]) : NEG; }
}
template <int DKR, bool NA = false>
__device__ __forceinline__ void attn_unit(const bf16_t* __restrict__ Qb, int ldq, const bf16_t* __restrict__ Kn, int ldk, const bf16_t* __restrict__ Kr, int ldkr,
                                          const bf16_t* __restrict__ Vh, int ldv, bf16_t* __restrict__ Ob, int ldo, int seq, const float* __restrict__ qtab, char* lds,
                                          const float* __restrict__ rpb_h = nullptr, int r0 = 0, int kstart = 0) {
  const int tid = opaque_v(threadIdx.x), wid = tid >> 6, lane = tid & 63, r32 = lane & 31, hi = lane >> 5;
  char* V_lds = lds + OFF_V; char* KN_lds = lds + OFF_KN; char* KR_lds = lds + OFF_KR;
  float* ws = (float*)(lds + OFF_WS) + wid * 64; float* li_l = ws; float* al_l = ws + 32;
  float m_reg = -1e30f, l_reg = 0; f32x16 o[2] = {}; bf16x8 qr[DKR ? 6 : 4];
  const bf16_t* Qw = Qb + (long)(wid * QBLK + r32) * ldq + hi * 8;
#pragma unroll
  for (int d0 = 0; d0 < 4; ++d0) qr[d0] = *reinterpret_cast<const bf16x8*>(Qw + d0 * 16);
  if constexpr (DKR != 0) {
    const bf16x8 x1 = *reinterpret_cast<const bf16x8*>(Qw + 64), x2 = *reinterpret_cast<const bf16x8*>(Qw + 80);
    const float* tb = qtab + (long)(wid * QBLK + r32) * 32 + hi * 8;
    const f32x4 c0 = *(const f32x4*)(tb), c1 = *(const f32x4*)(tb + 4), s0 = *(const f32x4*)(tb + 16), s1 = *(const f32x4*)(tb + 20);
    float y1[8], y2[8];
#pragma unroll
    for (int j = 0; j < 8; ++j) { const float a = bf2f(x1[j]), b = bf2f(x2[j]); const float cc = j < 4 ? c0[j & 3] : c1[j & 3], ss = j < 4 ? s0[j & 3] : s1[j & 3];
      y1[j] = a * cc - b * ss; y2[j] = b * cc + a * ss; }
    u32x4 w1 = {cvtpk(y1[0], y1[1]), cvtpk(y1[2], y1[3]), cvtpk(y1[4], y1[5]), cvtpk(y1[6], y1[7])};
    u32x4 w2 = {cvtpk(y2[0], y2[1]), cvtpk(y2[2], y2[3]), cvtpk(y2[4], y2[5]), cvtpk(y2[6], y2[7])};
    qr[4] = *reinterpret_cast<bf16x8*>(&w1); qr[5] = *reinterpret_cast<bf16x8*>(&w2);
  }
  const int sr = tid >> 3, sc8 = tid & 7, knst = kn_off(sr, sc8), vst = v_st(sr, sc8 * 8);
  const int rr_ = (tid >> 2) & 63, rc_ = tid & 3, krst = kr_off(rr_, rc_);
  const bool do_kr = (DKR != 0) && (tid < 256);
  const int vb0 = (int)(uintptr_t)V_lds + v_rd_base(lane);
  bf16x8 sK0, sV0, sR0, sK1, sV1, sR1;
  sR0 = bf16x8{}; sR1 = bf16x8{};
#define ATT_SLOAD(SK, SV, SR, k0) do { SK = *reinterpret_cast<const bf16x8*>(Kn + (long)((k0) + sr) * ldk + sc8 * 8); SV = *reinterpret_cast<const bf16x8*>(Vh + (long)((k0) + sr) * ldv + sc8 * 8); \
    if (do_kr) SR = *reinterpret_cast<const bf16x8*>(Kr + (long)((k0) + rr_) * ldkr + rc_ * 8); } while (0)
#define ATT_SWRITE(b, SK, SV, SR) do { *(bf16x8*)(V_lds + (b) * SHM_V + vst) = SV; *(bf16x8*)(KN_lds + (b) * SHM_KN + knst) = SK; \
    if (do_kr) *(bf16x8*)(KR_lds + (b) * SHM_KR + krst) = SR; } while (0)
#define ATT_RESC(a) do { if (__any((a) < 1.f)) { if (hi == 0) al_l[r32] = (a); asm volatile("s_waitcnt lgkmcnt(0)" ::: "memory"); \
    _Pragma("unroll") for (int d = 0; d < 2; ++d) _Pragma("unroll") for (int r = 0; r < 16; ++r) o[d][r] *= al_l[crow(r, hi)]; } } while (0)
  f32x16 pA0, pA1, pB0, pB1; float alA, alB; bf16x8 pa0, pa1, pa2, pa3; const int NT = seq / KVBLK;
  const int na_r = r0 + (wid >> 1), na_rs = min(max(na_r - 4, 0), 24), na_qc = (wid & 1) * 32 + r32, na_ws = min(max(na_qc - 8, 0), 48);
  const int na_a = 4 * hi - na_ws; const char* na_b0 = lds + OFF_BIAS + (4 * hi - na_qc + 15) * 4;
  if constexpr (NA) { float* bt = (float*)(lds + OFF_BIAS); if (tid < 15 * 32) bt[tid] = ((tid & 31) < 31) ? rpb_h[(tid >> 5) * 31 + (tid & 31)] : 0.f; }
#define ATT_NAMASK(P0, P1, t) do { if constexpr (NA) { const int kr_ = kstart + (t); const bool ok_ = (unsigned)(kr_ - na_rs) < 8u; const int ro_ = min(max(kr_ - na_r + 7, 0), 14); \
    na_mask(P0, P1, na_b0 + ro_ * 128, na_a, ok_); } } while (0)
  ATT_SLOAD(sK0, sV0, sR0, 0); ATT_SWRITE(0, sK0, sV0, sR0); __syncthreads();
  qkt<DKR>(pA0, pA1, KN_lds, KR_lds, qr, r32, hi); ATT_NAMASK(pA0, pA1, 0); partialSM<DKR>(pA0, pA1, m_reg, alA);
  ATT_SLOAD(sK1, sV1, sR1, KVBLK); if (2 < NT) ATT_SLOAD(sK0, sV0, sR0, 2 * KVBLK);
  ATT_SWRITE(1, sK1, sV1, sR1); __syncthreads();
  for (int j = 1; j + 1 < NT; j += 2) {
    ATT_SBAR(); qkt<DKR>(pB0, pB1, KN_lds + SHM_KN, KR_lds + SHM_KR, qr, r32, hi); ATT_NAMASK(pB0, pB1, j);
    finishSM(pA0, pA1, alA, l_reg, pa0, pa1, pa2, pa3); ATT_SBAR();
    ATT_SLOAD(sK1, sV1, sR1, (j + 2) * KVBLK); ATT_SBAR();
    pv_one<0>(o[0], vb0, pa0, pa1, pa2, pa3); pv_one<1>(o[1], vb0, pa0, pa1, pa2, pa3); partialSM<DKR>(pB0, pB1, m_reg, alB);
    __syncthreads(); ATT_SWRITE(0, sK0, sV0, sR0);
    ATT_RESC(alB); __syncthreads();
    ATT_SBAR(); qkt<DKR>(pA0, pA1, KN_lds, KR_lds, qr, r32, hi); ATT_NAMASK(pA0, pA1, j + 1);
    finishSM(pB0, pB1, alB, l_reg, pa0, pa1, pa2, pa3); ATT_SBAR();
    if (j + 3 < NT) ATT_SLOAD(sK0, sV0, sR0, (j + 3) * KVBLK); ATT_SBAR();
    pv_one<0>(o[0], vb0 + SHM_V, pa0, pa1, pa2, pa3); pv_one<1>(o[1], vb0 + SHM_V, pa0, pa1, pa2, pa3); partialSM<DKR>(pA0, pA1, m_reg, alA);
    __syncthreads(); ATT_SWRITE(1, sK1, sV1, sR1);
    ATT_RESC(alA); __syncthreads();
  }
  ATT_SBAR(); qkt<DKR>(pB0, pB1, KN_lds + SHM_KN, KR_lds + SHM_KR, qr, r32, hi); ATT_NAMASK(pB0, pB1, NT - 1);
  finishSM(pA0, pA1, alA, l_reg, pa0, pa1, pa2, pa3); ATT_SBAR();
  pv_one<0>(o[0], vb0, pa0, pa1, pa2, pa3); pv_one<1>(o[1], vb0, pa0, pa1, pa2, pa3); partialSM<DKR>(pB0, pB1, m_reg, alB);
  __syncthreads(); ATT_RESC(alB);
  finishSM(pB0, pB1, alB, l_reg, pa0, pa1, pa2, pa3); ATT_SBAR();
  pv_one<0>(o[0], vb0 + SHM_V, pa0, pa1, pa2, pa3); pv_one<1>(o[1], vb0 + SHM_V, pa0, pa1, pa2, pa3);
  if (hi == 0) li_l[r32] = l_reg; asm volatile("s_waitcnt lgkmcnt(0)" ::: "memory");
  float rli[16];
#pragma unroll
  for (int r = 0; r < 16; ++r) rli[r] = __builtin_amdgcn_rcpf(li_l[crow(r, hi)]);
  bf16_t* Ow = Ob + (long)(wid * QBLK) * ldo;
#pragma unroll
  for (int r = 0; r < 16; ++r) { const int orow = crow(r, hi);
#pragma unroll
    for (int d0 = 0; d0 < 2; ++d0) { const float v = o[d0][r] * rli[r]; Ow[(long)orow * ldo + d0 * 32 + r32] = (bf16_t)(cvtpk(v, v) & 0xffffu); } }
  __syncthreads();
#undef ATT_SLOAD
#undef ATT_SWRITE
#undef ATT_RESC
#undef ATT_NAMASK
}
#undef ATT_SBAR
}

constexpr int NWAVES = 8;
constexpr int BATCH = 8, SEQ = 2048, DM = 1024, DEPTH = 2, M = BATCH * SEQ;
constexpr int GRID_W = 64, NROWS = SEQ / GRID_W;
constexpr int IN_COLS = 5024, N1 = 2048  , NG = 3072, N1_USED = 1952;
constexpr int FFN = 2816, NMOD = 6;
constexpr float NORM_EPS = 1e-6f;
constexpr int C_QA = 0, C_KA = 256, C_VA = 512, C_VC = 768;
constexpr int C_CQ = 768, C_CKV = 1024, C_KR = 1152, C_QC = 1184, C_KC = 1696;

constexpr size_t MiB = 1u << 20;
constexpr size_t WS_CTL = 0, CTL_ZERO_BYTES = 64 * 1024;
constexpr size_t WS_MOD = 1 * MiB;
constexpr size_t WS_TABT = WS_MOD + 512 * 1024;
constexpr size_t WS_TABA = WS_TABT + 256 * 1024;
constexpr size_t WS_W = 2 * MiB;
constexpr size_t W_1 = 0, W_G = W_1 + (size_t)N1 * DM * 2, W_2 = W_G + (size_t)NG * DM * 2, W_BNA = W_2 + (size_t)1024 * 384 * 2, W_BMLA = W_BNA + (size_t)1024 * 256 * 2,
                 W_BGQA = W_BMLA + (size_t)1024 * 256 * 2, W_OUT = W_BGQA + (size_t)1024 * 512 * 2, W_GU = W_OUT + (size_t)1024 * 1024 * 2, W_DN = W_GU + (size_t)2 * FFN * DM * 2,
                 LAYER_W_BYTES = W_DN + (size_t)DM * FFN * 2;
static_assert(LAYER_W_BYTES == 32768000, "weights per layer");
constexpr size_t WS_ROWSS_A = 64 * MiB + 512 * 1024, WS_ROWSS_B = WS_ROWSS_A + 256 * 1024;
constexpr size_t WS_BIAS = WS_ROWSS_B + 256 * 1024;
constexpr int NB1 = N1, NBG = NG, NBGU = 2 * FFN, BIAS_PER_LAYER = 8 * (NB1 + NBG + NBGU);
constexpr size_t OUT_OCAT = 0, OUT_A2 = 0, OUT_XG2 = 32 * MiB;
constexpr size_t WS_XB = 98 * MiB;
constexpr size_t WS_H = 66 * MiB;
constexpr size_t WS_P1 = 130 * MiB;
constexpr size_t WS_KPE = 194 * MiB;
constexpr size_t WS_QC = 195 * MiB;
constexpr size_t WS_KC = 211 * MiB;
constexpr size_t WS_P2 = 215 * MiB;
constexpr size_t WS_OCAT_UNUSED = 0;
constexpr size_t WS_A2_UNUSED = 0;
constexpr size_t WS_GATES = 130 * MiB;
constexpr size_t WS_ACT = 130 * MiB;
constexpr size_t WS_END = 247 * MiB;
static_assert(WS_W + 2 * LAYER_W_BYTES <= WS_ROWSS_A && WS_BIAS + (size_t)2 * BIAS_PER_LAYER * 4 <= WS_H && WS_H + (size_t)M * DM * 2 <= WS_XB && WS_XB + (size_t)M * DM * 2 <= WS_P1 && WS_P2 + (size_t)M * DM * 2 <= WS_END && WS_GATES + (size_t)M * NG * 2 <= WS_END && WS_ACT + (size_t)M * FFN * 2 <= WS_END, "ws map");
constexpr int CW_BAR = 4096;

constexpr int RING_OFF = 0, RING_BYTES = 131072;
constexpr int LDSCTL_OFF = RING_BYTES, MISC_OFF = LDSCTL_OFF + 320;
constexpr int EPIX_OFF = 132096;
constexpr int LDS_BYTES = 147456;

#define GAS __attribute__((address_space(1)))
#define LAS __attribute__((address_space(3)))
typedef unsigned short bf16;
typedef unsigned v4u __attribute__((ext_vector_type(4)));
typedef unsigned v2u __attribute__((ext_vector_type(2)));
typedef float f32x4 __attribute__((ext_vector_type(4)));
typedef short bf16x8 __attribute__((ext_vector_type(8)));
typedef GAS unsigned gu32;
#define RLX_AGENT __ATOMIC_RELAXED, __HIP_MEMORY_SCOPE_AGENT
#define LDS_WAIT() asm volatile("s_waitcnt lgkmcnt(0)" ::: "memory")
__device__ __forceinline__ unsigned f2bf(float f) { unsigned u = __builtin_bit_cast(unsigned, f); return (u + 0x7fffu + ((u >> 16) & 1u)) >> 16; }
__device__ __forceinline__ unsigned pk2(float lo, float hi) { return f2bf(lo) | (f2bf(hi) << 16); }
__device__ __forceinline__ float bflo(unsigned w) { return __uint_as_float(w << 16); }
__device__ __forceinline__ float bfhi(unsigned w) { return __uint_as_float(w & 0xffff0000u); }
__device__ __forceinline__ float bf1(bf16 s) { return __uint_as_float(((unsigned)s) << 16); }

#define XB_TMO      128
#define XB_XCNT(j)  (256  + 64 * (j))
#define XB_XSUB(j)  (1280 + 64 * (j))
#define XB_XGEN(j)  (2304 + 64 * (j))
#define XB_TOP      3328
#define XB_TOPGEN   3392
#define XCD_BAR_WORDS 3456
#define XB_SPIN_CAP (1u << 18)
__device__ __forceinline__ unsigned xb_ld(unsigned* p)              { return __hip_atomic_load(p, __ATOMIC_RELAXED, __HIP_MEMORY_SCOPE_AGENT); }
__device__ __forceinline__ unsigned xb_add(unsigned* p, unsigned v) { return __hip_atomic_fetch_add(p, v, __ATOMIC_RELAXED, __HIP_MEMORY_SCOPE_AGENT); }
__device__ __forceinline__ unsigned xb_xcc_id() { return (unsigned)__builtin_amdgcn_s_getreg((3 << 11) | 20) & 0xFu; }
#define XB_SPIN(cond, bar) do { unsigned _sp = 0; while (cond) { __builtin_amdgcn_s_sleep(1); \
    if ((++_sp & 255u) == 0u) { if (xb_ld(&(bar)[XB_TMO])) break; if (_sp > XB_SPIN_CAP) { atomicAdd(&(bar)[XB_TMO], 1u); break; } } } } while (0)
struct XcdBarrier { unsigned* bar; unsigned x; volatile LAS unsigned* st; };
__device__ __forceinline__ XcdBarrier xcd_barrier_post(unsigned* bar, volatile LAS unsigned* st) {
    XcdBarrier b; b.bar = bar; b.x = xb_xcc_id(); b.st = st;
    if (threadIdx.x == 0) (void)xb_add(&bar[XB_XCNT(b.x)], 1u);
    return b;
}
__device__ __forceinline__ void xcd_barrier_complete(unsigned* bar, unsigned x, unsigned& nloc, unsigned& nx) {
    const unsigned G = gridDim.x * gridDim.y * gridDim.z;
    unsigned sum, cnt, mine, sp = 0u;
    for (;;) {
        sum = 0u; cnt = 0u; mine = 0u;
#pragma unroll
        for (unsigned j = 0; j < 16; ++j) { const unsigned c = xb_ld(&bar[XB_XCNT(j)]); sum += c; cnt += (c > 0u) ? 1u : 0u; mine = (j == x) ? c : mine; }
        if (sum == G) break;
        __builtin_amdgcn_s_sleep(1);
        if ((++sp & 255u) == 0u) { if (xb_ld(&bar[XB_TMO])) break; if (sp > XB_SPIN_CAP) { atomicAdd(&bar[XB_TMO], 1u); break; } }
    }
    nloc = mine > 0u ? mine : 1u; nx = cnt > 0u ? cnt : 1u;
}
__device__ __forceinline__ void xcd_barrier(const XcdBarrier& b) {
    asm volatile("s_waitcnt vmcnt(0)" ::: "memory");
    __syncthreads();
    if (threadIdx.x == 0) {
        GAS unsigned* barg = (GAS unsigned*)b.bar; asm volatile("" : "+s"(barg)); unsigned* bar = (unsigned*)barg;
        __builtin_amdgcn_s_waitcnt(0);
        unsigned nloc = b.st[0], nx = b.st[1];
        if (nloc == 0u) { xcd_barrier_complete(bar, b.x, nloc, nx); b.st[0] = nloc; b.st[1] = nx; }
        const unsigned old = xb_add(&bar[XB_XSUB(b.x)], 1u);
        const unsigned gen = old / nloc;
        if (old + 1u == (gen + 1u) * nloc) {
            __builtin_amdgcn_fence(__ATOMIC_RELEASE, "agent");
            asm volatile("s_waitcnt vmcnt(0)" ::: "memory");
            const unsigned og = xb_add(&bar[XB_TOP], 1u);
            const unsigned tg = og / nx;
            if (og + 1u == (tg + 1u) * nx) xb_add(&bar[XB_TOPGEN], 1u);
            else XB_SPIN(xb_ld(&bar[XB_TOPGEN]) == tg, bar);
            __builtin_amdgcn_fence(__ATOMIC_ACQUIRE, "agent");
            xb_add(&bar[XB_XGEN(b.x)], 1u);
            asm volatile("s_waitcnt vmcnt(0)" ::: "memory");
        } else {
            XB_SPIN(xb_ld(&bar[XB_XGEN(b.x)]) == gen, bar);
            __builtin_amdgcn_fence(__ATOMIC_ACQUIRE, "agent");
            asm volatile("s_waitcnt vmcnt(0)" ::: "memory");
        }
    }
    __syncthreads();
}

struct Args { const float* in[21]; float* out; unsigned char* ws; int ph_lo, ph_hi; };
struct LayerW { bf16 *w1, *wg, *w2, *bna, *bmla, *bgqa, *wout, *wgu, *wdn; };
__device__ __forceinline__ LayerW layer_w(unsigned char* ws, int l) {
    unsigned char* b = ws + WS_W + (size_t)l * LAYER_W_BYTES; LayerW w;
    w.w1 = (bf16*)(b + W_1); w.wg = (bf16*)(b + W_G); w.w2 = (bf16*)(b + W_2); w.bna = (bf16*)(b + W_BNA); w.bmla = (bf16*)(b + W_BMLA); w.bgqa = (bf16*)(b + W_BGQA);
    w.wout = (bf16*)(b + W_OUT); w.wgu = (bf16*)(b + W_GU); w.wdn = (bf16*)(b + W_DN); return w;
}
__device__ __forceinline__ float wave_sum(float v) {
#pragma unroll
    for (int o = 1; o < 64; o <<= 1) v += __shfl_xor(v, o);
    return v;
}
__device__ __forceinline__ void sincos_d(double x, double& s, double& c) {
    const double k = __builtin_rint(x * 0.15915494309189535);
    double r = __builtin_fma(-k, 6.283185307179586, x); r = __builtin_fma(-k, 2.4492935982947064e-16, r);
    const double r2 = r * r; double tc = 1.0, ts = 1.0, cs = 1.0, ss = 1.0;
#pragma unroll 1
    for (int n = 1; n <= 15; ++n) { tc *= -r2 / (double)((2 * n - 1) * (2 * n)); cs += tc; ts *= -r2 / (double)((2 * n) * (2 * n + 1)); ss += ts; }
    s = r * ss; c = cs;
}
__device__ __forceinline__ float inv_freq(int i) {
    const float q[4] = {1.0f, 0.5623413251903491f, 0.31622776601683794f, 0.17782794100389228f};
    const float p[4] = {1.0f, 0.1f, 0.01f, 0.001f};
    float a = (i & 3) == 0 ? q[0] : (i & 3) == 1 ? q[1] : (i & 3) == 2 ? q[2] : q[3];
    float b = (i >> 2) == 0 ? p[0] : (i >> 2) == 1 ? p[1] : (i >> 2) == 2 ? p[2] : p[3];
    return (float)((double)a * (double)b);
}

template <class RowPtr>
__device__ __forceinline__ void transpose_item(const float* W, int N, int k0, int n0, const RowPtr& rp, LAS float* scr, int lane) {
#pragma unroll 8
    for (int i = 0; i < 32; ++i) { const int kk = 2 * i + (lane >> 5); scr[kk * 33 + (lane & 31)] = W[(size_t)(k0 + kk) * N + n0 + (lane & 31)]; }
    LDS_WAIT(); asm volatile("" ::: "memory");
    const int c = lane & 7;
#pragma unroll
    for (int j = 0; j < 4; ++j) { const int n = (lane >> 3) + 8 * j; const LAS float* s = scr + (8 * c) * 33 + n;
        v4u o; o.x = pk2(s[0 * 33], s[1 * 33]); o.y = pk2(s[2 * 33], s[3 * 33]); o.z = pk2(s[4 * 33], s[5 * 33]); o.w = pk2(s[6 * 33], s[7 * 33]);
        *(GAS v4u*)(rp(n0 + n) + k0 + 8 * c) = o; }
    LDS_WAIT(); asm volatile("" ::: "memory");
}
struct RpPlain { bf16* base; int ld; int roff; int koff; __device__ __forceinline__ bf16* operator()(int n) const { return base + (size_t)(n + roff) * ld + koff; } };
struct RpWin { bf16* w1; bf16* wg; __device__ __forceinline__ bf16* operator()(int n) const {
    if (n >= N1_USED) return wg + (size_t)(n - N1_USED) * DM;
    int row;
    if (n < 1152) row = n;
    else if (n < 1184) { const int j = n - 1152, nn = j >> 4, i = j & 15; row = 1024 + 128 + 8 * (i >> 2) + 4 * nn + (i & 3); }
    else if (n < 1824) { const bool kc = n >= 1696; const int j = kc ? n - 1696 : n - 1184, head = j >> 6, d = j & 63, nn = d >> 5, bj = (d >> 4) & 1, i = d & 15, r = 8 * (i >> 2) + 4 * nn + (i & 3);
        const int tile = kc ? 7 : 5 + (head >> 2), wc = kc ? head : (head & 3); row = tile * 256 + bj * 128 + wc * 32 + r; }
    else { const int j = n - 1824, head = j >> 6, d = j & 63; row = 7 * 256 + (d >> 5) * 128 + (2 + head) * 32 + (d & 31); }
    return w1 + (size_t)row * DM; } };
struct RpGU { bf16* base; __device__ __forceinline__ bf16* operator()(int n) const { const int j = n < FFN ? n : n - FFN; return base + (size_t)(256 * (j >> 7) + (n < FFN ? 0 : 128) + (j & 127)) * DM; } };


#define SELFCHECK 0
#define CHK(ST) do { } while (0)

__global__ void __launch_bounds__(NWAVES * 64, 2) hybrid_fwd(Args args) {
    extern __shared__ __attribute__((aligned(16))) unsigned char lds[];
    LAS unsigned char* ldsl = (LAS unsigned char*)lds;
    volatile LAS unsigned* MISC = (volatile LAS unsigned*)(ldsl + MISC_OFF);
    const int tid = threadIdx.x, lane = tid & 63, wave = __builtin_amdgcn_readfirstlane(tid >> 6);
    const int G = gridDim.x; const int bx = blockIdx.x; const int vcu = (G % 8 == 0) ? (bx % 8) * (G / 8) + bx / 8 : bx;
    if (G != 256) return;
    unsigned char* ws = args.ws;
    gu32* ctl = (gu32*)(ws + WS_CTL);
    for (int u = tid; u < (LDS_BYTES - LDSCTL_OFF) / 4; u += NWAVES * 64) ((LAS unsigned*)(ldsl + LDSCTL_OFF))[u] = 0u;
    __syncthreads();
    XcdBarrier bar = xcd_barrier_post((unsigned*)(ctl + CW_BAR), MISC + 8);
    const int gw0 = vcu * NWAVES + wave;
    const int lo = args.ph_lo, hi = args.ph_hi; int ph = 0;
#ifndef PROBE_MASK
#define PROBE_MASK 0
#endif
#define PHASE_BEGIN(ID) if (lo <= ph && ph < hi) { for (int rep_ = 0; rep_ < 1 + (int)(((PROBE_MASK >> (ID)) & 1) && !((ID) == 8 && ph > 11)); ++rep_) { if (rep_) xcd_barrier(bar);
#define PHASE_END() } if (SELFCHECK || ph + 1 < hi) xcd_barrier(bar); } ++ph;

    float* modp = (float*)(ws + WS_MOD); float* tabt = (float*)(ws + WS_TABT); float* taba = (float*)(ws + WS_TABA);
    bf16* Hb = (bf16*)(ws + WS_H); bf16* P1 = (bf16*)(ws + WS_P1); bf16* KPE = (bf16*)(ws + WS_KPE); bf16* QC = (bf16*)(ws + WS_QC); bf16* KC = (bf16*)(ws + WS_KC);
    bf16* P2 = (bf16*)(ws + WS_P2); bf16* OCAT = (bf16*)((unsigned char*)args.out + OUT_OCAT); bf16* A2 = (bf16*)((unsigned char*)args.out + OUT_A2); bf16* GATES = (bf16*)(ws + WS_GATES); bf16* ACT = (bf16*)(ws + WS_ACT);
    const float* x_in = args.in[0]; float* xres = args.out; (void)xres;
    float* rowss_a = (float*)(ws + WS_ROWSS_A); float* rowss_b = (float*)(ws + WS_ROWSS_B); float* biasp = (float*)(ws + WS_BIAS); bf16* XG2 = (bf16*)((unsigned char*)args.out + OUT_XG2); bf16* XB = (bf16*)(ws + WS_XB);

    PHASE_BEGIN(0)
    { const int tid = opaque_v(threadIdx.x), lane = tid & 63, bx = opaque_s((int)blockIdx.x), G = opaque_s((int)gridDim.x), gw = opaque_s(gw0), NGW = G * NWAVES; (void)lane; (void)bx; (void)G; (void)gw; (void)NGW;
        LAS float* sc = (LAS float*)(ldsl + RING_OFF);
        const float* cin = args.in[1];
        for (int i = tid; i < BATCH * DM; i += NWAVES * 64) { const int b = i / DM, k = i % DM; const float v = cin[i]; sc[k * 8 + b] = v / (1.0f + __expf(-v)); }
        __syncthreads();
        if (bx < 192) {
            const int l = bx / 96, cg = bx % 96; const float* W = args.in[2] + (size_t)l * DM * (NMOD * DM) + cg * 64 + lane + (size_t)(wave * 128) * (NMOD * DM);
            LAS float* part = (LAS float*)(ldsl + RING_OFF + 102400);
            float acc[8];
#pragma unroll
            for (int b = 0; b < 8; ++b) acc[b] = 0.f;
#pragma unroll 16
            for (int k = 0; k < 128; ++k) { const float w = W[(size_t)k * (NMOD * DM)]; const int kk = wave * 128 + k; const f32x4 s0 = *(const LAS f32x4*)(sc + kk * 8), s1 = *(const LAS f32x4*)(sc + kk * 8 + 4);
                acc[0] += s0[0] * w; acc[1] += s0[1] * w; acc[2] += s0[2] * w; acc[3] += s0[3] * w; acc[4] += s1[0] * w; acc[5] += s1[1] * w; acc[6] += s1[2] * w; acc[7] += s1[3] * w; }
#pragma unroll
            for (int b = 0; b < 8; ++b) part[(wave * 8 + b) * 64 + lane] = acc[b];
            __syncthreads();
            {
                const int b = tid >> 6; float v = args.in[3][(size_t)l * NMOD * DM + cg * 64 + lane];
#pragma unroll
                for (int w8 = 0; w8 < 8; ++w8) v += part[(w8 * 8 + b) * 64 + lane];
                modp[((size_t)l * BATCH + b) * (NMOD * DM) + cg * 64 + lane] = v;
            }
        }
        for (int i = bx * NWAVES * 64 + tid; i < (SEQ + 64) * 16; i += G * NWAVES * 64) {
            const int p = i >> 4, fi = i & 15; const int pos = p < SEQ ? p : p - SEQ; float* dst = p < SEQ ? tabt + (size_t)p * 32 : taba + (size_t)(p - SEQ) * 32;
            const float ang = (float)pos * inv_freq(fi); double s, c; sincos_d((double)ang, s, c); dst[fi] = (float)c; dst[16 + fi] = (float)s;
        }
        LAS float* scr = (LAS float*)(ldsl + RING_OFF + 32768 + wave * 8704);
        for (int l = 0; l < DEPTH; ++l) {
            const LayerW w = layer_w(ws, l);
            constexpr int I_IN = 16 * 157, I_UQ = 4 * 12, I_UKV = 2 * 16, I_BNA = 4 * 32, I_BMLA = 4 * 32, I_BGQA = 8 * 32, I_OUT = 16 * 32, I_GU = 16 * 176, I_DN = 44 * 32;
            constexpr int NITEMS = I_IN + I_UQ + I_UKV + I_BNA + I_BMLA + I_BGQA + I_OUT + I_GU + I_DN;
            for (int it = gw; it < NITEMS; it += NGW) {
                int r = it;
                if (r < I_IN)  { transpose_item(args.in[6] + (size_t)l * DM * IN_COLS, IN_COLS, 64 * (r / 157), 32 * (r % 157), RpWin{w.w1, w.wg}, scr, lane); continue; } r -= I_IN;
                if (r < I_UQ)  { transpose_item(args.in[10] + (size_t)l * 256 * 384, 384, 64 * (r / 12), 32 * (r % 12), RpPlain{w.w2, 384, 0, 0}, scr, lane); continue; } r -= I_UQ;
                if (r < I_UKV) { transpose_item(args.in[11] + (size_t)l * 128 * 512, 512, 64 * (r / 16), 32 * (r % 16), RpPlain{w.w2, 384, 384, 256}, scr, lane); continue; } r -= I_UKV;
                if (r < I_BNA) { transpose_item(args.in[14] + (size_t)l * 256 * 1024, 1024, 64 * (r / 32), 32 * (r % 32), RpPlain{w.bna, 1024, 0, 0}, scr, lane); continue; } r -= I_BNA;
                if (r < I_BMLA){ transpose_item(args.in[15] + (size_t)l * 256 * 1024, 1024, 64 * (r / 32), 32 * (r % 32), RpPlain{w.bna, 1024, 0, 256}, scr, lane); continue; } r -= I_BMLA;
                if (r < I_BGQA){ transpose_item(args.in[16] + (size_t)l * 512 * 1024, 1024, 64 * (r / 32), 32 * (r % 32), RpPlain{w.bna, 1024, 0, 512}, scr, lane); continue; } r -= I_BGQA;
                if (r < I_OUT) { transpose_item(args.in[17] + (size_t)l * 1024 * 1024, 1024, 64 * (r / 32), 32 * (r % 32), RpPlain{w.wout, 1024, 0, 0}, scr, lane); continue; } r -= I_OUT;
                if (r < I_GU)  { transpose_item(args.in[18] + (size_t)l * DM * 2 * FFN, 2 * FFN, 64 * (r / 176), 32 * (r % 176), RpGU{w.wgu}, scr, lane); continue; } r -= I_GU;
                transpose_item(args.in[19] + (size_t)l * FFN * DM, DM, 64 * (r / 32), 32 * (r % 32), RpPlain{w.wdn, FFN, 0, 0}, scr, lane);
            }
            const v4u z = {0u, 0u, 0u, 0u};
            for (int i = bx * NWAVES * 64 + tid; i < 96 * 128; i += G * NWAVES * 64) *(GAS v4u*)(w.w1 + (size_t)(1024 + 160) * DM + (size_t)i * 8) = z;
            for (int i = bx * NWAVES * 64 + tid; i < 1024 * 48; i += G * NWAVES * 64) { const int row = i / 48, ch = i % 48, col = ch * 8;
                const bool zero = row < 384 ? (col >= 256) : row < 896 ? (col < 256) : true;
                if (zero) *(GAS v4u*)(w.w2 + (size_t)row * 384 + col) = z; }
        }
    }
    PHASE_END()
    { const int l_chk = 0; (void)l_chk; CHK(0); CHK(1); }

    PHASE_BEGIN(1)
    { const int tid = opaque_v(threadIdx.x), lane = tid & 63, bx = opaque_s((int)blockIdx.x), G = opaque_s((int)gridDim.x), gw = opaque_s(gw0), NGW = G * NWAVES; (void)lane; (void)bx; (void)G; (void)gw; (void)NGW;
        constexpr int ROWS_PER_LAYER = NB1 + NBG + NBGU, TASKS_PER_LAYER = ROWS_PER_LAYER / 16;
        for (int tk = gw; tk < DEPTH * TASKS_PER_LAYER; tk += NGW) {
            const int l = tk / TASKS_PER_LAYER, r0 = (tk % TASKS_PER_LAYER) * 16, n = lane & 15, q = lane >> 4; const LayerW w = layer_w(ws, l);
            const bf16* wrow; float* bout; int which, nb;
            if (r0 < NB1) { wrow = w.w1 + (size_t)(r0 + n) * DM; bout = biasp + (size_t)l * BIAS_PER_LAYER + r0 + n; which = 0; nb = NB1; }
            else if (r0 < NB1 + NBG) { wrow = w.wg + (size_t)(r0 - NB1 + n) * DM; bout = biasp + (size_t)l * BIAS_PER_LAYER + 8 * NB1 + (r0 - NB1) + n; which = 0; nb = NBG; }
            else { wrow = w.wgu + (size_t)(r0 - NB1 - NBG + n) * DM; bout = biasp + (size_t)l * BIAS_PER_LAYER + 8 * (NB1 + NBG) + (r0 - NB1 - NBG) + n; which = 3; nb = NBGU; }
            const float* sp = modp + ((size_t)l * BATCH + (n & 7)) * NMOD * DM + which * DM + 8 * q; wrow += 8 * q;
            f32x4 acc = {0.f, 0.f, 0.f, 0.f};
#pragma unroll 8
            for (int k = 0; k < DM; k += 32) { const bf16x8 bfrag = *(const bf16x8*)(wrow + k); const f32x4 s0 = *(const f32x4*)(sp + k), s1 = *(const f32x4*)(sp + k + 4);
                v4u aw; aw.x = pk2(s0[0], s0[1]); aw.y = pk2(s0[2], s0[3]); aw.z = pk2(s1[0], s1[1]); aw.w = pk2(s1[2], s1[3]); if (n >= 8) aw = (v4u){0u, 0u, 0u, 0u};
                acc = __builtin_amdgcn_mfma_f32_16x16x32_bf16(__builtin_bit_cast(bf16x8, aw), bfrag, acc, 0, 0, 0); }
            if (q < 2) {
#pragma unroll
                for (int e = 0; e < 4; ++e) bout[(size_t)(4 * q + e) * nb] = acc[e]; }
        }
        {
            const float* g = args.in[4]; const float* mod0 = modp;
            for (int m = gw; m < M; m += NGW) {
                const int b = m / SEQ; const float* xr = x_in + (size_t)m * DM; const float* scl = mod0 + (size_t)b * NMOD * DM + DM;
                f32x4 v[4]; float sq = 0.f;
#pragma unroll
                for (int j = 0; j < 4; ++j) { v[j] = *(const f32x4*)(xr + 256 * j + 4 * lane); sq += (v[j][0] * v[j][0] + v[j][1] * v[j][1]) + (v[j][2] * v[j][2] + v[j][3] * v[j][3]); }
                sq = wave_sum(sq); if (lane == 0) *(f32x4*)(rowss_a + 4 * (size_t)m) = (f32x4){sq, 0.f, 0.f, 0.f};
#pragma unroll
                for (int j = 0; j < 4; ++j) { const int c = 256 * j + 4 * lane; const f32x4 gg = *(const f32x4*)(g + c), s1 = *(const f32x4*)(scl + c);
                    v2u o; o.x = pk2(v[j][0] * gg[0] * (1.0f + s1[0]), v[j][1] * gg[1] * (1.0f + s1[1])); o.y = pk2(v[j][2] * gg[2] * (1.0f + s1[2]), v[j][3] * gg[3] * (1.0f + s1[3])); *(v2u*)(Hb + (size_t)m * DM + c) = o; }
            }
        }
    }
    PHASE_END()

    for (int l = 0; l < DEPTH; ++l) {
        const LayerW w = layer_w(ws, l);
        const float* mod = modp + (size_t)l * BATCH * NMOD * DM;
        const int l_chk = l; (void)l_chk;

        PHASE_BEGIN(2)
        { const int tid = opaque_v(threadIdx.x), lane = tid & 63, bx = opaque_s((int)blockIdx.x), G = opaque_s((int)gridDim.x), gw = opaque_s(gw0), NGW = G * NWAVES; (void)lane; (void)bx; (void)G; (void)gw; (void)NGW;
            pg8::Gemm g{Hb, w.w1, M, N1, DM, DM, DM}; pg8::StaticOrder S; S.init(M, N1, G, bx);
            pg8::EpiProj1 E{P1, N1, C_VC, rowss_a, biasp + (size_t)l * BIAS_PER_LAYER, NB1, SEQ, A2, KPE, QC, KC, args.in[8] + (size_t)l * 256, args.in[9] + (size_t)l * 128,
                            args.in[12] + (size_t)l * 64, args.in[13] + (size_t)l * 64, tabt, taba, (LAS float*)(ldsl + EPIX_OFF)};
            pg8::gemm_phase<pg8::EpiProj1, pg8::StaticOrder, true, true>(ldsl + RING_OFF, g, S, E);
        }
        PHASE_END()
        CHK(3);

        PHASE_BEGIN(4)
        { const int tid = opaque_v(threadIdx.x), lane = tid & 63, bx = opaque_s((int)blockIdx.x), G = opaque_s((int)gridDim.x), gw = opaque_s(gw0), NGW = G * NWAVES; (void)lane; (void)bx; (void)G; (void)gw; (void)NGW;
            pg8::Gemm g{A2, w.w2, M, 1024, 384, 384, 384}; pg8::StaticOrder S; S.init(M, 1024, G, bx);
            pg8::EpiBf16<0> E{P2, 1024};
            pg8::gemm_phase<pg8::EpiBf16<0>, pg8::StaticOrder, true, true>(ldsl + RING_OFF, g, S, E);
        }
        PHASE_END()
        CHK(5);

        PHASE_BEGIN(5)
        { const int tid = opaque_v(threadIdx.x), lane = tid & 63, bx = opaque_s((int)blockIdx.x), G = opaque_s((int)gridDim.x), gw = opaque_s(gw0), NGW = G * NWAVES; (void)lane; (void)bx; (void)G; (void)gw; (void)NGW;
            char* alds = (char*)lds + RING_OFF;
            {
                const int x8 = bx & 7, j32 = bx >> 3;
                {
                    const int grp = x8 * 4 + (j32 >> 3), qb = j32 & 7, b = grp >> 2, h = grp & 3; const size_t row0 = (size_t)b * SEQ;
                    att::attn_unit<32>(P2 + (row0 + qb * 256) * 1024 + h * 96, 1024, P2 + row0 * 1024 + 384 + h * 128, 1024, KPE + row0 * 32, 32,
                                       P2 + row0 * 1024 + 384 + h * 128 + 64, 1024, OCAT + (row0 + qb * 256) * 1024 + 256 + h * 64, 1024, SEQ, tabt + (size_t)(qb * 256) * 32, alds);
                }
                for (int i = 0; i < 2; ++i) {
                    const int grp = i * 8 + x8, b = grp >> 1, kvh = grp & 1, hq = kvh * 4 + (j32 >> 3), qb = j32 & 7; const size_t row0 = (size_t)b * SEQ;
                    att::attn_unit<0>(QC + (row0 + qb * 256) * 512 + hq * 64, 512, KC + row0 * 128 + kvh * 64, 128, nullptr, 0,
                                      P1 + row0 * N1 + C_VC + kvh * 64, N1, OCAT + (row0 + qb * 256) * 1024 + 512 + hq * 64, 1024, SEQ, nullptr, alds);
                }
            }
            {
                const int x8 = bx & 7, j32 = bx >> 3; const int grp = x8 * 4 + (j32 >> 3), i = j32 & 7, b = grp >> 2, h = grp & 3; const size_t row0 = (size_t)b * SEQ;
                const int r0 = 4 * i, kst = min(max(r0 - 4, 0), 24), nt = (i == 0 || i == 7) ? 8 : 12;
                const bf16* base = P1 + (row0 + (size_t)kst * GRID_W) * N1;
                att::attn_unit<0, true>(P1 + (row0 + (size_t)r0 * GRID_W) * N1 + C_QA + h * 64, N1, base + C_KA + h * 64, N1, nullptr, 0, base + C_VA + h * 64, N1,
                                        OCAT + (row0 + (size_t)r0 * GRID_W) * 1024 + h * 64, 1024, nt * 64, nullptr, alds, args.in[7] + ((size_t)l * 4 + h) * 15 * 31, r0, kst);
            }
        }
        PHASE_END()
        CHK(6); CHK(7); CHK(8);

        PHASE_BEGIN(6)
        { const int tid = opaque_v(threadIdx.x), lane = tid & 63, bx = opaque_s((int)blockIdx.x), G = opaque_s((int)gridDim.x), gw = opaque_s(gw0), NGW = G * NWAVES; (void)lane; (void)bx; (void)G; (void)gw; (void)NGW;
            pg8::Gemm g{Hb, w.wg, M, NG, DM, DM, DM}; pg8::StaticOrder S; S.init(M, NG, G, bx);
            pg8::EpiBf16N<1> E{GATES, NG, rowss_a, biasp + (size_t)l * BIAS_PER_LAYER + 8 * NB1, NBG, SEQ};
            pg8::gemm_phase<pg8::EpiBf16N<1>, pg8::StaticOrder, true, true>(ldsl + RING_OFF, g, S, E);
        }
        PHASE_END()
        CHK(9);

        PHASE_BEGIN(7)
        { const int tid = opaque_v(threadIdx.x), lane = tid & 63, bx = opaque_s((int)blockIdx.x), G = opaque_s((int)gridDim.x), gw = opaque_s(gw0), NGW = G * NWAVES; (void)lane; (void)bx; (void)G; (void)gw; (void)NGW;
            pg8::Gemm g{OCAT, w.bna, M, DM, DM, DM, DM}; pg8::StaticOrder S; S.init(M, DM, G, bx);
            pg8::EpiMerge E{Hb, DM, GATES, NG};
            pg8::gemm_phase<pg8::EpiMerge, pg8::StaticOrder, true, true>(ldsl + RING_OFF, g, S, E);
        }
        PHASE_END()
        CHK(10);

        PHASE_BEGIN(8)
        { const int tid = opaque_v(threadIdx.x), lane = tid & 63, bx = opaque_s((int)blockIdx.x), G = opaque_s((int)gridDim.x), gw = opaque_s(gw0), NGW = G * NWAVES; (void)lane; (void)bx; (void)G; (void)gw; (void)NGW;
            pg8::Gemm g{Hb, w.wout, M, DM, DM, DM, DM}; pg8::StaticOrder S; S.init(M, DM, G, bx);
            if (l == 0) { pg8::EpiResidualN<true> E{x_in, XB, DM, mod + 2 * DM, NMOD * DM, SEQ, XG2, args.in[5] + (size_t)l * DM, mod + 4 * DM, rowss_b, (LAS float*)(ldsl + EPIX_OFF)};
                pg8::gemm_phase<pg8::EpiResidualN<true>, pg8::StaticOrder, true, true>(ldsl + RING_OFF, g, S, E); }
            else { pg8::EpiResidualN<false> E{XB, XB, DM, mod + 2 * DM, NMOD * DM, SEQ, XG2, args.in[5] + (size_t)l * DM, mod + 4 * DM, rowss_b, (LAS float*)(ldsl + EPIX_OFF)};
                pg8::gemm_phase<pg8::EpiResidualN<false>, pg8::StaticOrder, true, true>(ldsl + RING_OFF, g, S, E); }
        }
        PHASE_END()
        CHK(11);

        PHASE_BEGIN(10)
        { const int tid = opaque_v(threadIdx.x), lane = tid & 63, bx = opaque_s((int)blockIdx.x), G = opaque_s((int)gridDim.x), gw = opaque_s(gw0), NGW = G * NWAVES; (void)lane; (void)bx; (void)G; (void)gw; (void)NGW;
            pg8::Gemm g{XG2, w.wgu, M, 2 * FFN, DM, DM, DM}; pg8::StaticOrder S; S.init(M, 2 * FFN, G, bx);
            pg8::EpiSwiGLUN E{ACT, FFN, rowss_b, biasp + (size_t)l * BIAS_PER_LAYER + 8 * (NB1 + NBG), NBGU, SEQ};
            pg8::gemm_phase<pg8::EpiSwiGLUN, pg8::StaticOrder, true, true>(ldsl + RING_OFF, g, S, E);
        }
        PHASE_END()
        CHK(13);

        PHASE_BEGIN(11)
        { const int tid = opaque_v(threadIdx.x), lane = tid & 63, bx = opaque_s((int)blockIdx.x), G = opaque_s((int)gridDim.x), gw = opaque_s(gw0), NGW = G * NWAVES; (void)lane; (void)bx; (void)G; (void)gw; (void)NGW;
            pg8::Gemm g{ACT, w.wdn, M, DM, FFN, FFN, FFN}; pg8::StaticOrder S; S.init(M, DM, G, bx);
            const bool more = (l + 1 < DEPTH); const float* modn = modp + (size_t)(more ? l + 1 : l) * BATCH * NMOD * DM;
            pg8::EpiResidualN<false> E{XB, XB, DM, mod + 5 * DM, NMOD * DM, SEQ, more ? Hb : (bf16*)nullptr, args.in[4] + (size_t)(more ? l + 1 : l) * DM, modn + DM, rowss_a, (LAS float*)(ldsl + EPIX_OFF)};
            pg8::gemm_phase<pg8::EpiResidualN<false>, pg8::StaticOrder, true, true>(ldsl + RING_OFF, g, S, E);
        }
        PHASE_END()
        CHK(14);
    }

    PHASE_BEGIN(12)
    { const int tid = opaque_v(threadIdx.x), lane = tid & 63, bx = opaque_s((int)blockIdx.x), G = opaque_s((int)gridDim.x), gw = opaque_s(gw0), NGW = G * NWAVES; (void)lane; (void)bx; (void)G; (void)gw; (void)NGW;
        const float* g = args.in[20];
        for (int m = gw; m < M; m += NGW) {
            const bf16* xr = XB + (size_t)m * DM; float* orow = args.out + (size_t)m * DM;
            f32x4 v[4]; float sq = 0.f;
#pragma unroll
            for (int j = 0; j < 2; ++j) { const v4u xw = *(const v4u*)(xr + 512 * j + 8 * lane); v[2 * j] = (f32x4){bflo(xw.x), bfhi(xw.x), bflo(xw.y), bfhi(xw.y)}; v[2 * j + 1] = (f32x4){bflo(xw.z), bfhi(xw.z), bflo(xw.w), bfhi(xw.w)}; }
#pragma unroll
            for (int j = 0; j < 4; ++j) sq += (v[j][0] * v[j][0] + v[j][1] * v[j][1]) + (v[j][2] * v[j][2] + v[j][3] * v[j][3]);
            const float rstd = 1.0f / sqrtf(wave_sum(sq) * (1.0f / DM) + NORM_EPS);
#pragma unroll
            for (int j = 0; j < 4; ++j) { const int c = 512 * (j >> 1) + 8 * lane + 4 * (j & 1); const f32x4 gg = *(const f32x4*)(g + c); f32x4 y;
#pragma unroll
                for (int e = 0; e < 4; ++e) y[e] = v[j][e] * rstd * gg[e];
                *(f32x4*)(orow + c) = y; }
        }
    }
    PHASE_END()
#if SELFCHECK
        xcd_barrier(bar);
        if (blockIdx.x == 0 && threadIdx.x == 0) { const unsigned fl = __hip_atomic_load((unsigned*)(ctl + CW_FLAGS), RLX_AGENT); unsigned c[12]; for (int i = 0; i < 12; ++i) c[i] = __hip_atomic_load((unsigned*)(ctl + CW_FLAGS + 2 + i), RLX_AGENT);
        unsigned tot = c[0] + c[1] + c[2] + c[3], bad_ = c[6] + c[7] + c[8] + c[9]; int d1 = (c[6] ? 1 : 0) | (c[7] ? 2 : 0) | (c[8] ? 4 : 0) | (c[9] ? 8 : 0); int d2 = tot ? (int)(9.99f * (float)bad_ / (float)tot) : 0;
        { int k1 = 0, k2 = 0; while ((c[0] >> k1) != 0) ++k1; while ((c[1] >> k2) != 0) ++k2; d1 = k1 / 2; d2 = k2 / 2; if (d1 > 9) d1 = 9; if (d2 > 9) d2 = 9; args.out[0] = 100.0f * (float)(10 * d1 + d2 + 1); return; }
        args.out[0] = 100.0f * (float)((((fl >> 15) & 1u) * 2u + ((fl >> 10) & 1u)) + 1u); }
#endif
#undef PHASE_BEGIN
#undef PHASE_END
}

constexpr int N_PHASES = 2 + DEPTH * 8 + 1;
#ifndef MK_PER_PHASE
#define MK_PER_PHASE 0
#endif

extern "C" void kernel_launch(void* const* d_in, const int* in_sizes, int n_in, void* d_out, int out_size, void* d_ws, size_t ws_size, hipStream_t stream) {
    static int grid = 0;
    if (grid == 0) {
        if (n_in != 21 || in_sizes[0] != M * DM || out_size != M * DM || ws_size < WS_END) { fprintf(stderr, "kernel_launch: unexpected shapes (n_in %d in0 %d out %d ws %zu)\n", n_in, n_in > 0 ? in_sizes[0] : -1, out_size, ws_size); grid = -1; return; }
        int dev = 0, cus = 0;
        if (hipGetDevice(&dev) != hipSuccess || hipDeviceGetAttribute(&cus, hipDeviceAttributeMultiprocessorCount, dev) != hipSuccess) { grid = -1; return; }
        if (hipFuncSetAttribute((const void*)hybrid_fwd, hipFuncAttributeMaxDynamicSharedMemorySize, LDS_BYTES) != hipSuccess) { fprintf(stderr, "kernel_launch: hipFuncSetAttribute failed\n"); grid = -1; return; }
        (void)hipGetLastError();
        grid = cus;
    }
    if (grid < 0) return;
    (void)hipMemsetAsync((char*)d_ws + WS_CTL, 0, CTL_ZERO_BYTES, stream);
    Args a{};
    for (int i = 0; i < 21; ++i) a.in[i] = (const float*)d_in[i];
    a.out = (float*)d_out; a.ws = (unsigned char*)d_ws;
#if MK_PER_PHASE
    for (int p = 0; p < N_PHASES; ++p) { a.ph_lo = p; a.ph_hi = p + 1; hipLaunchKernelGGL(hybrid_fwd, dim3(grid), dim3(NWAVES * 64), LDS_BYTES, stream, a); }
#else
#if SELFCHECK
    a.ph_lo = 0; a.ph_hi = 12;
#else
    a.ph_lo = 0; a.ph_hi = N_PHASES;
#endif
    hipLaunchKernelGGL(hybrid_fwd, dim3(grid), dim3(NWAVES * 64), LDS_BYTES, stream, a);
#endif
    const hipError_t le = hipPeekAtLastError();
    if (le != hipSuccess) fprintf(stderr, "kernel_launch: launch failed: %s\n", hipGetErrorName(le));
}
```

```cpp
#include <hip/hip_runtime.h>
#include <hip/hip_bf16.h>
#include <cstdio>
#include <cstdint>
#ifndef TIMING
#define TIMING 0
#endif
#ifndef TSEL_A
#define TSEL_A 0
#define TSEL_B 1
#endif

__device__ __forceinline__ int opaque_v(int v) { asm volatile("" : "+v"(v)); return v; }
__device__ __forceinline__ int opaque_s(int v) { asm volatile("" : "+s"(v)); return v; }
__device__ __forceinline__ int tid_of(int wave_s) { int w = opaque_s(wave_s); __builtin_assume(w >= 0 && w < 8); int l; asm volatile("v_mbcnt_lo_u32_b32 %0, -1, 0\n\tv_mbcnt_hi_u32_b32 %0, -1, %0" : "=v"(l)); __builtin_assume(l >= 0 && l < 64); return w * 64 + l; }
namespace pg8 {
#define PG8_LAS __attribute__((address_space(3)))
typedef unsigned short bf16_t;
typedef short bf16x8 __attribute__((ext_vector_type(8)));
typedef float f32x4 __attribute__((ext_vector_type(4)));
typedef unsigned u32x4 __attribute__((ext_vector_type(4)));
constexpr int BM = 256, BK = 64, HALF = 128, HTB = HALF * BK * 2, STAGE_BYTES = 8 * HTB, NXCD = 8, WGM = 8;

__host__ __device__ __forceinline__ int lds_byte(int r, int c) { const int st = (r >> 4) * 2 + (c >> 5), rr = r & 15, cc = c & 31, ob = rr * 64 + cc * 2; return st * 1024 + (ob ^ (((ob >> 9) & 1) << 5)); }
__host__ __device__ __forceinline__ void stage_rc(int b, int& R, int& C) { const int st = b / 1024, sb = b % 1024, swz = sb ^ (((sb >> 9) & 1) << 5); R = (st >> 1) * 16 + swz / 64; C = (st & 1) * 32 + (swz % 64) / 2; }
__host__ __device__ __forceinline__ int perm32(int rho) { const int n = rho >> 4, i = rho & 15; return 8 * (i >> 2) + 4 * n + (i & 3); }

struct Unit { int pm, pn; };
struct Gemm { const bf16_t* A; const bf16_t* Bt; int M, N, K, lda, ldb; };

struct StaticOrder {
    int nM, nN, nwg, G, c;
    __host__ __device__ void init(int M, int N, int G_, int c_) { nM = M / BM; nN = N / BM; nwg = nM * nN; G = G_; c = c_; }
    __host__ __device__ bool next(int i, Unit& u) const {
        const long L = (long)i * G + c; if (L >= nwg) return false;
        int wgid = (int)L; { const int q = nwg / NXCD, r = nwg % NXCD, xcd = wgid % NXCD, off = wgid / NXCD; wgid = (xcd < r ? xcd * (q + 1) : r * (q + 1) + (xcd - r) * q) + off; }
        const int nig = WGM * nN, gid = wgid / nig, fm = gid * WGM, gsz = (nM - fm) < WGM ? (nM - fm) : WGM;
        u.pm = fm + ((wgid % nig) % gsz); u.pn = (wgid % nig) / gsz; return true;
    }
    __device__ __forceinline__ void a_ready(const Unit&) const {}
    __device__ __forceinline__ void done(const Unit&) const {}
};

typedef float f32x2_t __attribute__((ext_vector_type(2))); typedef __bf16 bf16x2_t __attribute__((ext_vector_type(2)));
__device__ __forceinline__ unsigned cvt_pk_bf16(float lo, float hi) { f32x2_t v = {lo, hi}; bf16x2_t b = __builtin_convertvector(v, bf16x2_t); return __builtin_bit_cast(unsigned, b); }
__device__ __forceinline__ float bf_lo(unsigned w) { return __uint_as_float(w << 16); }
__device__ __forceinline__ float bf_hi(unsigned w) { return __uint_as_float(w & 0xffff0000u); }
__device__ __forceinline__ float sum_x16_x32(float v) {
    auto a = __builtin_amdgcn_permlane16_swap(__float_as_uint(v), __float_as_uint(v), false, false); v = __uint_as_float(a[0]) + __uint_as_float(a[1]);
    auto b = __builtin_amdgcn_permlane32_swap(__float_as_uint(v), __float_as_uint(v), false, false); return __uint_as_float(b[0]) + __uint_as_float(b[1]);
}
__device__ __forceinline__ float sigmoidf_(float v) { return __builtin_amdgcn_rcpf(1.0f + __builtin_amdgcn_exp2f(-1.4426950408889634f * v)); }

template <int ACT  > struct EpiBf16 {
    static constexpr bool PERM = true, AFTER_DRAIN = false, HAS_MID = false; static constexpr int MID0 = 0, MID1 = 0;
    bf16_t* O; int ldc;
    __device__ __forceinline__ void operator()(const f32x4 (&acc)[2][2][4][2], const Unit& u, int wr, int wc, int fr, int fq) const {
        const int row0 = u.pm * BM + wr * 64 + fr, col0 = u.pn * BM + wc * 32 + 8 * fq;
#pragma unroll
        for (int ai = 0; ai < 2; ++ai)
#pragma unroll
            for (int m = 0; m < 4; ++m) { bf16_t* rowp = O + (size_t)(row0 + ai * HALF + m * 16) * ldc + col0;
#pragma unroll
                for (int bj = 0; bj < 2; ++bj) { f32x4 v0 = acc[ai][bj][m][0], v1 = acc[ai][bj][m][1];
                    if (ACT == 1) {
#pragma unroll
                        for (int e = 0; e < 4; ++e) { v0[e] = sigmoidf_(v0[e]); v1[e] = sigmoidf_(v1[e]); } }
                    u32x4 w; w.x = cvt_pk_bf16(v0[0], v0[1]); w.y = cvt_pk_bf16(v0[2], v0[3]); w.z = cvt_pk_bf16(v1[0], v1[1]); w.w = cvt_pk_bf16(v1[2], v1[3]);
                    *(u32x4*)(rowp + bj * HALF) = w; } }
    }
};
struct EpiGateAcc {
    static constexpr bool PERM = true, AFTER_DRAIN = false, HAS_MID = false; static constexpr int MID0 = 0, MID1 = 0;
    bf16_t* O; int ldc; const bf16_t* G; int ldg; int goff; int first;
    __device__ __forceinline__ void operator()(const f32x4 (&acc)[2][2][4][2], const Unit& u, int wr, int wc, int fr, int fq) const {
        const int row0 = u.pm * BM + wr * 64 + fr, col0 = u.pn * BM + wc * 32 + 8 * fq;
#pragma unroll
        for (int ai = 0; ai < 2; ++ai)
#pragma unroll
            for (int m = 0; m < 4; ++m) { const size_t r = (size_t)(row0 + ai * HALF + m * 16); bf16_t* rowp = O + r * ldc + col0; const bf16_t* gp = G + r * ldg + goff + col0;
#pragma unroll
                for (int bj = 0; bj < 2; ++bj) { const f32x4 v0 = acc[ai][bj][m][0], v1 = acc[ai][bj][m][1];
                    const u32x4 g = *(const u32x4*)(gp + bj * HALF);
                    float o[8];
                    o[0] = bf_lo(g.x) * v0[0]; o[1] = bf_hi(g.x) * v0[1]; o[2] = bf_lo(g.y) * v0[2]; o[3] = bf_hi(g.y) * v0[3];
                    o[4] = bf_lo(g.z) * v1[0]; o[5] = bf_hi(g.z) * v1[1]; o[6] = bf_lo(g.w) * v1[2]; o[7] = bf_hi(g.w) * v1[3];
                    if (!first) { const u32x4 p = *(const u32x4*)(rowp + bj * HALF);
                        o[0] += bf_lo(p.x); o[1] += bf_hi(p.x); o[2] += bf_lo(p.y); o[3] += bf_hi(p.y); o[4] += bf_lo(p.z); o[5] += bf_hi(p.z); o[6] += bf_lo(p.w); o[7] += bf_hi(p.w); }
                    u32x4 w; w.x = cvt_pk_bf16(o[0], o[1]); w.y = cvt_pk_bf16(o[2], o[3]); w.z = cvt_pk_bf16(o[4], o[5]); w.w = cvt_pk_bf16(o[6], o[7]);
                    *(u32x4*)(rowp + bj * HALF) = w; } }
    }
};
struct EpiSwiGLU {
    static constexpr bool PERM = true, AFTER_DRAIN = false, HAS_MID = false; static constexpr int MID0 = 0, MID1 = 0;
    bf16_t* O; int ldc;
    __device__ __forceinline__ void operator()(const f32x4 (&acc)[2][2][4][2], const Unit& u, int wr, int wc, int fr, int fq) const {
        const int row0 = u.pm * BM + wr * 64 + fr, col0 = u.pn * HALF + wc * 32 + 8 * fq;
#pragma unroll
        for (int ai = 0; ai < 2; ++ai)
#pragma unroll
            for (int m = 0; m < 4; ++m) { bf16_t* rowp = O + (size_t)(row0 + ai * HALF + m * 16) * ldc + col0;
                float o[8];
#pragma unroll
                for (int n = 0; n < 2; ++n)
#pragma unroll
                    for (int e = 0; e < 4; ++e) { const float g = acc[ai][0][m][n][e], up = acc[ai][1][m][n][e]; o[n * 4 + e] = g * sigmoidf_(g) * up; }
                u32x4 w; w.x = cvt_pk_bf16(o[0], o[1]); w.y = cvt_pk_bf16(o[2], o[3]); w.z = cvt_pk_bf16(o[4], o[5]); w.w = cvt_pk_bf16(o[6], o[7]);
                *(u32x4*)rowp = w; }
    }
};
struct EpiResidual {
    static constexpr bool PERM = false, AFTER_DRAIN = false, HAS_MID = false; static constexpr int MID0 = 0, MID1 = 0;
    const float* xin; float* xout; int ldc; const float* gvec; int gstride; int rows_per_batch;
    __device__ __forceinline__ void operator()(const f32x4 (&acc)[2][2][4][2], const Unit& u, int wr, int wc, int fr, int fq) const {
        const int row0 = u.pm * BM + wr * 64 + fr, col0 = u.pn * BM + wc * 32 + 4 * fq;
        const int b = (u.pm * BM) / rows_per_batch;
        f32x4 gv[2][2];
#pragma unroll
        for (int bj = 0; bj < 2; ++bj)
#pragma unroll
            for (int n = 0; n < 2; ++n) gv[bj][n] = *(const f32x4*)(gvec + (size_t)b * gstride + col0 + bj * HALF + n * 16);
#pragma unroll
        for (int ai = 0; ai < 2; ++ai)
#pragma unroll
            for (int m = 0; m < 4; ++m) { const size_t off = (size_t)(row0 + ai * HALF + m * 16) * ldc + col0;
#pragma unroll
                for (int bj = 0; bj < 2; ++bj)
#pragma unroll
                    for (int n = 0; n < 2; ++n) { const f32x4 xi = *(const f32x4*)(xin + off + bj * HALF + n * 16);
                        *(f32x4*)(xout + off + bj * HALF + n * 16) = xi + gv[bj][n] * acc[ai][bj][m][n]; } }
    }
};

template <int ACT  > struct EpiBf16N {
    static constexpr bool PERM = true, AFTER_DRAIN = false, HAS_MID = false; static constexpr int MID0 = 0, MID1 = 0;
    bf16_t* O; int ldc; const float* rowss; const float* bias; int nb; int rows_per_batch;
    __device__ __forceinline__ void operator()(const f32x4 (&acc)[2][2][4][2], const Unit& u, int wr, int wc, int fr, int fq) const {
        const int row0 = u.pm * BM + wr * 64 + fr, col0 = u.pn * BM + wc * 32 + 8 * fq; const float* bp = bias + (size_t)((u.pm * BM) / rows_per_batch) * nb + col0;
        f32x4 bv[2][2];
#pragma unroll
        for (int bj = 0; bj < 2; ++bj) { bv[bj][0] = *(const f32x4*)(bp + bj * HALF); bv[bj][1] = *(const f32x4*)(bp + bj * HALF + 4); }
#pragma unroll
        for (int ai = 0; ai < 2; ++ai)
#pragma unroll
            for (int m = 0; m < 4; ++m) { const int row = row0 + ai * HALF + m * 16; const f32x4 rp = *(const f32x4*)(rowss + 4 * (size_t)row); const float rs = __builtin_amdgcn_rsqf(((rp[0] + rp[1]) + (rp[2] + rp[3])) * (1.0f / 1024.0f) + 1e-6f); bf16_t* rowp = O + (size_t)row * ldc + col0;
#pragma unroll
                for (int bj = 0; bj < 2; ++bj) { f32x4 v0 = acc[ai][bj][m][0] * rs + bv[bj][0], v1 = acc[ai][bj][m][1] * rs + bv[bj][1];
                    if (ACT == 1) {
#pragma unroll
                        for (int e = 0; e < 4; ++e) { v0[e] = sigmoidf_(v0[e]); v1[e] = sigmoidf_(v1[e]); } }
                    u32x4 w; w.x = cvt_pk_bf16(v0[0], v0[1]); w.y = cvt_pk_bf16(v0[2], v0[3]); w.z = cvt_pk_bf16(v1[0], v1[1]); w.w = cvt_pk_bf16(v1[2], v1[3]);
                    *(u32x4*)(rowp + bj * HALF) = w; } }
    }
};
struct EpiSwiGLUN {
    static constexpr bool PERM = true, AFTER_DRAIN = false, HAS_MID = false; static constexpr int MID0 = 0, MID1 = 0;
    bf16_t* O; int ldc; const float* rowss; const float* bias; int nb; int rows_per_batch;
    __device__ __forceinline__ void operator()(const f32x4 (&acc)[2][2][4][2], const Unit& u, int wr, int wc, int fr, int fq) const {
        const int row0 = u.pm * BM + wr * 64 + fr, col0 = u.pn * HALF + wc * 32 + 8 * fq; const float* bp = bias + (size_t)((u.pm * BM) / rows_per_batch) * nb + u.pn * BM + wc * 32 + 8 * fq;
        f32x4 bv[2][2];
#pragma unroll
        for (int bj = 0; bj < 2; ++bj) { bv[bj][0] = *(const f32x4*)(bp + bj * HALF); bv[bj][1] = *(const f32x4*)(bp + bj * HALF + 4); }
#pragma unroll
        for (int ai = 0; ai < 2; ++ai)
#pragma unroll
            for (int m = 0; m < 4; ++m) { const int row = row0 + ai * HALF + m * 16; const f32x4 rp = *(const f32x4*)(rowss + 4 * (size_t)row); const float rs = __builtin_amdgcn_rsqf(((rp[0] + rp[1]) + (rp[2] + rp[3])) * (1.0f / 1024.0f) + 1e-6f); bf16_t* rowp = O + (size_t)row * ldc + col0;
                float o[8];
#pragma unroll
                for (int n = 0; n < 2; ++n)
#pragma unroll
                    for (int e = 0; e < 4; ++e) { const float g = acc[ai][0][m][n][e] * rs + bv[0][n][e], up = acc[ai][1][m][n][e] * rs + bv[1][n][e]; o[n * 4 + e] = g * sigmoidf_(g) * up; }
                u32x4 w; w.x = cvt_pk_bf16(o[0], o[1]); w.y = cvt_pk_bf16(o[2], o[3]); w.z = cvt_pk_bf16(o[4], o[5]); w.w = cvt_pk_bf16(o[6], o[7]);
                *(u32x4*)rowp = w; }
    }
};
template <bool XIN_F32> struct EpiResidualN {
    static constexpr bool PERM = true, AFTER_DRAIN = false, HAS_MID = false; static constexpr int MID0 = 0, MID1 = 0;
    const void* xin; bf16_t* xout; int ldc; const float* gvec; int gstride; int rows_per_batch; bf16_t* xg; const float* gn; const float* scn; float* rowss4; PG8_LAS float* lds_x;
    __device__ __forceinline__ void operator()(const f32x4 (&acc)[2][2][4][2], const Unit& u, int wr, int wc, int fr, int fq) const {
        const int row0 = u.pm * BM + wr * 64 + fr, col0 = u.pn * BM + wc * 32 + 8 * fq;
        const int b = (u.pm * BM) / rows_per_batch;
        float ss[2][4];
#pragma unroll
        for (int ai = 0; ai < 2; ++ai)
#pragma unroll
            for (int m = 0; m < 4; ++m) ss[ai][m] = 0.f;
#pragma unroll
        for (int bj = 0; bj < 2; ++bj) { const int c = col0 + bj * HALF;
            const f32x4 gv0 = *(const f32x4*)(gvec + (size_t)b * gstride + c), gv1 = *(const f32x4*)(gvec + (size_t)b * gstride + c + 4);
            f32x4 gs0 = {0.f, 0.f, 0.f, 0.f}, gs1 = {0.f, 0.f, 0.f, 0.f};
            if (xg) { gs0 = *(const f32x4*)(gn + c) * (*(const f32x4*)(scn + (size_t)b * gstride + c) + 1.0f); gs1 = *(const f32x4*)(gn + c + 4) * (*(const f32x4*)(scn + (size_t)b * gstride + c + 4) + 1.0f); }
#pragma unroll
            for (int ai = 0; ai < 2; ++ai)
#pragma unroll
                for (int m = 0; m < 4; ++m) { const size_t off = (size_t)(row0 + ai * HALF + m * 16) * ldc + c; f32x4 xi0, xi1;
                    if constexpr (XIN_F32) { xi0 = *(const f32x4*)((const float*)xin + off); xi1 = *(const f32x4*)((const float*)xin + off + 4); }
                    else { const u32x4 xw = *(const u32x4*)((const bf16_t*)xin + off); xi0 = (f32x4){bf_lo(xw.x), bf_hi(xw.x), bf_lo(xw.y), bf_hi(xw.y)}; xi1 = (f32x4){bf_lo(xw.z), bf_hi(xw.z), bf_lo(xw.w), bf_hi(xw.w)}; }
                    const f32x4 xo0 = xi0 + gv0 * acc[ai][bj][m][0], xo1 = xi1 + gv1 * acc[ai][bj][m][1];
                    { u32x4 w; w.x = cvt_pk_bf16(xo0[0], xo0[1]); w.y = cvt_pk_bf16(xo0[2], xo0[3]); w.z = cvt_pk_bf16(xo1[0], xo1[1]); w.w = cvt_pk_bf16(xo1[2], xo1[3]); *(u32x4*)(xout + off) = w; }
                    if (xg) { const f32x4 y0 = xo0 * gs0, y1 = xo1 * gs1; u32x4 w; w.x = cvt_pk_bf16(y0[0], y0[1]); w.y = cvt_pk_bf16(y0[2], y0[3]); w.z = cvt_pk_bf16(y1[0], y1[1]); w.w = cvt_pk_bf16(y1[2], y1[3]); *(u32x4*)(xg + off) = w;
                        ss[ai][m] += ((xo0[0] * xo0[0] + xo0[1] * xo0[1]) + (xo0[2] * xo0[2] + xo0[3] * xo0[3])) + ((xo1[0] * xo1[0] + xo1[1] * xo1[1]) + (xo1[2] * xo1[2] + xo1[3] * xo1[3])); } } }
        if (xg) {
#pragma unroll
            for (int ai = 0; ai < 2; ++ai)
#pragma unroll
                for (int m = 0; m < 4; ++m) { float v = sum_x16_x32(ss[ai][m]); if (fq == 0) lds_x[wc * 256 + ai * HALF + wr * 64 + m * 16 + fr] = v; }
            asm volatile("s_waitcnt lgkmcnt(0)" ::: "memory"); __builtin_amdgcn_s_barrier(); asm volatile("" ::: "memory");
            const int t = ((wr * 4 + wc) << 6) | (fq << 4) | fr;
            if (t < 256) rowss4[4 * (size_t)(u.pm * BM + t) + u.pn] = (lds_x[t] + lds_x[256 + t]) + (lds_x[512 + t] + lds_x[768 + t]);
        }
    }
};

struct EpiProj1 {
    static constexpr bool PERM = true, AFTER_DRAIN = false, HAS_MID = false; static constexpr int MID0 = 0, MID1 = 0;
    bf16_t* P1; int ld1; int c_vc; const float* rowss; const float* bias; int nb; int rows_per_batch;
    bf16_t* A2; bf16_t* KPE; bf16_t* QC; bf16_t* KC; const float* g_q; const float* g_kv; const float* g_qc; const float* g_kc; const float* tabt; const float* taba; PG8_LAS float* lds_x;
    __device__ __forceinline__ float rstd_of(int row) const { const f32x4 rp = *(const f32x4*)(rowss + 4 * (size_t)row); return __builtin_amdgcn_rsqf(((rp[0] + rp[1]) + (rp[2] + rp[3])) * (1.0f / 1024.0f) + 1e-6f); }
    __device__ __forceinline__ void operator()(const f32x4 (&acc)[2][2][4][2], const Unit& u, int wr, int wc, int fr, int fq) const {
        const int row0 = u.pm * BM + wr * 64 + fr, pn = u.pn; const float* bp = bias + (size_t)((u.pm * BM) / rows_per_batch) * nb + pn * BM + wc * 32 + 8 * fq;
#define EP1_BV(bj, n) (*(const f32x4*)(bp + (bj) * HALF + 4 * (n)))
#define EP1_PACK(v0, v1) (u32x4){cvt_pk_bf16((v0)[0], (v0)[1]), cvt_pk_bf16((v0)[2], (v0)[3]), cvt_pk_bf16((v1)[0], (v1)[1]), cvt_pk_bf16((v1)[2], (v1)[3])}
#define EP1_FENCE() asm volatile("" ::: "memory")
        if (pn < 3 || (pn == 7 && wc >= 2)) {
            const int dcol = pn < 3 ? pn * BM + wc * 32 + 8 * fq : c_vc + (wc - 2) * 64 + 8 * fq; const int bjs = pn < 3 ? HALF : 32;
#pragma unroll
            for (int ai = 0; ai < 2; ++ai)
#pragma unroll
                for (int m = 0; m < 4; ++m) { const int row = row0 + ai * HALF + m * 16; const float rs = rstd_of(row); bf16_t* rowp = P1 + (size_t)row * ld1 + dcol;
#pragma unroll
                    for (int bj = 0; bj < 2; ++bj) { const f32x4 v0 = acc[ai][bj][m][0] * rs + EP1_BV(bj, 0), v1 = acc[ai][bj][m][1] * rs + EP1_BV(bj, 1); *(u32x4*)(rowp + bj * bjs) = EP1_PACK(v0, v1); }
                    EP1_FENCE(); }
        } else if (pn == 3 || pn == 4) {
#pragma unroll
            for (int ai = 0; ai < 2; ++ai)
#pragma unroll
                for (int m = 0; m < 4; ++m) { const float rs = rstd_of(row0 + ai * HALF + m * 16); float ss = 0.f;
#pragma unroll
                    for (int bj = 0; bj < 2; ++bj) if (pn == 3 || bj == 0) { const f32x4 v0 = acc[ai][bj][m][0] * rs + EP1_BV(bj, 0), v1 = acc[ai][bj][m][1] * rs + EP1_BV(bj, 1);
                        ss += ((v0[0] * v0[0] + v0[1] * v0[1]) + (v0[2] * v0[2] + v0[3] * v0[3])) + ((v1[0] * v1[0] + v1[1] * v1[1]) + (v1[2] * v1[2] + v1[3] * v1[3])); }
                    ss = sum_x16_x32(ss); if (fq == 0) lds_x[wc * 256 + ai * HALF + wr * 64 + m * 16 + fr] = ss; EP1_FENCE(); }
            asm volatile("s_waitcnt lgkmcnt(0)" ::: "memory"); __builtin_amdgcn_s_barrier(); asm volatile("" ::: "memory");
            const float invn = pn == 3 ? (1.0f / 256.0f) : (1.0f / 128.0f); const float* gp = (pn == 3 ? g_q : g_kv) + wc * 32 + 8 * fq; const int a2c = (pn == 3 ? 0 : 256) + wc * 32 + 8 * fq;
#pragma unroll
            for (int ai = 0; ai < 2; ++ai)
#pragma unroll
                for (int m = 0; m < 4; ++m) { const int rl = ai * HALF + wr * 64 + m * 16 + fr; const int row = u.pm * BM + rl; float rs = rstd_of(row); asm volatile("" : "+v"(rs));
                    const float r2 = __builtin_amdgcn_rsqf(((lds_x[rl] + lds_x[256 + rl]) + (lds_x[512 + rl] + lds_x[768 + rl])) * invn + 1e-6f);
                    { const f32x4 v0 = (acc[ai][0][m][0] * rs + EP1_BV(0, 0)) * r2 * *(const f32x4*)(gp), v1 = (acc[ai][0][m][1] * rs + EP1_BV(0, 1)) * r2 * *(const f32x4*)(gp + 4); *(u32x4*)(A2 + (size_t)row * 384 + a2c) = EP1_PACK(v0, v1); }
                    if (pn == 3) { const f32x4 v0 = (acc[ai][1][m][0] * rs + EP1_BV(1, 0)) * r2 * *(const f32x4*)(gp + HALF), v1 = (acc[ai][1][m][1] * rs + EP1_BV(1, 1)) * r2 * *(const f32x4*)(gp + HALF + 4); *(u32x4*)(A2 + (size_t)row * 384 + a2c + HALF) = EP1_PACK(v0, v1); }
                    else if (wc == 0) {
                        const int t = row % rows_per_batch; const f32x4 c = *(const f32x4*)(tabt + (size_t)t * 32 + 4 * fq), sn = *(const f32x4*)(tabt + (size_t)t * 32 + 16 + 4 * fq);
                        const f32x4 x1 = acc[ai][1][m][0] * rs + EP1_BV(1, 0), x2 = acc[ai][1][m][1] * rs + EP1_BV(1, 1); const f32x4 y1 = x1 * c - x2 * sn, y2 = x2 * c + x1 * sn;
                        typedef unsigned u32x2 __attribute__((ext_vector_type(2)));
                        *(u32x2*)(KPE + (size_t)row * 32 + 4 * fq) = (u32x2){cvt_pk_bf16(y1[0], y1[1]), cvt_pk_bf16(y1[2], y1[3])};
                        *(u32x2*)(KPE + (size_t)row * 32 + 16 + 4 * fq) = (u32x2){cvt_pk_bf16(y2[0], y2[1]), cvt_pk_bf16(y2[2], y2[3])}; }
                    EP1_FENCE(); }
        } else {
            const bool isq = pn != 7; const float* g = (isq ? g_qc : g_kc) + 4 * fq; bf16_t* dst = isq ? QC + ((pn - 5) * 4 + wc) * 64 + 8 * fq : KC + wc * 64 + 8 * fq; const int ldd = isq ? 512 : 128;
#pragma unroll
            for (int ai = 0; ai < 2; ++ai)
#pragma unroll
                for (int m = 0; m < 4; ++m) { const int row = row0 + ai * HALF + m * 16; const int t = row % rows_per_batch; const float rs = rstd_of(row);
                    f32x4 v[2][2]; float ss = 0.f;
#pragma unroll
                    for (int bj = 0; bj < 2; ++bj)
#pragma unroll
                        for (int n = 0; n < 2; ++n) { v[bj][n] = acc[ai][bj][m][n] * rs + EP1_BV(bj, n); ss += (v[bj][n][0] * v[bj][n][0] + v[bj][n][1] * v[bj][n][1]) + (v[bj][n][2] * v[bj][n][2] + v[bj][n][3] * v[bj][n][3]); }
                    ss = sum_x16_x32(ss);
                    const float r2 = __builtin_amdgcn_rsqf(ss * (1.0f / 64.0f) + 1e-6f);
                    f32x4 o[2][2];
#pragma unroll
                    for (int n = 0; n < 2; ++n) { const int pos = n == 0 ? (t >> 6) : (t & 63); const f32x4 c = *(const f32x4*)(taba + (size_t)pos * 32 + 4 * fq), sn = *(const f32x4*)(taba + (size_t)pos * 32 + 16 + 4 * fq);
                        const f32x4 y1 = v[0][n] * r2 * *(const f32x4*)(g + 32 * n), y2 = v[1][n] * r2 * *(const f32x4*)(g + 32 * n + 16); o[0][n] = y1 * c - y2 * sn; o[1][n] = y2 * c + y1 * sn; }
#pragma unroll
                    for (int bj = 0; bj < 2; ++bj) *(u32x4*)(dst + (size_t)row * ldd + bj * 32) = EP1_PACK(o[bj][0], o[bj][1]);
                    EP1_FENCE(); }
        }
#undef EP1_BV
#undef EP1_PACK
#undef EP1_FENCE
    }
};

struct EpiGateU8 {
    static constexpr bool PERM = true, AFTER_DRAIN = false, HAS_MID = false; static constexpr int MID0 = 0, MID1 = 0;
    unsigned char* O; int ldc; const float* rowss; const float* bias; int nb; int rows_per_batch;
    __device__ __forceinline__ static unsigned q8(float z) { const float s = sigmoidf_(z); const unsigned q = (unsigned)(s * 255.0f + 0.5f); return q < 1u ? 1u : q; }
    __device__ __forceinline__ void operator()(const f32x4 (&acc)[2][2][4][2], const Unit& u, int wr, int wc, int fr, int fq) const {
        const int row0 = u.pm * BM + wr * 64 + fr, col0 = u.pn * BM + wc * 32 + 8 * fq; const float* bp = bias + (size_t)((u.pm * BM) / rows_per_batch) * nb + col0;
        f32x4 bv[2][2];
#pragma unroll
        for (int bj = 0; bj < 2; ++bj) { bv[bj][0] = *(const f32x4*)(bp + bj * HALF); bv[bj][1] = *(const f32x4*)(bp + bj * HALF + 4); }
#pragma unroll
        for (int ai = 0; ai < 2; ++ai)
#pragma unroll
            for (int m = 0; m < 4; ++m) { const int row = row0 + ai * HALF + m * 16; const f32x4 rp = *(const f32x4*)(rowss + 4 * (size_t)row); const float rs = __builtin_amdgcn_rsqf(((rp[0] + rp[1]) + (rp[2] + rp[3])) * (1.0f / 1024.0f) + 1e-6f);
                unsigned char* rowp = O + (size_t)row * ldc + col0;
#pragma unroll
                for (int bj = 0; bj < 2; ++bj) { const f32x4 v0 = acc[ai][bj][m][0] * rs + bv[bj][0], v1 = acc[ai][bj][m][1] * rs + bv[bj][1];
                    typedef unsigned u32x2 __attribute__((ext_vector_type(2))); u32x2 w;
                    w.x = q8(v0[0]) | (q8(v0[1]) << 8) | (q8(v0[2]) << 16) | (q8(v0[3]) << 24); w.y = q8(v1[0]) | (q8(v1[1]) << 8) | (q8(v1[2]) << 16) | (q8(v1[3]) << 24);
                    *(u32x2*)(rowp + bj * HALF) = w; } }
    }
};
struct EpiMerge {
    static constexpr bool PERM = true, AFTER_DRAIN = false, HAS_MID = true; static constexpr int MID0 = 4, MID1 = 8;
    bf16_t* O; int ldc; const unsigned char* G; int ldg;
    __device__ __forceinline__ static float ub(unsigned w, int k) { return (float)((w >> (8 * k)) & 0xffu); }
    __device__ __forceinline__ void mid(f32x4 (&acc)[2][2][4][2], const Unit& u, int which, int wr, int wc, int fr, int fq) const {
        const int row0 = u.pm * BM + wr * 64 + fr, col0 = u.pn * BM + wc * 32 + 8 * fq; typedef unsigned u32x2 __attribute__((ext_vector_type(2)));
#pragma unroll
        for (int ai = 0; ai < 2; ++ai)
#pragma unroll
            for (int m = 0; m < 4; ++m) { const unsigned char* gp = G + (size_t)(row0 + ai * HALF + m * 16) * ldg + which * 1024 + col0;
#pragma unroll
                for (int bj = 0; bj < 2; ++bj) { const u32x2 gn = *(const u32x2*)(gp + bj * HALF), gd = *(const u32x2*)(gp + 1024 + bj * HALF);
                    f32x4 r0, r1;
#pragma unroll
                    for (int e = 0; e < 4; ++e) { r0[e] = ub(gn.x, e) * __builtin_amdgcn_rcpf(ub(gd.x, e)); r1[e] = ub(gn.y, e) * __builtin_amdgcn_rcpf(ub(gd.y, e)); }
                    acc[ai][bj][m][0] *= r0; acc[ai][bj][m][1] *= r1; }
                asm volatile("" ::: "memory"); }
    }
    __device__ __forceinline__ void operator()(const f32x4 (&acc)[2][2][4][2], const Unit& u, int wr, int wc, int fr, int fq) const {
        const int row0 = u.pm * BM + wr * 64 + fr, col0 = u.pn * BM + wc * 32 + 8 * fq; typedef unsigned u32x2 __attribute__((ext_vector_type(2))); const float k255 = 1.0f / 255.0f;
#pragma unroll
        for (int ai = 0; ai < 2; ++ai)
#pragma unroll
            for (int m = 0; m < 4; ++m) { const size_t r = (size_t)(row0 + ai * HALF + m * 16); bf16_t* rowp = O + r * ldc + col0; const unsigned char* gp = G + r * ldg + 2048 + col0;
#pragma unroll
                for (int bj = 0; bj < 2; ++bj) { const f32x4 v0 = acc[ai][bj][m][0] * k255, v1 = acc[ai][bj][m][1] * k255; const u32x2 g = *(const u32x2*)(gp + bj * HALF);
                    u32x4 w; w.x = cvt_pk_bf16(ub(g.x, 0) * v0[0], ub(g.x, 1) * v0[1]); w.y = cvt_pk_bf16(ub(g.x, 2) * v0[2], ub(g.x, 3) * v0[3]);
                    w.z = cvt_pk_bf16(ub(g.y, 0) * v1[0], ub(g.y, 1) * v1[1]); w.w = cvt_pk_bf16(ub(g.y, 2) * v1[2], ub(g.y, 3) * v1[3]);
                    *(u32x4*)(rowp + bj * HALF) = w; }
                asm volatile("" ::: "memory"); }
    }
};

template <class Epi, class Sched, bool ALIGN_EPI = false, bool SP2 = false>
__device__ __forceinline__ void gemm_phase(PG8_LAS unsigned char* lds, const Gemm g, const Sched& S, const Epi& E, int wave_s) {
    const int tid = tid_of(wave_s), wid = __builtin_amdgcn_readfirstlane(tid >> 6), lane = tid & 63, wr = wid >> 2, wc = wid & 3, fr = lane & 15, fq = lane >> 4;
    const int K = g.K, nt = K / BK;
    unsigned voffA[2], voffB[2];
#pragma unroll
    for (int i = 0; i < 2; ++i) { int R, C; stage_rc(tid * 16 + i * 8192, R, C); const int Rb = Epi::PERM ? ((R & ~31) + perm32(R & 31)) : R;
        voffA[i] = (unsigned)(R * g.lda + C) * 2u; voffB[i] = (unsigned)(Rb * g.ldb + C) * 2u; }
    const size_t kstep = (size_t)(BK * 2);
    const size_t hstepA = (size_t)HALF * g.lda * 2, hstepB = (size_t)HALF * g.ldb * 2;
    const size_t tstepA = 2 * hstepA, tstepB = 2 * hstepB;
    const unsigned ldsw = (unsigned)wid * 1024u;
    const int aoff = lds_byte(wr * 64 + fr, fq * 8), boff = lds_byte(wc * 32 + fr, fq * 8);
#define PG8_SA(b, h) (((b) * 2 + (h)) * HTB)
#define PG8_SB(b, h) ((4 + (b) * 2 + (h)) * HTB)
#define PG8_STAGE(bufoff, gbase, voff) do { _Pragma("unroll") for (int _i = 0; _i < 2; ++_i) \
        __builtin_amdgcn_global_load_lds((const unsigned*)((const char*)(gbase) + (voff)[_i]), (PG8_LAS unsigned*)(lds + (bufoff) + ldsw + _i * 8192), 16, 0, 0); } while (0)
#define PG8_LDA(dst, b, h) do { _Pragma("unroll") for (int m = 0; m < 4; ++m) _Pragma("unroll") for (int k = 0; k < 2; ++k) dst[m][k] = *(const PG8_LAS bf16x8*)(lds + PG8_SA(b, h) + aoff + m * 2048 + k * 1024); } while (0)
#define PG8_LDB(dst, b, h) do { _Pragma("unroll") for (int n = 0; n < 2; ++n) _Pragma("unroll") for (int k = 0; k < 2; ++k) dst[n][k] = *(const PG8_LAS bf16x8*)(lds + PG8_SB(b, h) + boff + n * 2048 + k * 1024); } while (0)
#define PG8_MMA(ai, bj, At, Bt) do { __builtin_amdgcn_s_setprio(1); _Pragma("unroll") for (int m = 0; m < 4; ++m) _Pragma("unroll") for (int n = 0; n < 2; ++n) _Pragma("unroll") for (int k = 0; k < 2; ++k) \
        acc[ai][bj][m][n] = __builtin_amdgcn_mfma_f32_16x16x32_bf16(Bt[n][k], At[m][k], acc[ai][bj][m][n], 0, 0, 0); __builtin_amdgcn_s_setprio(0); } while (0)
#define PG8_WAIT_V(n) asm volatile("s_waitcnt vmcnt(" #n ")" ::: "memory")
#define PG8_WAIT_L(n) asm volatile("s_waitcnt lgkmcnt(" #n ")" ::: "memory")
#define PG8_BAR __builtin_amdgcn_s_barrier()
#define PG8_SCHED __builtin_amdgcn_sched_barrier(0)
    Unit cur, nxt; int ui = 0;
    if (!S.next(0, cur)) return;
    f32x4 acc[2][2][4][2];
#pragma unroll
    for (int a = 0; a < 2; ++a)
#pragma unroll
        for (int b = 0; b < 2; ++b)
#pragma unroll
            for (int m = 0; m < 4; ++m)
#pragma unroll
                for (int n = 0; n < 2; ++n) acc[a][b][m][n] = (f32x4){0.f, 0.f, 0.f, 0.f};
    bf16x8 At[4][2], B0[2][2], B1[2][2];
    const char* cA = (const char*)g.A + (size_t)cur.pm * tstepA; const char* cB = (const char*)g.Bt + (size_t)cur.pn * tstepB;
    S.a_ready(cur);
    if constexpr (SP2) {
        PG8_STAGE(PG8_SB(0, 0), cB, voffB); PG8_STAGE(PG8_SB(0, 1), cB + hstepB, voffB); PG8_STAGE(PG8_SA(0, 0), cA, voffA); PG8_STAGE(PG8_SA(0, 1), cA + hstepA, voffA);
        if (wr == 1) PG8_BAR;
        PG8_WAIT_V(2); PG8_BAR;
        PG8_STAGE(PG8_SB(1, 0), cB + kstep, voffB); PG8_STAGE(PG8_SA(1, 0), cA + kstep, voffA); PG8_STAGE(PG8_SB(1, 1), cB + hstepB + kstep, voffB);
        PG8_WAIT_V(6); PG8_BAR;
    } else {
        PG8_STAGE(PG8_SB(0, 0), cB, voffB); PG8_STAGE(PG8_SA(0, 0), cA, voffA); PG8_STAGE(PG8_SB(0, 1), cB + hstepB, voffB); PG8_STAGE(PG8_SA(0, 1), cA + hstepA, voffA);
        if (wr == 1) PG8_BAR;
        PG8_WAIT_V(4); PG8_BAR;
        PG8_STAGE(PG8_SB(1, 0), cB + kstep, voffB); PG8_STAGE(PG8_SA(1, 0), cA + kstep, voffA); PG8_STAGE(PG8_SB(1, 1), cB + hstepB + kstep, voffB);
        PG8_WAIT_V(6); PG8_BAR;
    }
    for (;;) {
        const bool has_next = S.next(ui + 1, nxt);
        const char* nA = has_next ? (const char*)g.A + (size_t)nxt.pm * tstepA : cA; const char* nB = has_next ? (const char*)g.Bt + (size_t)nxt.pn * tstepB : cB;
        int t = 0;
#pragma unroll 1
        for (int seg = 0; seg < (Epi::HAS_MID ? 3 : 1); ++seg) {
        const int tend = Epi::HAS_MID ? (seg == 0 ? Epi::MID0 : seg == 1 ? Epi::MID1 : nt) : nt;
        if constexpr (Epi::HAS_MID) { if (seg > 0) E.mid(acc, cur, seg - 1, wr, wc, fr, fq); }
#pragma unroll 1
        for (; t < tend; t += 2) {
            const bool last = (t == nt - 2);
            const char* a1 = cA + (size_t)(t + 1) * kstep;
            const char* a2 = last ? nA : cA + (size_t)(t + 2) * kstep; const char* b2 = last ? nB : cB + (size_t)(t + 2) * kstep;
            const char* a3 = a2 + kstep; const char* b3 = b2 + kstep;
            if (last && has_next) S.a_ready(nxt);
            if constexpr (SP2) {
            PG8_LDB(B0, 0, 0); PG8_LDB(B1, 0, 1); PG8_SCHED; PG8_LDA(At, 0, 0); PG8_STAGE(PG8_SA(1, 1), a1 + hstepA, voffA);
            PG8_WAIT_V(8); PG8_WAIT_L(0); PG8_BAR; PG8_MMA(0, 0, At, B0); PG8_MMA(0, 1, At, B1); PG8_BAR; PG8_SCHED;
            PG8_LDA(At, 0, 1); PG8_STAGE(PG8_SB(0, 0), b2, voffB); PG8_STAGE(PG8_SB(0, 1), b2 + hstepB, voffB); PG8_STAGE(PG8_SA(0, 0), a2, voffA);
            PG8_WAIT_V(8); PG8_WAIT_L(0); PG8_BAR; PG8_MMA(1, 0, At, B0); PG8_MMA(1, 1, At, B1); PG8_BAR; PG8_SCHED;
            PG8_LDB(B0, 1, 0); PG8_LDB(B1, 1, 1); PG8_SCHED; PG8_LDA(At, 1, 0); PG8_STAGE(PG8_SA(0, 1), a2 + hstepA, voffA);
            PG8_WAIT_V(8); PG8_WAIT_L(0); PG8_BAR; PG8_MMA(0, 0, At, B0); PG8_MMA(0, 1, At, B1); PG8_BAR; PG8_SCHED;
            PG8_LDA(At, 1, 1); PG8_STAGE(PG8_SB(1, 0), b3, voffB); PG8_STAGE(PG8_SB(1, 1), b3 + hstepB, voffB); PG8_STAGE(PG8_SA(1, 0), a3, voffA);
            PG8_WAIT_V(8); PG8_WAIT_L(0); PG8_BAR; PG8_MMA(1, 0, At, B0); PG8_MMA(1, 1, At, B1); PG8_BAR; PG8_SCHED;
            } else {
            PG8_LDB(B0, 0, 0); PG8_SCHED; PG8_LDA(At, 0, 0); PG8_STAGE(PG8_SA(1, 1), a1 + hstepA, voffA);
            PG8_WAIT_L(8); PG8_BAR; PG8_WAIT_L(0); PG8_MMA(0, 0, At, B0); PG8_BAR; PG8_SCHED;
            PG8_LDB(B1, 0, 1); PG8_STAGE(PG8_SB(0, 0), b2, voffB);
            PG8_BAR; PG8_WAIT_L(0); PG8_MMA(0, 1, At, B1); PG8_BAR;
            PG8_LDA(At, 0, 1); PG8_STAGE(PG8_SA(0, 0), a2, voffA);
            PG8_BAR; PG8_WAIT_L(0); PG8_MMA(1, 0, At, B0); PG8_BAR; PG8_SCHED;
            PG8_STAGE(PG8_SB(0, 1), b2 + hstepB, voffB);
            PG8_WAIT_V(6); PG8_BAR; PG8_MMA(1, 1, At, B1); PG8_BAR;
            PG8_LDB(B0, 1, 0); PG8_SCHED; PG8_LDA(At, 1, 0); PG8_STAGE(PG8_SA(0, 1), a2 + hstepA, voffA);
            PG8_WAIT_L(8); PG8_BAR; PG8_WAIT_L(0); PG8_MMA(0, 0, At, B0); PG8_BAR; PG8_SCHED;
            PG8_LDB(B1, 1, 1); PG8_STAGE(PG8_SB(1, 0), b3, voffB);
            PG8_BAR; PG8_WAIT_L(0); PG8_MMA(0, 1, At, B1); PG8_BAR;
            PG8_LDA(At, 1, 1); PG8_STAGE(PG8_SA(1, 0), a3, voffA);
            PG8_BAR; PG8_WAIT_L(0); PG8_MMA(1, 0, At, B0); PG8_BAR; PG8_SCHED;
            PG8_STAGE(PG8_SB(1, 1), b3 + hstepB, voffB);
            PG8_WAIT_V(6); PG8_BAR; PG8_MMA(1, 1, At, B1); PG8_BAR;
            }
        }
        }
        if constexpr (ALIGN_EPI) { if (wr == 0) PG8_BAR; }
        if constexpr (!Epi::AFTER_DRAIN) { E(acc, cur, wr, wc, fr, fq); S.done(cur); }
        if (!has_next) break;
#pragma unroll
        for (int a = 0; a < 2; ++a)
#pragma unroll
            for (int b = 0; b < 2; ++b)
#pragma unroll
                for (int m = 0; m < 4; ++m)
#pragma unroll
                    for (int n = 0; n < 2; ++n) acc[a][b][m][n] = (f32x4){0.f, 0.f, 0.f, 0.f};
        cur = nxt; cA = nA; cB = nB; ++ui;
        if constexpr (ALIGN_EPI) { if (wr == 1) PG8_BAR; }
    }
    PG8_WAIT_V(0);
    if constexpr (!ALIGN_EPI) { if (wr == 0) PG8_BAR; }
    PG8_BAR;
#undef PG8_SA
#undef PG8_SB
#undef PG8_STAGE
#undef PG8_LDA
#undef PG8_LDB
#undef PG8_MMA
#undef PG8_WAIT_V
#undef PG8_WAIT_L
#undef PG8_BAR
#undef PG8_SCHED
}
}

namespace att {
using bf16x8 = __attribute__((ext_vector_type(8))) short;
using s16x4  = __attribute__((ext_vector_type(4))) short;
using f32x16 = __attribute__((ext_vector_type(16))) float;
using f32x4  = __attribute__((ext_vector_type(4))) float;
using u32x4  = __attribute__((ext_vector_type(4))) unsigned;
typedef unsigned short bf16_t;
constexpr int NW = 8, QBLK = 32, KVBLK = 64;
constexpr int SHM_V = 8192, SHM_KN = 8192, SHM_KR = 4096;
constexpr int OFF_V = 0, OFF_KN = 2 * SHM_V, OFF_KR = OFF_KN + 2 * SHM_KN, OFF_WS = OFF_KR + 2 * SHM_KR, OFF_BIAS = OFF_WS + NW * 64 * 4 + 1024  , LDS_BYTES = OFF_BIAS + 15 * 32 * 4 + 1024;
#define ATT_SBAR() __builtin_amdgcn_sched_barrier(0)
__device__ __forceinline__ int crow(int r, int hi) { return (r & 3) + 8 * (r >> 2) + 4 * hi; }
__device__ __forceinline__ unsigned cvtpk(float lo, float hi) { return pg8::cvt_pk_bf16(lo, hi); }
__device__ __forceinline__ float bf2f(short s) { return __uint_as_float(((unsigned)(unsigned short)s) << 16); }
__device__ __forceinline__ int kn_off(int row, int chunk) { return row * 128 + ((chunk ^ ((row >> 1) & 7)) << 4); }
__device__ __forceinline__ int kr_off(int row, int chunk) { return row * 64 + ((chunk ^ ((row >> 2) & 3)) << 4); }
__device__ __forceinline__ int v_st(int k, int c) { const int kk = (k & ~0xC) | ((k & 4) << 1) | ((k & 8) >> 1); return ((kk >> 3) * 2 + (c >> 5)) * 512 + ((kk & 7) * 32 + (c & 31)) * 2; }
__device__ __forceinline__ int v_rd_base(int lane) { return ((lane & 3) << 3) | (((lane >> 2) & 3) << 6) | (((lane >> 4) & 1) << 5) | (((lane >> 5) & 1) << 8); }
constexpr int v_rd_off(int d0, int ks, int half) { return d0 * 512 + ks * 2048 + half * 1024; }
template <int OFF> __device__ __forceinline__ s16x4 tr_read(int vb) { s16x4 r; asm volatile("ds_read_b64_tr_b16 %0, %1 offset:%2" : "=&v"(r) : "v"(vb), "i"(OFF) : "memory"); return r; }

template <int D0> __device__ __forceinline__ void pv_one(f32x16& od, int vb, bf16x8 pa0, bf16x8 pa1, bf16x8 pa2, bf16x8 pa3) {
  const s16x4 l0 = tr_read<v_rd_off(D0, 0, 0)>(vb), h0 = tr_read<v_rd_off(D0, 0, 1)>(vb), l1 = tr_read<v_rd_off(D0, 1, 0)>(vb), h1 = tr_read<v_rd_off(D0, 1, 1)>(vb);
  const s16x4 l2 = tr_read<v_rd_off(D0, 2, 0)>(vb), h2 = tr_read<v_rd_off(D0, 2, 1)>(vb), l3 = tr_read<v_rd_off(D0, 3, 0)>(vb), h3 = tr_read<v_rd_off(D0, 3, 1)>(vb);
  asm volatile("s_waitcnt lgkmcnt(0)" ::: "memory"); ATT_SBAR();
#define ATT_PK(L, H) (bf16x8){L[0], L[1], L[2], L[3], H[0], H[1], H[2], H[3]}
  od = __builtin_amdgcn_mfma_f32_32x32x16_bf16(pa0, ATT_PK(l0, h0), od, 0, 0, 0);
  od = __builtin_amdgcn_mfma_f32_32x32x16_bf16(pa1, ATT_PK(l1, h1), od, 0, 0, 0);
  od = __builtin_amdgcn_mfma_f32_32x32x16_bf16(pa2, ATT_PK(l2, h2), od, 0, 0, 0);
  od = __builtin_amdgcn_mfma_f32_32x32x16_bf16(pa3, ATT_PK(l3, h3), od, 0, 0, 0);
#undef ATT_PK
}

template <int DKR> struct Cst { static constexpr float SCALE = DKR ? 0.10206207261596577f : 0.125f; static constexpr float C = SCALE * 1.4426950408889634f; };

template <int DKR> __device__ __forceinline__ void partialSM(f32x16& p0, f32x16& p1, float& m_reg, float& alpha) {
  constexpr float C = Cst<DKR>::C;
  float pmax = p0[0];
#pragma unroll
  for (int r = 1; r < 16; ++r) pmax = fmaxf(pmax, p0[r]);
#pragma unroll
  for (int r = 0; r < 16; ++r) pmax = fmaxf(pmax, p1[r]);
  { auto rr = __builtin_amdgcn_permlane32_swap(__float_as_uint(pmax), __float_as_uint(pmax), false, false);
    pmax = fmaxf(__uint_as_float(rr[0]), __uint_as_float(rr[1])); }
  float mn;
  if (__builtin_expect(__all((pmax - m_reg) * C <= 6.0f), 1)) { mn = m_reg; alpha = 1.f; }
  else { mn = fmaxf(m_reg, pmax); alpha = __builtin_amdgcn_exp2f((m_reg - mn) * C); m_reg = mn; }
  const float mnC = -mn * C;
#pragma unroll
  for (int r = 0; r < 16; ++r) p0[r] = fmaf(p0[r], C, mnC);
#pragma unroll
  for (int r = 0; r < 16; ++r) p1[r] = fmaf(p1[r], C, mnC);
#pragma unroll
  for (int r = 0; r < 16; ++r) p0[r] = __builtin_amdgcn_exp2f(p0[r]);
}
__device__ __forceinline__ void finishSM(f32x16& p0, f32x16& p1, float alpha, float& l_reg, bf16x8& pa0, bf16x8& pa1, bf16x8& pa2, bf16x8& pa3) {
#pragma unroll
  for (int r = 0; r < 16; ++r) p1[r] = __builtin_amdgcn_exp2f(p1[r]);
  float ps = 0;
#pragma unroll
  for (int r = 0; r < 16; ++r) ps += p0[r];
#pragma unroll
  for (int r = 0; r < 16; ++r) ps += p1[r];
  { auto rr = __builtin_amdgcn_permlane32_swap(__float_as_uint(ps), __float_as_uint(ps), false, false);
    ps = __uint_as_float(rr[0]) + __uint_as_float(rr[1]); }
  l_reg = l_reg * alpha + ps;
#define ATT_PK4(P, BASE, OUT) do { unsigned a0 = cvtpk(P[BASE + 0], P[BASE + 1]), a1 = cvtpk(P[BASE + 2], P[BASE + 3]);   \
    unsigned b0 = cvtpk(P[BASE + 4], P[BASE + 5]), b1 = cvtpk(P[BASE + 6], P[BASE + 7]);                              \
    auto r0 = __builtin_amdgcn_permlane32_swap(a0, b0, false, false); auto r1 = __builtin_amdgcn_permlane32_swap(a1, b1, false, false); \
    u32x4 w = {r0[0], r1[0], r0[1], r1[1]}; OUT = *reinterpret_cast<bf16x8*>(&w); } while (0)
  ATT_PK4(p0, 0, pa0); ATT_PK4(p0, 8, pa1); ATT_PK4(p1, 0, pa2); ATT_PK4(p1, 8, pa3);
#undef ATT_PK4
}
template <int DKR> __device__ __forceinline__ void qkt(f32x16& p0, f32x16& p1, const char* Kn, const char* Kr, const bf16x8* qr, int r32, int hi) {
  p0 = f32x16{}; p1 = f32x16{};
#pragma unroll
  for (int d0 = 0; d0 < 4; ++d0) {
    const bf16x8 b0 = *reinterpret_cast<const bf16x8*>(Kn + kn_off(r32, d0 * 2 + hi));
    const bf16x8 b1 = *reinterpret_cast<const bf16x8*>(Kn + kn_off(32 + r32, d0 * 2 + hi));
    p0 = __builtin_amdgcn_mfma_f32_32x32x16_bf16(b0, qr[d0], p0, 0, 0, 0);
    p1 = __builtin_amdgcn_mfma_f32_32x32x16_bf16(b1, qr[d0], p1, 0, 0, 0); }
  if constexpr (DKR != 0) {
#pragma unroll
    for (int d0 = 0; d0 < 2; ++d0) {
      const bf16x8 b0 = *reinterpret_cast<const bf16x8*>(Kr + kr_off(r32, d0 * 2 + hi));
      const bf16x8 b1 = *reinterpret_cast<const bf16x8*>(Kr + kr_off(32 + r32, d0 * 2 + hi));
      p0 = __builtin_amdgcn_mfma_f32_32x32x16_bf16(b0, qr[4 + d0], p0, 0, 0, 0);
      p1 = __builtin_amdgcn_mfma_f32_32x32x16_bf16(b1, qr[4 + d0], p1, 0, 0, 0); }
  }
}

__device__ __forceinline__ void na_mask(f32x16& p0, f32x16& p1, const char* brow_b, int a, bool tile_ok) {
  const float NEG = -INFINITY;
#pragma unroll
  for (int r = 0; r < 16; ++r) { const int cr = (r & 3) + 8 * (r >> 2);
    const float b0 = *reinterpret_cast<const float*>(brow_b + cr * 4), b1 = *reinterpret_cast<const float*>(brow_b + (cr + 32) * 4);
    const bool v0 = tile_ok && ((unsigned)(cr + a) < 16u), v1 = tile_ok && ((unsigned)(cr + 32 + a) < 16u);
    p0[r] = v0 ? fmaf(8.0f, b0, p0[r]) : NEG; p1[r] = v1 ? fmaf(8.0f, b1, p1[r]) : NEG; }
}
template <int DKR, bool NA = false>
__device__ __forceinline__ void attn_unit(const bf16_t* __restrict__ Qb, int ldq, const bf16_t* __restrict__ Kn, int ldk, const bf16_t* __restrict__ Kr, int ldkr,
                                          const bf16_t* __restrict__ Vh, int ldv, bf16_t* __restrict__ Ob, int ldo, int seq, const float* __restrict__ qtab, char* lds,
                                          int wave_s, const float* __restrict__ rpb_h = nullptr, int r0 = 0, int kstart = 0) {
  const int tid = tid_of(wave_s), wid = tid >> 6, lane = tid & 63, r32 = lane & 31, hi = lane >> 5;
  char* V_lds = lds + OFF_V; char* KN_lds = lds + OFF_KN; char* KR_lds = lds + OFF_KR;
  float* ws = (float*)(lds + OFF_WS) + wid * 64; float* li_l = ws; float* al_l = ws + 32;
  float m_reg = -1e30f, l_reg = 0; f32x16 o[2] = {}; bf16x8 qr[DKR ? 6 : 4];
  const bf16_t* Qw = Qb + (long)(wid * QBLK + r32) * ldq + hi * 8;
#pragma unroll
  for (int d0 = 0; d0 < 4; ++d0) qr[d0] = *reinterpret_cast<const bf16x8*>(Qw + d0 * 16);
  if constexpr (DKR != 0) {
    const bf16x8 x1 = *reinterpret_cast<const bf16x8*>(Qw + 64), x2 = *reinterpret_cast<const bf16x8*>(Qw + 80);
    const float* tb = qtab + (long)(wid * QBLK + r32) * 32 + hi * 8;
    const f32x4 c0 = *(const f32x4*)(tb), c1 = *(const f32x4*)(tb + 4), s0 = *(const f32x4*)(tb + 16), s1 = *(const f32x4*)(tb + 20);
    float y1[8], y2[8];
#pragma unroll
    for (int j = 0; j < 8; ++j) { const float a = bf2f(x1[j]), b = bf2f(x2[j]); const float cc = j < 4 ? c0[j & 3] : c1[j & 3], ss = j < 4 ? s0[j & 3] : s1[j & 3];
      y1[j] = a * cc - b * ss; y2[j] = b * cc + a * ss; }
    u32x4 w1 = {cvtpk(y1[0], y1[1]), cvtpk(y1[2], y1[3]), cvtpk(y1[4], y1[5]), cvtpk(y1[6], y1[7])};
    u32x4 w2 = {cvtpk(y2[0], y2[1]), cvtpk(y2[2], y2[3]), cvtpk(y2[4], y2[5]), cvtpk(y2[6], y2[7])};
    qr[4] = *reinterpret_cast<bf16x8*>(&w1); qr[5] = *reinterpret_cast<bf16x8*>(&w2);
  }
  const int sr = tid >> 3, sc8 = tid & 7, knst = kn_off(sr, sc8), vst = v_st(sr, sc8 * 8);
  const int rr_ = (tid >> 2) & 63, rc_ = tid & 3, krst = kr_off(rr_, rc_);
  const bool do_kr = (DKR != 0) && (tid < 256);
  const int vb0 = (int)(uintptr_t)V_lds + v_rd_base(lane);
  bf16x8 sK0, sV0, sR0, sK1, sV1, sR1;
  sR0 = bf16x8{}; sR1 = bf16x8{};
#define ATT_SLOAD(SK, SV, SR, k0) do { SK = *reinterpret_cast<const bf16x8*>(Kn + (long)((k0) + sr) * ldk + sc8 * 8); SV = *reinterpret_cast<const bf16x8*>(Vh + (long)((k0) + sr) * ldv + sc8 * 8); \
    if (do_kr) SR = *reinterpret_cast<const bf16x8*>(Kr + (long)((k0) + rr_) * ldkr + rc_ * 8); } while (0)
#define ATT_SWRITE(b, SK, SV, SR) do { *(bf16x8*)(V_lds + (b) * SHM_V + vst) = SV; *(bf16x8*)(KN_lds + (b) * SHM_KN + knst) = SK; \
    if (do_kr) *(bf16x8*)(KR_lds + (b) * SHM_KR + krst) = SR; } while (0)
#define ATT_RESC(a) do { if (__any((a) < 1.f)) { if (hi == 0) al_l[r32] = (a); asm volatile("s_waitcnt lgkmcnt(0)" ::: "memory"); \
    _Pragma("unroll") for (int d = 0; d < 2; ++d) _Pragma("unroll") for (int r = 0; r < 16; ++r) o[d][r] *= al_l[crow(r, hi)]; } } while (0)
  f32x16 pA0, pA1, pB0, pB1; float alA, alB; bf16x8 pa0, pa1, pa2, pa3; const int NT = seq / KVBLK;
  const int na_r = r0 + (wid >> 1), na_rs = min(max(na_r - 4, 0), 24), na_qc = (wid & 1) * 32 + r32, na_ws = min(max(na_qc - 8, 0), 48);
  const int na_a = 4 * hi - na_ws; const char* na_b0 = lds + OFF_BIAS + (4 * hi - na_qc + 15) * 4;
  if constexpr (NA) { float* bt = (float*)(lds + OFF_BIAS); if (tid < 15 * 32) bt[tid] = ((tid & 31) < 31) ? rpb_h[(tid >> 5) * 31 + (tid & 31)] : 0.f; }
#define ATT_NAMASK(P0, P1, t) do { if constexpr (NA) { const int kr_ = kstart + (t); const bool ok_ = (unsigned)(kr_ - na_rs) < 8u; const int ro_ = min(max(kr_ - na_r + 7, 0), 14); \
    na_mask(P0, P1, na_b0 + ro_ * 128, na_a, ok_); } } while (0)
  ATT_SLOAD(sK0, sV0, sR0, 0); ATT_SWRITE(0, sK0, sV0, sR0); __syncthreads();
  qkt<DKR>(pA0, pA1, KN_lds, KR_lds, qr, r32, hi); ATT_NAMASK(pA0, pA1, 0); partialSM<DKR>(pA0, pA1, m_reg, alA);
  ATT_SLOAD(sK1, sV1, sR1, KVBLK); if (2 < NT) ATT_SLOAD(sK0, sV0, sR0, 2 * KVBLK);
  ATT_SWRITE(1, sK1, sV1, sR1); __syncthreads();
  for (int j = 1; j + 1 < NT; j += 2) {
    ATT_SBAR(); qkt<DKR>(pB0, pB1, KN_lds + SHM_KN, KR_lds + SHM_KR, qr, r32, hi); ATT_NAMASK(pB0, pB1, j);
    finishSM(pA0, pA1, alA, l_reg, pa0, pa1, pa2, pa3); ATT_SBAR();
    ATT_SLOAD(sK1, sV1, sR1, (j + 2) * KVBLK); ATT_SBAR();
    pv_one<0>(o[0], vb0, pa0, pa1, pa2, pa3); pv_one<1>(o[1], vb0, pa0, pa1, pa2, pa3); partialSM<DKR>(pB0, pB1, m_reg, alB);
    __syncthreads(); ATT_SWRITE(0, sK0, sV0, sR0);
    ATT_RESC(alB); __syncthreads();
    ATT_SBAR(); qkt<DKR>(pA0, pA1, KN_lds, KR_lds, qr, r32, hi); ATT_NAMASK(pA0, pA1, j + 1);
    finishSM(pB0, pB1, alB, l_reg, pa0, pa1, pa2, pa3); ATT_SBAR();
    if (j + 3 < NT) ATT_SLOAD(sK0, sV0, sR0, (j + 3) * KVBLK); ATT_SBAR();
    pv_one<0>(o[0], vb0 + SHM_V, pa0, pa1, pa2, pa3); pv_one<1>(o[1], vb0 + SHM_V, pa0, pa1, pa2, pa3); partialSM<DKR>(pA0, pA1, m_reg, alA);
    __syncthreads(); ATT_SWRITE(1, sK1, sV1, sR1);
    ATT_RESC(alA); __syncthreads();
  }
  ATT_SBAR(); qkt<DKR>(pB0, pB1, KN_lds + SHM_KN, KR_lds + SHM_KR, qr, r32, hi); ATT_NAMASK(pB0, pB1, NT - 1);
  finishSM(pA0, pA1, alA, l_reg, pa0, pa1, pa2, pa3); ATT_SBAR();
  pv_one<0>(o[0], vb0, pa0, pa1, pa2, pa3); pv_one<1>(o[1], vb0, pa0, pa1, pa2, pa3); partialSM<DKR>(pB0, pB1, m_reg, alB);
  __syncthreads(); ATT_RESC(alB);
  finishSM(pB0, pB1, alB, l_reg, pa0, pa1, pa2, pa3); ATT_SBAR();
  pv_one<0>(o[0], vb0 + SHM_V, pa0, pa1, pa2, pa3); pv_one<1>(o[1], vb0 + SHM_V, pa0, pa1, pa2, pa3);
  if (hi == 0) li_l[r32] = l_reg; asm volatile("s_waitcnt lgkmcnt(0)" ::: "memory");
  float rli[16];
#pragma unroll
  for (int r = 0; r < 16; ++r) rli[r] = __builtin_amdgcn_rcpf(li_l[crow(r, hi)]);
  bf16_t* Ow = Ob + (long)(wid * QBLK) * ldo;
#pragma unroll
  for (int r = 0; r < 16; ++r) { const int orow = crow(r, hi);
#pragma unroll
    for (int d0 = 0; d0 < 2; ++d0) { const float v = o[d0][r] * rli[r]; Ow[(long)orow * ldo + d0 * 32 + r32] = (bf16_t)(cvtpk(v, v) & 0xffffu); } }
  __syncthreads();
#undef ATT_SLOAD
#undef ATT_SWRITE
#undef ATT_RESC
#undef ATT_NAMASK
}
#undef ATT_SBAR
}

constexpr int NWAVES = 8;
constexpr int BATCH = 8, SEQ = 2048, DM = 1024, DEPTH = 2, M = BATCH * SEQ;
constexpr int GRID_W = 64, NROWS = SEQ / GRID_W;
constexpr int IN_COLS = 5024, N1 = 2048  , NG = 3072, N1_USED = 1952;
constexpr int FFN = 2816, NMOD = 6;
constexpr float NORM_EPS = 1e-6f;
constexpr int C_QA = 0, C_KA = 256, C_VA = 512, C_VC = 768;
constexpr int C_CQ = 768, C_CKV = 1024, C_KR = 1152, C_QC = 1184, C_KC = 1696;

constexpr size_t MiB = 1u << 20;
constexpr size_t WS_CTL = 0, CTL_ZERO_BYTES = 64 * 1024;
constexpr size_t WS_MOD = 1 * MiB;
constexpr size_t WS_TABT = WS_MOD + 512 * 1024;
constexpr size_t WS_TABA = WS_TABT + 256 * 1024;
constexpr size_t WS_W = 2 * MiB;
constexpr size_t W_1 = 0, W_G = W_1 + (size_t)N1 * DM * 2, W_2 = W_G + (size_t)NG * DM * 2, W_BNA = W_2 + (size_t)1024 * 384 * 2, W_BMLA = W_BNA + (size_t)1024 * 256 * 2,
                 W_BGQA = W_BMLA + (size_t)1024 * 256 * 2, W_OUT = W_BGQA + (size_t)1024 * 512 * 2, W_GU = W_OUT + (size_t)1024 * 1024 * 2, W_DN = W_GU + (size_t)2 * FFN * DM * 2,
                 LAYER_W_BYTES = W_DN + (size_t)DM * FFN * 2;
static_assert(LAYER_W_BYTES == 32768000, "weights per layer");
constexpr size_t WS_ROWSS_A = 64 * MiB + 512 * 1024, WS_ROWSS_B = WS_ROWSS_A + 256 * 1024;
constexpr size_t WS_BIAS = WS_ROWSS_B + 256 * 1024;
constexpr int NB1 = N1, NBG = NG, NBGU = 2 * FFN, BIAS_PER_LAYER = 8 * (NB1 + NBG + NBGU);
constexpr size_t OUT_OCAT = 0, OUT_A2 = 0, OUT_XG2 = 32 * MiB;
constexpr size_t WS_XB = 98 * MiB;
constexpr size_t WS_H = 66 * MiB;
constexpr size_t WS_P1 = 130 * MiB;
constexpr size_t WS_KPE = 194 * MiB;
constexpr size_t WS_QC = 195 * MiB;
constexpr size_t WS_KC = 211 * MiB;
constexpr size_t WS_P2 = 215 * MiB;
constexpr size_t WS_OCAT_UNUSED = 0;
constexpr size_t WS_A2_UNUSED = 0;
constexpr size_t WS_GATES = 130 * MiB;
constexpr size_t WS_ACT = 130 * MiB;
constexpr size_t WS_END = 247 * MiB;
static_assert(WS_W + 2 * LAYER_W_BYTES <= WS_ROWSS_A && WS_BIAS + (size_t)2 * BIAS_PER_LAYER * 4 <= WS_H && WS_H + (size_t)M * DM * 2 <= WS_XB && WS_XB + (size_t)M * DM * 2 <= WS_P1 && WS_P2 + (size_t)M * DM * 2 <= WS_END && WS_GATES + (size_t)M * NG * 2 <= WS_END && WS_ACT + (size_t)M * FFN * 2 <= WS_END, "ws map");
constexpr int CW_BAR = 4096;

constexpr int RING_OFF = 0, RING_BYTES = 131072;
constexpr int LDSCTL_OFF = RING_BYTES, MISC_OFF = LDSCTL_OFF + 320;
constexpr int EPIX_OFF = 132096;
constexpr int LDS_BYTES = 147456;

#define GAS __attribute__((address_space(1)))
#define LAS __attribute__((address_space(3)))
typedef unsigned short bf16;
typedef unsigned v4u __attribute__((ext_vector_type(4)));
typedef unsigned v2u __attribute__((ext_vector_type(2)));
typedef float f32x4 __attribute__((ext_vector_type(4)));
typedef short bf16x8 __attribute__((ext_vector_type(8)));
typedef GAS unsigned gu32;
#define RLX_AGENT __ATOMIC_RELAXED, __HIP_MEMORY_SCOPE_AGENT
#define LDS_WAIT() asm volatile("s_waitcnt lgkmcnt(0)" ::: "memory")
__device__ __forceinline__ unsigned f2bf(float f) { unsigned u = __builtin_bit_cast(unsigned, f); return (u + 0x7fffu + ((u >> 16) & 1u)) >> 16; }
__device__ __forceinline__ unsigned pk2(float lo, float hi) { return f2bf(lo) | (f2bf(hi) << 16); }
__device__ __forceinline__ float bflo(unsigned w) { return __uint_as_float(w << 16); }
__device__ __forceinline__ float bfhi(unsigned w) { return __uint_as_float(w & 0xffff0000u); }
__device__ __forceinline__ float bf1(bf16 s) { return __uint_as_float(((unsigned)s) << 16); }

#define XB_TMO      128
#define XB_XCNT(j)  (256  + 64 * (j))
#define XB_XSUB(j)  (1280 + 64 * (j))
#define XB_XGEN(j)  (2304 + 64 * (j))
#define XB_TOP      3328
#define XB_TOPGEN   3392
#define XCD_BAR_WORDS 3456
#define XB_SPIN_CAP (1u << 18)
__device__ __forceinline__ unsigned xb_ld(unsigned* p)              { return __hip_atomic_load(p, __ATOMIC_RELAXED, __HIP_MEMORY_SCOPE_AGENT); }
__device__ __forceinline__ unsigned xb_add(unsigned* p, unsigned v) { return __hip_atomic_fetch_add(p, v, __ATOMIC_RELAXED, __HIP_MEMORY_SCOPE_AGENT); }
__device__ __forceinline__ unsigned xb_xcc_id() { return (unsigned)__builtin_amdgcn_s_getreg((3 << 11) | 20) & 0xFu; }
#define XB_SPIN(cond, bar) do { unsigned _sp = 0; while (cond) { __builtin_amdgcn_s_sleep(1); \
    if ((++_sp & 255u) == 0u) { if (xb_ld(&(bar)[XB_TMO])) break; if (_sp > XB_SPIN_CAP) { atomicAdd(&(bar)[XB_TMO], 1u); break; } } } } while (0)
struct XcdBarrier { unsigned* bar; unsigned x; volatile LAS unsigned* st; };
__device__ __forceinline__ XcdBarrier xcd_barrier_post(unsigned* bar, volatile LAS unsigned* st) {
    XcdBarrier b; b.bar = bar; b.x = xb_xcc_id(); b.st = st;
    if (threadIdx.x == 0) (void)xb_add(&bar[XB_XCNT(b.x)], 1u);
    return b;
}
__device__ __forceinline__ void xcd_barrier_complete(unsigned* bar, unsigned x, unsigned& nloc, unsigned& nx) {
    const unsigned G = gridDim.x * gridDim.y * gridDim.z;
    unsigned sum, cnt, mine, sp = 0u;
    for (;;) {
        sum = 0u; cnt = 0u; mine = 0u;
#pragma unroll
        for (unsigned j = 0; j < 16; ++j) { const unsigned c = xb_ld(&bar[XB_XCNT(j)]); sum += c; cnt += (c > 0u) ? 1u : 0u; mine = (j == x) ? c : mine; }
        if (sum == G) break;
        __builtin_amdgcn_s_sleep(1);
        if ((++sp & 255u) == 0u) { if (xb_ld(&bar[XB_TMO])) break; if (sp > XB_SPIN_CAP) { atomicAdd(&bar[XB_TMO], 1u); break; } }
    }
    nloc = mine > 0u ? mine : 1u; nx = cnt > 0u ? cnt : 1u;
}
__device__ __forceinline__ void xcd_barrier(const XcdBarrier& b, int wave_s) {
    asm volatile("s_waitcnt vmcnt(0)" ::: "memory");
    __syncthreads();
    if (tid_of(wave_s) == 0) {
        GAS unsigned* barg = (GAS unsigned*)b.bar; asm volatile("" : "+s"(barg)); unsigned* bar = (unsigned*)barg;
        __builtin_amdgcn_s_waitcnt(0);
        unsigned nloc = b.st[0], nx = b.st[1];
        if (nloc == 0u) { xcd_barrier_complete(bar, b.x, nloc, nx); b.st[0] = nloc; b.st[1] = nx; }
        const unsigned old = xb_add(&bar[XB_XSUB(b.x)], 1u);
        const unsigned gen = old / nloc;
        if (old + 1u == (gen + 1u) * nloc) {
            __builtin_amdgcn_fence(__ATOMIC_RELEASE, "agent");
            asm volatile("s_waitcnt vmcnt(0)" ::: "memory");
            const unsigned og = xb_add(&bar[XB_TOP], 1u);
            const unsigned tg = og / nx;
            if (og + 1u == (tg + 1u) * nx) xb_add(&bar[XB_TOPGEN], 1u);
            else XB_SPIN(xb_ld(&bar[XB_TOPGEN]) == tg, bar);
            __builtin_amdgcn_fence(__ATOMIC_ACQUIRE, "agent");
            xb_add(&bar[XB_XGEN(b.x)], 1u);
            asm volatile("s_waitcnt vmcnt(0)" ::: "memory");
        } else {
            XB_SPIN(xb_ld(&bar[XB_XGEN(b.x)]) == gen, bar);
            __builtin_amdgcn_fence(__ATOMIC_ACQUIRE, "agent");
            asm volatile("s_waitcnt vmcnt(0)" ::: "memory");
        }
    }
    __syncthreads();
}

struct Args { const float* in[21]; float* out; unsigned char* ws; int ph_lo, ph_hi; };
struct LayerW { bf16 *w1, *wg, *w2, *bna, *bmla, *bgqa, *wout, *wgu, *wdn; };
__device__ __forceinline__ LayerW layer_w(unsigned char* ws, int l) {
    unsigned char* b = ws + WS_W + (size_t)l * LAYER_W_BYTES; LayerW w;
    w.w1 = (bf16*)(b + W_1); w.wg = (bf16*)(b + W_G); w.w2 = (bf16*)(b + W_2); w.bna = (bf16*)(b + W_BNA); w.bmla = (bf16*)(b + W_BMLA); w.bgqa = (bf16*)(b + W_BGQA);
    w.wout = (bf16*)(b + W_OUT); w.wgu = (bf16*)(b + W_GU); w.wdn = (bf16*)(b + W_DN); return w;
}
__device__ __forceinline__ float wave_sum(float v) {
#pragma unroll
    for (int o = 1; o < 64; o <<= 1) v += __shfl_xor(v, o);
    return v;
}
__device__ __forceinline__ void sincos_d(double x, double& s, double& c) {
    const double k = __builtin_rint(x * 0.15915494309189535);
    double r = __builtin_fma(-k, 6.283185307179586, x); r = __builtin_fma(-k, 2.4492935982947064e-16, r);
    const double r2 = r * r; double tc = 1.0, ts = 1.0, cs = 1.0, ss = 1.0;
#pragma unroll 1
    for (int n = 1; n <= 15; ++n) { tc *= -r2 / (double)((2 * n - 1) * (2 * n)); cs += tc; ts *= -r2 / (double)((2 * n) * (2 * n + 1)); ss += ts; }
    s = r * ss; c = cs;
}
__device__ __forceinline__ float inv_freq(int i) {
    const float q[4] = {1.0f, 0.5623413251903491f, 0.31622776601683794f, 0.17782794100389228f};
    const float p[4] = {1.0f, 0.1f, 0.01f, 0.001f};
    float a = (i & 3) == 0 ? q[0] : (i & 3) == 1 ? q[1] : (i & 3) == 2 ? q[2] : q[3];
    float b = (i >> 2) == 0 ? p[0] : (i >> 2) == 1 ? p[1] : (i >> 2) == 2 ? p[2] : p[3];
    return (float)((double)a * (double)b);
}

template <class RowPtr>
__device__ __forceinline__ void transpose_item(const float* W, int N, int k0, int n0, const RowPtr& rp, LAS float* scr, int lane) {
#pragma unroll 8
    for (int i = 0; i < 32; ++i) { const int kk = 2 * i + (lane >> 5); scr[kk * 33 + (lane & 31)] = W[(size_t)(k0 + kk) * N + n0 + (lane & 31)]; }
    LDS_WAIT(); asm volatile("" ::: "memory");
    const int c = lane & 7;
#pragma unroll
    for (int j = 0; j < 4; ++j) { const int n = (lane >> 3) + 8 * j; const LAS float* s = scr + (8 * c) * 33 + n;
        v4u o; o.x = pk2(s[0 * 33], s[1 * 33]); o.y = pk2(s[2 * 33], s[3 * 33]); o.z = pk2(s[4 * 33], s[5 * 33]); o.w = pk2(s[6 * 33], s[7 * 33]);
        *(GAS v4u*)(rp(n0 + n) + k0 + 8 * c) = o; }
    LDS_WAIT(); asm volatile("" ::: "memory");
}
struct RpPlain { bf16* base; int ld; int roff; int koff; __device__ __forceinline__ bf16* operator()(int n) const { return base + (size_t)(n + roff) * ld + koff; } };
struct RpWin { bf16* w1; bf16* wg; __device__ __forceinline__ bf16* operator()(int n) const {
    if (n >= N1_USED) return wg + (size_t)(n - N1_USED) * DM;
    int row;
    if (n < 1152) row = n;
    else if (n < 1184) { const int j = n - 1152, nn = j >> 4, i = j & 15; row = 1024 + 128 + 8 * (i >> 2) + 4 * nn + (i & 3); }
    else if (n < 1824) { const bool kc = n >= 1696; const int j = kc ? n - 1696 : n - 1184, head = j >> 6, d = j & 63, nn = d >> 5, bj = (d >> 4) & 1, i = d & 15, r = 8 * (i >> 2) + 4 * nn + (i & 3);
        const int tile = kc ? 7 : 5 + (head >> 2), wc = kc ? head : (head & 3); row = tile * 256 + bj * 128 + wc * 32 + r; }
    else { const int j = n - 1824, head = j >> 6, d = j & 63; row = 7 * 256 + (d >> 5) * 128 + (2 + head) * 32 + (d & 31); }
    return w1 + (size_t)row * DM; } };
struct RpGU { bf16* base; __device__ __forceinline__ bf16* operator()(int n) const { const int j = n < FFN ? n : n - FFN; return base + (size_t)(256 * (j >> 7) + (n < FFN ? 0 : 128) + (j & 127)) * DM; } };


#define CHK(ST) do { } while (0)

__global__ void __launch_bounds__(NWAVES * 64, 2) hybrid_fwd(Args args) {
    extern __shared__ __attribute__((aligned(16))) unsigned char lds[];
    LAS unsigned char* ldsl = (LAS unsigned char*)lds;
    volatile LAS unsigned* MISC = (volatile LAS unsigned*)(ldsl + MISC_OFF);
    const int tid = threadIdx.x, lane = tid & 63, wave = __builtin_amdgcn_readfirstlane(tid >> 6);
    const int G = gridDim.x; const int bx = blockIdx.x; const int vcu = (G % 8 == 0) ? (bx % 8) * (G / 8) + bx / 8 : bx;
    if (G != 256) return;
    unsigned char* ws = args.ws;
    gu32* ctl = (gu32*)(ws + WS_CTL);
    for (int u = tid; u < (LDS_BYTES - LDSCTL_OFF) / 4; u += NWAVES * 64) ((LAS unsigned*)(ldsl + LDSCTL_OFF))[u] = 0u;
    __syncthreads();
    XcdBarrier bar = xcd_barrier_post((unsigned*)(ctl + CW_BAR), MISC + 8);
    const int gw0 = vcu * NWAVES + wave;
    const int lo = args.ph_lo, hi = args.ph_hi; int ph = 0;
    unsigned long long* tstamp = (unsigned long long*)(ws + 32768);
    if (TIMING && blockIdx.x == 0 && tid_of(wave) == 0) tstamp[0] = __builtin_amdgcn_s_memrealtime();
#ifndef PROBE_MASK
#define PROBE_MASK 0
#endif
#define PHASE_BEGIN(ID) if (lo <= ph && ph < hi) { for (int rep_ = 0; rep_ < 1 + (int)(((PROBE_MASK >> (ID)) & 1) && !((ID) == 8 && ph > 11)); ++rep_) { if (rep_) xcd_barrier(bar, wave);
#define PHASE_END() } if (TIMING || ph + 1 < hi) xcd_barrier(bar, wave); } ++ph; if (TIMING && blockIdx.x == 0 && tid_of(wave) == 0) tstamp[ph] = __builtin_amdgcn_s_memrealtime();

    float* modp = (float*)(ws + WS_MOD); float* tabt = (float*)(ws + WS_TABT); float* taba = (float*)(ws + WS_TABA);
    bf16* Hb = (bf16*)(ws + WS_H); bf16* P1 = (bf16*)(ws + WS_P1); bf16* KPE = (bf16*)(ws + WS_KPE); bf16* QC = (bf16*)(ws + WS_QC); bf16* KC = (bf16*)(ws + WS_KC);
    bf16* P2 = (bf16*)(ws + WS_P2); bf16* OCAT = (bf16*)((unsigned char*)args.out + OUT_OCAT); bf16* A2 = (bf16*)((unsigned char*)args.out + OUT_A2); bf16* GATES = (bf16*)(ws + WS_GATES); bf16* ACT = (bf16*)(ws + WS_ACT);
    const float* x_in = args.in[0]; float* xres = args.out; (void)xres;
    float* rowss_a = (float*)(ws + WS_ROWSS_A); float* rowss_b = (float*)(ws + WS_ROWSS_B); float* biasp = (float*)(ws + WS_BIAS); bf16* XG2 = (bf16*)((unsigned char*)args.out + OUT_XG2); bf16* XB = (bf16*)(ws + WS_XB);

    PHASE_BEGIN(0)
    { const int tid = tid_of(wave), lane = tid & 63, bx = opaque_s((int)blockIdx.x), G = opaque_s((int)gridDim.x), gw = opaque_s(gw0), NGW = G * NWAVES; (void)lane; (void)bx; (void)G; (void)gw; (void)NGW;
        LAS float* sc = (LAS float*)(ldsl + RING_OFF);
        const float* cin = args.in[1];
        for (int i = tid; i < BATCH * DM; i += NWAVES * 64) { const int b = i / DM, k = i % DM; const float v = cin[i]; sc[k * 8 + b] = v / (1.0f + __expf(-v)); }
        __syncthreads();
        if (bx < 192) {
            const int l = bx / 96, cg = bx % 96; const float* W = args.in[2] + (size_t)l * DM * (NMOD * DM) + cg * 64 + lane + (size_t)(wave * 128) * (NMOD * DM);
            LAS float* part = (LAS float*)(ldsl + RING_OFF + 102400);
            float acc[8];
#pragma unroll
            for (int b = 0; b < 8; ++b) acc[b] = 0.f;
#pragma unroll 16
            for (int k = 0; k < 128; ++k) { const float w = W[(size_t)k * (NMOD * DM)]; const int kk = wave * 128 + k; const f32x4 s0 = *(const LAS f32x4*)(sc + kk * 8), s1 = *(const LAS f32x4*)(sc + kk * 8 + 4);
                acc[0] += s0[0] * w; acc[1] += s0[1] * w; acc[2] += s0[2] * w; acc[3] += s0[3] * w; acc[4] += s1[0] * w; acc[5] += s1[1] * w; acc[6] += s1[2] * w; acc[7] += s1[3] * w; }
#pragma unroll
            for (int b = 0; b < 8; ++b) part[(wave * 8 + b) * 64 + lane] = acc[b];
            __syncthreads();
            {
                const int b = tid >> 6; float v = args.in[3][(size_t)l * NMOD * DM + cg * 64 + lane];
#pragma unroll
                for (int w8 = 0; w8 < 8; ++w8) v += part[(w8 * 8 + b) * 64 + lane];
                modp[((size_t)l * BATCH + b) * (NMOD * DM) + cg * 64 + lane] = v;
            }
        }
        for (int i = bx * NWAVES * 64 + tid; i < (SEQ + 64) * 16; i += G * NWAVES * 64) {
            const int p = i >> 4, fi = i & 15; const int pos = p < SEQ ? p : p - SEQ; float* dst = p < SEQ ? tabt + (size_t)p * 32 : taba + (size_t)(p - SEQ) * 32;
            const float ang = (float)pos * inv_freq(fi); double s, c; sincos_d((double)ang, s, c); dst[fi] = (float)c; dst[16 + fi] = (float)s;
        }
        LAS float* scr = (LAS float*)(ldsl + RING_OFF + 32768 + wave * 8704);
        for (int l = 0; l < DEPTH; ++l) {
            const LayerW w = layer_w(ws, l);
            constexpr int I_IN = 16 * 157, I_UQ = 4 * 12, I_UKV = 2 * 16, I_BNA = 4 * 32, I_BMLA = 4 * 32, I_BGQA = 8 * 32, I_OUT = 16 * 32, I_GU = 16 * 176, I_DN = 44 * 32;
            constexpr int NITEMS = I_IN + I_UQ + I_UKV + I_BNA + I_BMLA + I_BGQA + I_OUT + I_GU + I_DN;
            for (int it = gw; it < NITEMS; it += NGW) {
                int r = it;
                if (r < I_IN)  { transpose_item(args.in[6] + (size_t)l * DM * IN_COLS, IN_COLS, 64 * (r / 157), 32 * (r % 157), RpWin{w.w1, w.wg}, scr, lane); continue; } r -= I_IN;
                if (r < I_UQ)  { transpose_item(args.in[10] + (size_t)l * 256 * 384, 384, 64 * (r / 12), 32 * (r % 12), RpPlain{w.w2, 384, 0, 0}, scr, lane); continue; } r -= I_UQ;
                if (r < I_UKV) { transpose_item(args.in[11] + (size_t)l * 128 * 512, 512, 64 * (r / 16), 32 * (r % 16), RpPlain{w.w2, 384, 384, 256}, scr, lane); continue; } r -= I_UKV;
                if (r < I_BNA) { transpose_item(args.in[14] + (size_t)l * 256 * 1024, 1024, 64 * (r / 32), 32 * (r % 32), RpPlain{w.bna, 1024, 0, 0}, scr, lane); continue; } r -= I_BNA;
                if (r < I_BMLA){ transpose_item(args.in[15] + (size_t)l * 256 * 1024, 1024, 64 * (r / 32), 32 * (r % 32), RpPlain{w.bna, 1024, 0, 256}, scr, lane); continue; } r -= I_BMLA;
                if (r < I_BGQA){ transpose_item(args.in[16] + (size_t)l * 512 * 1024, 1024, 64 * (r / 32), 32 * (r % 32), RpPlain{w.bna, 1024, 0, 512}, scr, lane); continue; } r -= I_BGQA;
                if (r < I_OUT) { transpose_item(args.in[17] + (size_t)l * 1024 * 1024, 1024, 64 * (r / 32), 32 * (r % 32), RpPlain{w.wout, 1024, 0, 0}, scr, lane); continue; } r -= I_OUT;
                if (r < I_GU)  { transpose_item(args.in[18] + (size_t)l * DM * 2 * FFN, 2 * FFN, 64 * (r / 176), 32 * (r % 176), RpGU{w.wgu}, scr, lane); continue; } r -= I_GU;
                transpose_item(args.in[19] + (size_t)l * FFN * DM, DM, 64 * (r / 32), 32 * (r % 32), RpPlain{w.wdn, FFN, 0, 0}, scr, lane);
            }
            const v4u z = {0u, 0u, 0u, 0u};
            for (int i = bx * NWAVES * 64 + tid; i < 96 * 128; i += G * NWAVES * 64) *(GAS v4u*)(w.w1 + (size_t)(1024 + 160) * DM + (size_t)i * 8) = z;
            for (int i = bx * NWAVES * 64 + tid; i < 1024 * 48; i += G * NWAVES * 64) { const int row = i / 48, ch = i % 48, col = ch * 8;
                const bool zero = row < 384 ? (col >= 256) : row < 896 ? (col < 256) : true;
                if (zero) *(GAS v4u*)(w.w2 + (size_t)row * 384 + col) = z; }
        }
    }
    PHASE_END()
    { const int l_chk = 0; (void)l_chk; CHK(0); CHK(1); }

    PHASE_BEGIN(1)
    { const int tid = tid_of(wave), lane = tid & 63, bx = opaque_s((int)blockIdx.x), G = opaque_s((int)gridDim.x), gw = opaque_s(gw0), NGW = G * NWAVES; (void)lane; (void)bx; (void)G; (void)gw; (void)NGW;
        constexpr int ROWS_PER_LAYER = NB1 + NBG + NBGU, TASKS_PER_LAYER = ROWS_PER_LAYER / 16;
        for (int tk = gw; tk < DEPTH * TASKS_PER_LAYER; tk += NGW) {
            const int l = tk / TASKS_PER_LAYER, r0 = (tk % TASKS_PER_LAYER) * 16, n = lane & 15, q = lane >> 4; const LayerW w = layer_w(ws, l);
            const bf16* wrow; float* bout; int which, nb;
            if (r0 < NB1) { wrow = w.w1 + (size_t)(r0 + n) * DM; bout = biasp + (size_t)l * BIAS_PER_LAYER + r0 + n; which = 0; nb = NB1; }
            else if (r0 < NB1 + NBG) { wrow = w.wg + (size_t)(r0 - NB1 + n) * DM; bout = biasp + (size_t)l * BIAS_PER_LAYER + 8 * NB1 + (r0 - NB1) + n; which = 0; nb = NBG; }
            else { wrow = w.wgu + (size_t)(r0 - NB1 - NBG + n) * DM; bout = biasp + (size_t)l * BIAS_PER_LAYER + 8 * (NB1 + NBG) + (r0 - NB1 - NBG) + n; which = 3; nb = NBGU; }
            const float* sp = modp + ((size_t)l * BATCH + (n & 7)) * NMOD * DM + which * DM + 8 * q; wrow += 8 * q;
            f32x4 acc = {0.f, 0.f, 0.f, 0.f};
#pragma unroll 8
            for (int k = 0; k < DM; k += 32) { const bf16x8 bfrag = *(const bf16x8*)(wrow + k); const f32x4 s0 = *(const f32x4*)(sp + k), s1 = *(const f32x4*)(sp + k + 4);
                v4u aw; aw.x = pk2(s0[0], s0[1]); aw.y = pk2(s0[2], s0[3]); aw.z = pk2(s1[0], s1[1]); aw.w = pk2(s1[2], s1[3]); if (n >= 8) aw = (v4u){0u, 0u, 0u, 0u};
                acc = __builtin_amdgcn_mfma_f32_16x16x32_bf16(__builtin_bit_cast(bf16x8, aw), bfrag, acc, 0, 0, 0); }
            if (q < 2) {
#pragma unroll
                for (int e = 0; e < 4; ++e) bout[(size_t)(4 * q + e) * nb] = acc[e]; }
        }
        {
            const float* g = args.in[4]; const float* mod0 = modp;
            for (int m = gw; m < M; m += NGW) {
                const int b = m / SEQ; const float* xr = x_in + (size_t)m * DM; const float* scl = mod0 + (size_t)b * NMOD * DM + DM;
                f32x4 v[4]; float sq = 0.f;
#pragma unroll
                for (int j = 0; j < 4; ++j) { v[j] = *(const f32x4*)(xr + 256 * j + 4 * lane); sq += (v[j][0] * v[j][0] + v[j][1] * v[j][1]) + (v[j][2] * v[j][2] + v[j][3] * v[j][3]); }
                sq = wave_sum(sq); if (lane == 0) *(f32x4*)(rowss_a + 4 * (size_t)m) = (f32x4){sq, 0.f, 0.f, 0.f};
#pragma unroll
                for (int j = 0; j < 4; ++j) { const int c = 256 * j + 4 * lane; const f32x4 gg = *(const f32x4*)(g + c), s1 = *(const f32x4*)(scl + c);
                    v2u o; o.x = pk2(v[j][0] * gg[0] * (1.0f + s1[0]), v[j][1] * gg[1] * (1.0f + s1[1])); o.y = pk2(v[j][2] * gg[2] * (1.0f + s1[2]), v[j][3] * gg[3] * (1.0f + s1[3])); *(v2u*)(Hb + (size_t)m * DM + c) = o; }
            }
        }
    }
    PHASE_END()

    for (int l = 0; l < DEPTH; ++l) {
        const LayerW w = layer_w(ws, l);
        const float* mod = modp + (size_t)l * BATCH * NMOD * DM;
        const int l_chk = l; (void)l_chk;

        PHASE_BEGIN(2)
        { const int tid = tid_of(wave), lane = tid & 63, bx = opaque_s((int)blockIdx.x), G = opaque_s((int)gridDim.x), gw = opaque_s(gw0), NGW = G * NWAVES; (void)lane; (void)bx; (void)G; (void)gw; (void)NGW;
            pg8::Gemm g{Hb, w.w1, M, N1, DM, DM, DM}; pg8::StaticOrder S; S.init(M, N1, G, bx);
            pg8::EpiProj1 E{P1, N1, C_VC, rowss_a, biasp + (size_t)l * BIAS_PER_LAYER, NB1, SEQ, A2, KPE, QC, KC, args.in[8] + (size_t)l * 256, args.in[9] + (size_t)l * 128,
                            args.in[12] + (size_t)l * 64, args.in[13] + (size_t)l * 64, tabt, taba, (LAS float*)(ldsl + EPIX_OFF)};
            pg8::gemm_phase<pg8::EpiProj1, pg8::StaticOrder, true, true>(ldsl + RING_OFF, g, S, E, wave);
        }
        PHASE_END()
        CHK(3);

        PHASE_BEGIN(4)
        { const int tid = tid_of(wave), lane = tid & 63, bx = opaque_s((int)blockIdx.x), G = opaque_s((int)gridDim.x), gw = opaque_s(gw0), NGW = G * NWAVES; (void)lane; (void)bx; (void)G; (void)gw; (void)NGW;
            pg8::Gemm g{A2, w.w2, M, 1024, 384, 384, 384}; pg8::StaticOrder S; S.init(M, 1024, G, bx);
            pg8::EpiBf16<0> E{P2, 1024};
            pg8::gemm_phase<pg8::EpiBf16<0>, pg8::StaticOrder, true, true>(ldsl + RING_OFF, g, S, E, wave);
        }
        PHASE_END()
        CHK(5);

        PHASE_BEGIN(5)
        { const int tid = tid_of(wave), lane = tid & 63, bx = opaque_s((int)blockIdx.x), G = opaque_s((int)gridDim.x), gw = opaque_s(gw0), NGW = G * NWAVES; (void)lane; (void)bx; (void)G; (void)gw; (void)NGW;
            char* alds = (char*)lds + RING_OFF;
            {
                const int x8 = bx & 7, j32 = bx >> 3;
                {
                    const int grp = x8 * 4 + (j32 >> 3), qb = j32 & 7, b = grp >> 2, h = grp & 3; const size_t row0 = (size_t)b * SEQ;
                    att::attn_unit<32>(P2 + (row0 + qb * 256) * 1024 + h * 96, 1024, P2 + row0 * 1024 + 384 + h * 128, 1024, KPE + row0 * 32, 32,
                                       P2 + row0 * 1024 + 384 + h * 128 + 64, 1024, OCAT + (row0 + qb * 256) * 1024 + 256 + h * 64, 1024, SEQ, tabt + (size_t)(qb * 256) * 32, alds, wave);
                }
                for (int i = 0; i < 2; ++i) {
                    const int grp = i * 8 + x8, b = grp >> 1, kvh = grp & 1, hq = kvh * 4 + (j32 >> 3), qb = j32 & 7; const size_t row0 = (size_t)b * SEQ;
                    att::attn_unit<0>(QC + (row0 + qb * 256) * 512 + hq * 64, 512, KC + row0 * 128 + kvh * 64, 128, nullptr, 0,
                                      P1 + row0 * N1 + C_VC + kvh * 64, N1, OCAT + (row0 + qb * 256) * 1024 + 512 + hq * 64, 1024, SEQ, nullptr, alds, wave);
                }
            }
            {
                const int x8 = bx & 7, j32 = bx >> 3; const int grp = x8 * 4 + (j32 >> 3), i = j32 & 7, b = grp >> 2, h = grp & 3; const size_t row0 = (size_t)b * SEQ;
                const int r0 = 4 * i, kst = min(max(r0 - 4, 0), 24), nt = (i == 0 || i == 7) ? 8 : 12;
                const bf16* base = P1 + (row0 + (size_t)kst * GRID_W) * N1;
                att::attn_unit<0, true>(P1 + (row0 + (size_t)r0 * GRID_W) * N1 + C_QA + h * 64, N1, base + C_KA + h * 64, N1, nullptr, 0, base + C_VA + h * 64, N1,
                                        OCAT + (row0 + (size_t)r0 * GRID_W) * 1024 + h * 64, 1024, nt * 64, nullptr, alds, wave, args.in[7] + ((size_t)l * 4 + h) * 15 * 31, r0, kst);
            }
        }
        PHASE_END()
        CHK(6); CHK(7); CHK(8);

        PHASE_BEGIN(6)
        { const int tid = tid_of(wave), lane = tid & 63, bx = opaque_s((int)blockIdx.x), G = opaque_s((int)gridDim.x), gw = opaque_s(gw0), NGW = G * NWAVES; (void)lane; (void)bx; (void)G; (void)gw; (void)NGW;
            pg8::Gemm g{Hb, w.wg, M, NG, DM, DM, DM}; pg8::StaticOrder S; S.init(M, NG, G, bx);
            pg8::EpiGateU8 E{(unsigned char*)GATES, NG, rowss_a, biasp + (size_t)l * BIAS_PER_LAYER + 8 * NB1, NBG, SEQ};
            pg8::gemm_phase<pg8::EpiGateU8, pg8::StaticOrder, true, true>(ldsl + RING_OFF, g, S, E, wave);
        }
        PHASE_END()
        CHK(9);

        PHASE_BEGIN(7)
        { const int tid = tid_of(wave), lane = tid & 63, bx = opaque_s((int)blockIdx.x), G = opaque_s((int)gridDim.x), gw = opaque_s(gw0), NGW = G * NWAVES; (void)lane; (void)bx; (void)G; (void)gw; (void)NGW;
            pg8::Gemm g{OCAT, w.bna, M, DM, DM, DM, DM}; pg8::StaticOrder S; S.init(M, DM, G, bx);
            pg8::EpiMerge E{Hb, DM, (const unsigned char*)GATES, NG};
            pg8::gemm_phase<pg8::EpiMerge, pg8::StaticOrder, true, true>(ldsl + RING_OFF, g, S, E, wave);
        }
        PHASE_END()
        CHK(10);

        PHASE_BEGIN(8)
        { const int tid = tid_of(wave), lane = tid & 63, bx = opaque_s((int)blockIdx.x), G = opaque_s((int)gridDim.x), gw = opaque_s(gw0), NGW = G * NWAVES; (void)lane; (void)bx; (void)G; (void)gw; (void)NGW;
            pg8::Gemm g{Hb, w.wout, M, DM, DM, DM, DM}; pg8::StaticOrder S; S.init(M, DM, G, bx);
            if (l == 0) { pg8::EpiResidualN<true> E{x_in, XB, DM, mod + 2 * DM, NMOD * DM, SEQ, XG2, args.in[5] + (size_t)l * DM, mod + 4 * DM, rowss_b, (LAS float*)(ldsl + EPIX_OFF)};
                pg8::gemm_phase<pg8::EpiResidualN<true>, pg8::StaticOrder, true, true>(ldsl + RING_OFF, g, S, E, wave); }
            else { pg8::EpiResidualN<false> E{XB, XB, DM, mod + 2 * DM, NMOD * DM, SEQ, XG2, args.in[5] + (size_t)l * DM, mod + 4 * DM, rowss_b, (LAS float*)(ldsl + EPIX_OFF)};
                pg8::gemm_phase<pg8::EpiResidualN<false>, pg8::StaticOrder, true, true>(ldsl + RING_OFF, g, S, E, wave); }
        }
        PHASE_END()
        CHK(11);

        PHASE_BEGIN(10)
        { const int tid = tid_of(wave), lane = tid & 63, bx = opaque_s((int)blockIdx.x), G = opaque_s((int)gridDim.x), gw = opaque_s(gw0), NGW = G * NWAVES; (void)lane; (void)bx; (void)G; (void)gw; (void)NGW;
            pg8::Gemm g{XG2, w.wgu, M, 2 * FFN, DM, DM, DM}; pg8::StaticOrder S; S.init(M, 2 * FFN, G, bx);
            pg8::EpiSwiGLUN E{ACT, FFN, rowss_b, biasp + (size_t)l * BIAS_PER_LAYER + 8 * (NB1 + NBG), NBGU, SEQ};
            pg8::gemm_phase<pg8::EpiSwiGLUN, pg8::StaticOrder, true, true>(ldsl + RING_OFF, g, S, E, wave);
        }
        PHASE_END()
        CHK(13);

        PHASE_BEGIN(11)
        { const int tid = tid_of(wave), lane = tid & 63, bx = opaque_s((int)blockIdx.x), G = opaque_s((int)gridDim.x), gw = opaque_s(gw0), NGW = G * NWAVES; (void)lane; (void)bx; (void)G; (void)gw; (void)NGW;
            pg8::Gemm g{ACT, w.wdn, M, DM, FFN, FFN, FFN}; pg8::StaticOrder S; S.init(M, DM, G, bx);
            const bool more = (l + 1 < DEPTH); const float* modn = modp + (size_t)(more ? l + 1 : l) * BATCH * NMOD * DM;
            pg8::EpiResidualN<false> E{XB, XB, DM, mod + 5 * DM, NMOD * DM, SEQ, more ? Hb : (bf16*)nullptr, args.in[4] + (size_t)(more ? l + 1 : l) * DM, modn + DM, rowss_a, (LAS float*)(ldsl + EPIX_OFF)};
            pg8::gemm_phase<pg8::EpiResidualN<false>, pg8::StaticOrder, true, true>(ldsl + RING_OFF, g, S, E, wave);
        }
        PHASE_END()
        CHK(14);
    }

    PHASE_BEGIN(12)
    { const int tid = tid_of(wave), lane = tid & 63, bx = opaque_s((int)blockIdx.x), G = opaque_s((int)gridDim.x), gw = opaque_s(gw0), NGW = G * NWAVES; (void)lane; (void)bx; (void)G; (void)gw; (void)NGW;
        const float* g = args.in[20];
        for (int m = gw; m < M; m += NGW) {
            const bf16* xr = XB + (size_t)m * DM; float* orow = args.out + (size_t)m * DM;
            f32x4 v[4]; float sq = 0.f;
#pragma unroll
            for (int j = 0; j < 2; ++j) { const v4u xw = *(const v4u*)(xr + 512 * j + 8 * lane); v[2 * j] = (f32x4){bflo(xw.x), bfhi(xw.x), bflo(xw.y), bfhi(xw.y)}; v[2 * j + 1] = (f32x4){bflo(xw.z), bfhi(xw.z), bflo(xw.w), bfhi(xw.w)}; }
#pragma unroll
            for (int j = 0; j < 4; ++j) sq += (v[j][0] * v[j][0] + v[j][1] * v[j][1]) + (v[j][2] * v[j][2] + v[j][3] * v[j][3]);
            const float rstd = 1.0f / sqrtf(wave_sum(sq) * (1.0f / DM) + NORM_EPS);
#pragma unroll
            for (int j = 0; j < 4; ++j) { const int c = 512 * (j >> 1) + 8 * lane + 4 * (j & 1); const f32x4 gg = *(const f32x4*)(g + c); f32x4 y;
#pragma unroll
                for (int e = 0; e < 4; ++e) y[e] = v[j][e] * rstd * gg[e];
                *(f32x4*)(orow + c) = y; }
        }
    }
    PHASE_END()
#if TIMING
    {
        float T[2];
        for (int k = 0; k < 2; ++k) { const int g = k == 0 ? TSEL_A : TSEL_B; unsigned long long d = 0;
            if (g < 2) d = tstamp[g + 1] - tstamp[g]; else if (g == 10) d = tstamp[19] - tstamp[18]; else d = (tstamp[g + 1] - tstamp[g]) + (tstamp[g + 9] - tstamp[g + 8]);
            T[k] = (float)d * 0.01f; }
        const int t = tid_of(wave);
        if (blockIdx.x == 0) { for (int i = t; i < 167772; i += NWAVES * 64) args.out[16384 + i] += T[1] * 0.1f; if (t == 0) args.out[0] = T[0]; }
    }
#endif
#undef PHASE_BEGIN
#undef PHASE_END
}

constexpr int N_PHASES = 2 + DEPTH * 8 + 1;
#ifndef MK_PER_PHASE
#define MK_PER_PHASE 0
#endif

extern "C" void kernel_launch(void* const* d_in, const int* in_sizes, int n_in, void* d_out, int out_size, void* d_ws, size_t ws_size, hipStream_t stream) {
    static int grid = 0;
    if (grid == 0) {
        if (n_in != 21 || in_sizes[0] != M * DM || out_size != M * DM || ws_size < WS_END) { fprintf(stderr, "kernel_launch: unexpected shapes (n_in %d in0 %d out %d ws %zu)\n", n_in, n_in > 0 ? in_sizes[0] : -1, out_size, ws_size); grid = -1; return; }
        int dev = 0, cus = 0;
        if (hipGetDevice(&dev) != hipSuccess || hipDeviceGetAttribute(&cus, hipDeviceAttributeMultiprocessorCount, dev) != hipSuccess) { grid = -1; return; }
        if (hipFuncSetAttribute((const void*)hybrid_fwd, hipFuncAttributeMaxDynamicSharedMemorySize, LDS_BYTES) != hipSuccess) { fprintf(stderr, "kernel_launch: hipFuncSetAttribute failed\n"); grid = -1; return; }
        (void)hipGetLastError();
        grid = cus;
    }
    if (grid < 0) return;
    (void)hipMemsetAsync((char*)d_ws + WS_CTL, 0, CTL_ZERO_BYTES, stream);
    Args a{};
    for (int i = 0; i < 21; ++i) a.in[i] = (const float*)d_in[i];
    a.out = (float*)d_out; a.ws = (unsigned char*)d_ws;
#if MK_PER_PHASE
    for (int p = 0; p < N_PHASES; ++p) { a.ph_lo = p; a.ph_hi = p + 1; hipLaunchKernelGGL(hybrid_fwd, dim3(grid), dim3(NWAVES * 64), LDS_BYTES, stream, a); }
#else
    a.ph_lo = 0; a.ph_hi = N_PHASES;
    hipLaunchKernelGGL(hybrid_fwd, dim3(grid), dim3(NWAVES * 64), LDS_BYTES, stream, a);
#endif
    const hipError_t le = hipPeekAtLastError();
    if (le != hipSuccess) fprintf(stderr, "kernel_launch: launch failed: %s\n", hipGetErrorName(le));
}
```
